# Optimizing an MI355X kernel written in HIP

```python
import jax
import jax.numpy as jnp
from jax import lax
import numpy as np

D_MODEL = 2048
BATCH = 8
SEQ = 2048
DEPTH = 1

GRID_W = 64
CTX_LEN = 256

D_CONV = D_MODEL // 2
CONV_WIDTH = 31
D_RWKV = D_MODEL // 2
HEAD_SIZE = 64
N_HEADS_RWKV = D_RWKV // HEAD_SIZE
D_DECAY_LORA = 64
D_AAA_LORA = 64
D_GATE_LORA = 160
N_DIR = 2
GN_EPS = 64e-5
D_SHIFT = 3 * D_RWKV + N_DIR * D_DECAY_LORA + N_DIR * D_AAA_LORA + D_GATE_LORA
P_IN = 2 * D_CONV + D_SHIFT + 2 * D_MODEL
RWKV_SPLITS = (D_RWKV, 2 * D_RWKV, 3 * D_RWKV, 3 * D_RWKV + N_DIR * D_DECAY_LORA,
               3 * D_RWKV + N_DIR * (D_DECAY_LORA + D_AAA_LORA))
N_EXPERTS = 32
TOP_K = 4
D_EXPERT = D_MODEL
SWIGLU_LIMIT = 7.0
SWIGLU_ALPHA = 1.702
LN_EPS = 1e-5
DEEPNORM_ALPHA = (2.0 * DEPTH) ** 0.25
DEEPNORM_BETA = (8.0 * DEPTH) ** -0.25

kernel_name = 'hybrid_conformer_rwkv7_moe_dit_block'


def _layer_norm(h):
    hf = h.astype(jnp.float32)
    mu = jnp.mean(hf, -1, keepdims=True)
    var = jnp.mean(jnp.square(hf - mu), -1, keepdims=True)
    return ((hf - mu) * lax.rsqrt(var + LN_EPS)).astype(h.dtype)


def _modulate(h, shift, scale):
    return _layer_norm(h) * (1.0 + scale[..., None, :]) + shift[..., None, :]


def _post_norm(res, out, gate, g, b):
    return _layer_norm(DEEPNORM_ALPHA * res + gate[..., None, :] * out) * g + b


def _centred_shift(z, mu_prev, mu_next):
    zero = jnp.zeros_like(z[:, :1])
    prev = jnp.concatenate([zero, z[:, :-1]], axis=1)
    nxt = jnp.concatenate([z[:, 1:], zero], axis=1)
    return z + mu_prev * (prev - z) + mu_next * (nxt - z)


def _conv_branch(zc, p, rows):
    B, T, _ = zc.shape
    h = zc[..., :D_CONV] * jax.nn.sigmoid(zc[..., D_CONV:])
    if rows is not None:
        h = h.reshape(B * rows, GRID_W, D_CONV)
    h = lax.conv_general_dilated(h, p['conv_w'][:, None, :], window_strides=(1,),
                                 padding=[(CONV_WIDTH // 2, CONV_WIDTH // 2)],
                                 dimension_numbers=('NWC', 'WIO', 'NWC'),
                                 feature_group_count=D_CONV)
    h = h.reshape(B, T, D_CONV) + p['conv_b']
    h = _layer_norm(h) * p['conv_ln_g'] + p['conv_ln_b']
    return jax.nn.silu(h) @ p['w_conv_o'] + p['b_conv_o']


def _rwkv_prepare(zr, p):
    B, T, _ = zr.shape
    zr = _centred_shift(zr, p['shift_mu'][0], p['shift_mu'][1])
    r, k, v, wd, ad, gd = jnp.split(zr, RWKV_SPLITS, axis=-1)
    heads = lambda t: t.reshape(B, T, N_HEADS_RWKV, HEAD_SIZE)
    g = jax.nn.sigmoid(gd) @ p['g2']
    kk = heads(k * p['k_k']).astype(jnp.float32)
    kk = kk / jnp.maximum(jnp.sqrt(jnp.sum(kk * kk, -1, keepdims=True)), 1e-12)
    dirs = []
    for d in range(N_DIR):
        wd_d = wd[..., d * D_DECAY_LORA:(d + 1) * D_DECAY_LORA]
        ad_d = ad[..., d * D_AAA_LORA:(d + 1) * D_AAA_LORA]
        w_log = -jax.nn.softplus(-(p['w0'][d] + jnp.tanh(wd_d) @ p['w2'][d])) - 0.5
        decay = jnp.exp(-jnp.exp(w_log.astype(jnp.float32)))
        a = jax.nn.sigmoid(p['a0'][d] + ad_d @ p['a2'][d])
        k_d = k * (1.0 + (a - 1.0) * p['k_a'])
        dirs.append((heads(decay), heads(k_d), heads(a).astype(jnp.float32)))
    return heads(r), heads(v), kk, g, dirs


def _wkv_scan(state0, r, decay, k, v, a_vec, b_vec, reverse):
    def step(S, inp):
        r_t, w_t, k_t, v_t, a_t, b_t = inp
        sa = jnp.einsum('bhvk,bhk->bhv', S, a_t)
        S = S * w_t[:, :, None, :] + sa[..., None] * b_t[:, :, None, :] + v_t[..., None] * k_t[:, :, None, :]
        return S, jnp.einsum('bhvk,bhk->bhv', S, r_t)
    xs = tuple(jnp.moveaxis(t.astype(jnp.float32), 1, 0) for t in (r, decay, k, v, a_vec, b_vec))
    S, ys = lax.scan(step, state0, xs, reverse=reverse)
    return S, jnp.moveaxis(ys, 0, 1)


def _rwkv_out(y, r, v, dirs, g, p):
    B, T = y.shape[:2]
    mu = jnp.mean(y, -1, keepdims=True)
    var = jnp.mean(jnp.square(y - mu), -1, keepdims=True)
    yn = ((y - mu) * lax.rsqrt(var + GN_EPS)).reshape(B, T, D_RWKV).astype(r.dtype)
    yn = yn * p['lnx_g'] + p['lnx_b']
    rk = sum(jnp.sum(r * k_d * p['r_k'], -1, keepdims=True) for (_, k_d, _) in dirs)
    bonus = (rk * v).reshape(B, T, D_RWKV)
    return ((yn + bonus) * g) @ p['w_rwkv_o']


def _merge(y_conv, y_rwkv, zg, p):
    mix = jax.nn.sigmoid(zg[..., :D_MODEL]) * y_conv + jax.nn.sigmoid(zg[..., D_MODEL:]) * y_rwkv
    return mix @ p['w_out'] + p['b_out']


def _split_proj(z):
    return z[..., :2 * D_CONV], z[..., 2 * D_CONV:2 * D_CONV + D_SHIFT], z[..., 2 * D_CONV + D_SHIFT:]


def _moe(u, p):
    B, T, D = u.shape
    t = u.reshape(B * T, D)
    logits = (t @ p['w_router'] + p['b_router']).astype(jnp.float32)
    top_vals, top_idx = lax.top_k(logits, TOP_K)
    gates = jax.nn.softmax(top_vals, axis=-1)
    combine = jnp.sum(jax.nn.one_hot(top_idx, N_EXPERTS, dtype=jnp.float32) * gates[..., None], axis=1).astype(t.dtype)
    out = jnp.zeros_like(t)
    for e in range(N_EXPERTS):
        h = t @ p['w_gate_up'][e] + p['b_gate_up'][e]
        gate = jnp.minimum(h[:, :D_EXPERT], SWIGLU_LIMIT)
        up = jnp.clip(h[:, D_EXPERT:], -SWIGLU_LIMIT, SWIGLU_LIMIT)
        hid = (up + 1.0) * (gate * jax.nn.sigmoid(SWIGLU_ALPHA * gate))
        out = out + combine[:, e:e + 1] * (hid @ p['w_down'][e] + p['b_down'][e])
    return out.reshape(B, T, D)


def setup_inputs(seed: int = 0) -> dict:
    key = jax.random.key(seed)
    ks = iter(jax.random.split(key, 48))
    nrm = lambda shape, scale: jax.random.normal(next(ks), shape, jnp.float32) * scale
    L = DEPTH
    D = D_MODEL
    w0_base = jnp.linspace(-6.5, -1.5, D_RWKV, dtype=jnp.float32)
    return {
        'x': nrm((BATCH, SEQ, D), 1.0),
        'c': nrm((BATCH, D), 1.0),
        'ctx': nrm((BATCH, CTX_LEN, D), 1.0),
        'c_ctx': nrm((D,), 1.0),
        'w_ada': nrm((L, D, 6 * D), D ** -0.5),
        'b_ada': nrm((L, 6 * D), 0.01),
        'w_in': nrm((L, D, P_IN), D ** -0.5),
        'b_in': nrm((L, P_IN), 0.01),
        'shift_mu': jax.random.uniform(next(ks), (L, 2, D_SHIFT), jnp.float32, 0.0, 0.5),
        'conv_w': nrm((L, CONV_WIDTH, D_CONV), CONV_WIDTH ** -0.5),
        'conv_b': nrm((L, D_CONV), 0.01),
        'conv_ln_g': 1.0 + nrm((L, D_CONV), 0.02),
        'conv_ln_b': nrm((L, D_CONV), 0.01),
        'w_conv_o': nrm((L, D_CONV, D), D_CONV ** -0.5 * DEEPNORM_BETA),
        'b_conv_o': nrm((L, D), 0.01),
        'w0': w0_base + nrm((L, N_DIR, D_RWKV), 0.1),
        'w2': nrm((L, N_DIR, D_DECAY_LORA, D_RWKV), 0.1 * D_DECAY_LORA ** -0.5),
        'a0': nrm((L, N_DIR, D_RWKV), 0.1),
        'a2': nrm((L, N_DIR, D_AAA_LORA, D_RWKV), D_AAA_LORA ** -0.5),
        'g2': nrm((L, D_GATE_LORA, D_RWKV), D_GATE_LORA ** -0.5),
        'k_k': 0.85 + nrm((L, D_RWKV), 0.02),
        'k_a': 1.0 + nrm((L, D_RWKV), 0.02),
        'r_k': nrm((L, N_HEADS_RWKV, HEAD_SIZE), 0.05),
        'lnx_g': 1.0 + nrm((L, D_RWKV), 0.02),
        'lnx_b': nrm((L, D_RWKV), 0.01),
        'w_rwkv_o': nrm((L, D_RWKV, D), D_RWKV ** -0.5 * DEEPNORM_BETA),
        'w_out': nrm((L, D, D), D ** -0.5 * DEEPNORM_BETA),
        'b_out': nrm((L, D), 0.01),
        'ln1_g': 1.0 + nrm((L, D), 0.02),
        'ln1_b': nrm((L, D), 0.01),
        'w_router': nrm((L, D, N_EXPERTS), D ** -0.5),
        'b_router': nrm((L, N_EXPERTS), 0.01),
        'w_gate_up': nrm((L, N_EXPERTS, D, 2 * D_EXPERT), D ** -0.5),
        'b_gate_up': nrm((L, N_EXPERTS, 2 * D_EXPERT), 0.01),
        'w_down': nrm((L, N_EXPERTS, D_EXPERT, D), D_EXPERT ** -0.5 * DEEPNORM_BETA),
        'b_down': nrm((L, N_EXPERTS, D), 0.01),
        'ln2_g': 1.0 + nrm((L, D), 0.02),
        'ln2_b': nrm((L, D), 0.01),
    }


def reference(x, c, ctx, c_ctx, w_ada, b_ada, w_in, b_in, shift_mu, conv_w, conv_b, conv_ln_g, conv_ln_b,
              w_conv_o, b_conv_o, w0, w2, a0, a2, g2, k_k, k_a, r_k, lnx_g, lnx_b, w_rwkv_o, w_out, b_out,
              ln1_g, ln1_b, w_router, b_router, w_gate_up, b_gate_up, w_down, b_down, ln2_g, ln2_b):
    B, n_lat, _ = x.shape
    rows = n_lat // GRID_W
    h_ctx = ctx
    for l in range(DEPTH):
        need_ctx = l < DEPTH - 1
        p = {'shift_mu': shift_mu[l], 'conv_w': conv_w[l], 'conv_b': conv_b[l], 'conv_ln_g': conv_ln_g[l],
             'conv_ln_b': conv_ln_b[l], 'w_conv_o': w_conv_o[l], 'b_conv_o': b_conv_o[l], 'w0': w0[l],
             'w2': w2[l], 'a0': a0[l], 'a2': a2[l], 'g2': g2[l], 'k_k': k_k[l], 'k_a': k_a[l], 'r_k': r_k[l],
             'lnx_g': lnx_g[l], 'lnx_b': lnx_b[l], 'w_rwkv_o': w_rwkv_o[l], 'w_out': w_out[l], 'b_out': b_out[l],
             'w_router': w_router[l], 'b_router': b_router[l], 'w_gate_up': w_gate_up[l],
             'b_gate_up': b_gate_up[l], 'w_down': w_down[l], 'b_down': b_down[l]}
        mod_l = jnp.split(jax.nn.silu(c) @ w_ada[l] + b_ada[l], 6, axis=-1)
        mod_c = jnp.split(jax.nn.silu(c_ctx) @ w_ada[l] + b_ada[l], 6, axis=-1)

        z_l = _modulate(x, mod_l[0], mod_l[1]) @ w_in[l] + b_in[l]
        z_c = _modulate(h_ctx, mod_c[0], mod_c[1]) @ w_in[l] + b_in[l]
        zc_l, zr_l, zg_l = _split_proj(z_l)
        zc_c, zr_c, zg_c = _split_proj(z_c)

        r_c, v_c, kk_c, g_c, dirs_c = _rwkv_prepare(zr_c, p)
        r_l, v_l, kk_l, g_l, dirs_l = _rwkv_prepare(zr_l, p)
        state0 = jnp.zeros((B, N_HEADS_RWKV, HEAD_SIZE, HEAD_SIZE), jnp.float32)
        y_l = 0.0
        y_c = 0.0
        for d in range(N_DIR):
            rev = d == 1
            dec_c, kd_c, a_c = dirs_c[d]
            s_ctx, yc_d = _wkv_scan(state0, r_c, dec_c, kd_c, v_c, -kk_c, kk_c * a_c, rev)
            dec_l, kd_l, a_l = dirs_l[d]
            _, yl_d = _wkv_scan(s_ctx, r_l, dec_l, kd_l, v_l, -kk_l, kk_l * a_l, rev)
            y_l = y_l + yl_d
            y_c = y_c + yc_d
        out_l = _merge(_conv_branch(zc_l, p, rows), _rwkv_out(y_l, r_l, v_l, dirs_l, g_l, p), zg_l, p)
        x_mid = _post_norm(x, out_l, mod_l[2], ln1_g[l], ln1_b[l])

        x = _post_norm(x_mid, _moe(_modulate(x_mid, mod_l[3], mod_l[4]), p), mod_l[5], ln2_g[l], ln2_b[l])

        if need_ctx:
            out_c = _merge(_conv_branch(zc_c, p, None), _rwkv_out(y_c, r_c, v_c, dirs_c, g_c, p), zg_c, p)
            c_mid = _post_norm(h_ctx, out_c, mod_c[2], ln1_g[l], ln1_b[l])
            h_ctx = _post_norm(c_mid, _moe(_modulate(c_mid, mod_c[3], mod_c[4]), p), mod_c[5], ln2_g[l], ln2_b[l])
    return x
```

```cpp
#include <hip/hip_runtime.h>
#include <cstdio>
#include <cstdint>
#include <cstring>

#ifndef MK_FUSED
#define MK_FUSED 0
#endif

#define GAS __attribute__((address_space(1)))
#define LAS __attribute__((address_space(3)))
typedef unsigned short bf16;
typedef short bf16x8 __attribute__((ext_vector_type(8)));
typedef float f32x4 __attribute__((ext_vector_type(4)));
typedef float f32x2 __attribute__((ext_vector_type(2)));
typedef unsigned u32x4 __attribute__((ext_vector_type(4)));
typedef unsigned u32x2 __attribute__((ext_vector_type(2)));

constexpr int D = 2048, NB = 8, SEQ = 2048, CTXL = 256, TL = NB * SEQ, TC = NB * CTXL, TT = TL + TC;
constexpr int DCV = 1024, DR = 1024, NH = 16, HS = 64, CWID = 31;
constexpr int DSHIFT = 3488, PIN = 9632;
constexpr int ZN = 9728, ZCN = 3584, ZR0 = 2048, ZG0 = 5632;
constexpr int NE = 32, ECAP = 16384, MAXMT = 288;
constexpr int LORA_K = 512, LORA_N = 5120;
constexpr int NOCT = (CTXL + SEQ) / 8;
constexpr int SC_REC = 11264;
constexpr float LN_EPS = 1e-5f, GN_EPS = 64e-5f, DN_ALPHA = 1.189207115002721f;
constexpr float SW_LIMIT = 7.0f, SW_ALPHA = 1.702f;

constexpr size_t MiB = 1u << 20;
constexpr size_t WS_CTL = 0, CTL_ZERO_BYTES = 1 * MiB;
constexpr size_t WS_MOD = 1 * MiB, WS_BIN = 2 * MiB, WS_BGU = 2 * MiB + 65536, WS_WR = 3 * MiB, WS_SEL = 4 * MiB, WS_RK = 5 * MiB;
constexpr size_t WS_ROWTOK = 6 * MiB, WS_ROWW = 8 * MiB, WS_WCO = 10 * MiB, WS_WRO = 14 * MiB, WS_WOUT = 18 * MiB, WS_WLORA = 26 * MiB;
constexpr size_t WS_WIN = 32 * MiB, WS_U = 70 * MiB, WS_ACONV = 142 * MiB, WS_ALORA = 174 * MiB, WS_ARWKV = 192 * MiB, WS_VS = 224 * MiB;
constexpr size_t WS_MIX = 256 * MiB, WS_U2HI = 320 * MiB, WS_U2LO = 384 * MiB, WS_T1 = 448 * MiB, WS_XMID = 576 * MiB, WS_Y = 704 * MiB;
constexpr size_t WS_ZC = 832 * MiB, WS_LORA = 848 * MiB, WS_ZL = 1028 * MiB, WS_SC = 1332 * MiB, WS_WGU = 1728 * MiB, WS_WDN = 2240 * MiB;
constexpr size_t WS_HID = 2496 * MiB, WS_DOWN = 2784 * MiB, WS_END = 3072 * MiB;
constexpr int CW_BAR = 4096;
constexpr int CW_CNT = 1024;

constexpr int RING_BYTES = 131072;
constexpr int LDSX_OFF = RING_BYTES;
constexpr int LX_MISC = LDSX_OFF;
constexpr int LX_CNT = LDSX_OFF + 256;
constexpr int LX_TST = LDSX_OFF + 512;
constexpr int LX_TE = LDSX_OFF + 768;
constexpr int LDS_BYTES = 147456;

__device__ __forceinline__ unsigned f2bf(float f) { unsigned u = __builtin_bit_cast(unsigned, f); return (u + 0x7fffu + ((u >> 16) & 1u)) >> 16; }
__device__ __forceinline__ unsigned cvt_pk_bf16(float lo, float hi) { unsigned r; asm volatile("v_cvt_pk_bf16_f32 %0, %1, %2" : "=v"(r) : "v"(lo), "v"(hi)); return r; }
__device__ __forceinline__ float bflo(unsigned u) { return __builtin_bit_cast(float, u << 16); }
__device__ __forceinline__ float bfhi(unsigned u) { return __builtin_bit_cast(float, u & 0xffff0000u); }
__device__ __forceinline__ float bf1(bf16 h) { return __builtin_bit_cast(float, ((unsigned)h) << 16); }
__device__ __forceinline__ float sigm(float x) { return __builtin_amdgcn_rcpf(1.f + __expf(-x)); }
__device__ __forceinline__ float wave_sum(float v) {
#pragma unroll
    for (int o = 1; o < 64; o <<= 1) v += __shfl_xor(v, o);
    return v;
}
#define RLX_AGENT __ATOMIC_RELAXED, __HIP_MEMORY_SCOPE_AGENT

#define XB_TMO      128
#define XB_XCNT(j)  (256  + 64 * (j))
#define XB_XSUB(j)  (1280 + 64 * (j))
#define XB_XGEN(j)  (2304 + 64 * (j))
#define XB_TOP      3328
#define XB_TOPGEN   3392
#define XCD_BAR_WORDS 3456
#define XB_SPIN_CAP (1u << 22)
__device__ __forceinline__ unsigned xb_ld(unsigned* p)              { return __hip_atomic_load(p, __ATOMIC_RELAXED, __HIP_MEMORY_SCOPE_AGENT); }
__device__ __forceinline__ unsigned xb_add(unsigned* p, unsigned v) { return __hip_atomic_fetch_add(p, v, __ATOMIC_RELAXED, __HIP_MEMORY_SCOPE_AGENT); }
__device__ __forceinline__ unsigned xb_xcc_id() { return (unsigned)__builtin_amdgcn_s_getreg((3 << 11) | 20) & 0xFu; }
#define XB_SPIN(cond, bar) do { unsigned _sp = 0; while (cond) { __builtin_amdgcn_s_sleep(1); \
    if ((++_sp & 255u) == 0u) { if (xb_ld(&(bar)[XB_TMO])) break; if (_sp > XB_SPIN_CAP) { atomicAdd(&(bar)[XB_TMO], 1u); break; } } } } while (0)
struct XcdBarrier { unsigned* bar; unsigned x; volatile LAS unsigned* st; };
__device__ __forceinline__ XcdBarrier xcd_barrier_post(unsigned* bar, volatile LAS unsigned* st) {
    XcdBarrier b; b.bar = bar; b.x = xb_xcc_id(); b.st = st;
    if (threadIdx.x == 0) (void)xb_add(&bar[XB_XCNT(b.x)], 1u);
    return b;
}
__device__ __forceinline__ void xcd_barrier_complete(unsigned* bar, unsigned x, unsigned& nloc, unsigned& nx) {
    const unsigned G = gridDim.x * gridDim.y * gridDim.z;
    unsigned sum, cnt, mine, sp = 0u;
    for (;;) {
        sum = 0u; cnt = 0u; mine = 0u;
#pragma unroll
        for (unsigned j = 0; j < 16; ++j) { const unsigned c = xb_ld(&bar[XB_XCNT(j)]); sum += c; cnt += (c > 0u) ? 1u : 0u; mine = (j == x) ? c : mine; }
        if (sum == G) break;
        __builtin_amdgcn_s_sleep(1);
        if ((++sp & 255u) == 0u) { if (xb_ld(&bar[XB_TMO])) break; if (sp > XB_SPIN_CAP) { atomicAdd(&bar[XB_TMO], 1u); break; } }
    }
    nloc = mine > 0u ? mine : 1u; nx = cnt > 0u ? cnt : 1u;
}
__device__ __forceinline__ void xcd_barrier(const XcdBarrier& b) {
    asm volatile("s_waitcnt vmcnt(0)" ::: "memory");
    __syncthreads();
    if (threadIdx.x == 0) {
        unsigned* bar = b.bar;
        __builtin_amdgcn_s_waitcnt(0);
        unsigned nloc = b.st[0], nx = b.st[1];
        if (nloc == 0u) { xcd_barrier_complete(bar, b.x, nloc, nx); b.st[0] = nloc; b.st[1] = nx; }
        const unsigned old = xb_add(&bar[XB_XSUB(b.x)], 1u);
        const unsigned gen = old / nloc;
        if (old + 1u == (gen + 1u) * nloc) {
            __builtin_amdgcn_fence(__ATOMIC_RELEASE, "agent");
            asm volatile("s_waitcnt vmcnt(0)" ::: "memory");
            const unsigned og = xb_add(&bar[XB_TOP], 1u);
            const unsigned tg = og / nx;
            if (og + 1u == (tg + 1u) * nx) xb_add(&bar[XB_TOPGEN], 1u);
            else XB_SPIN(xb_ld(&bar[XB_TOPGEN]) == tg, bar);
            __builtin_amdgcn_fence(__ATOMIC_ACQUIRE, "agent");
            xb_add(&bar[XB_XGEN(b.x)], 1u);
            asm volatile("s_waitcnt vmcnt(0)" ::: "memory");
        } else {
            XB_SPIN(xb_ld(&bar[XB_XGEN(b.x)]) == gen, bar);
            __builtin_amdgcn_fence(__ATOMIC_ACQUIRE, "agent");
            asm volatile("s_waitcnt vmcnt(0)" ::: "memory");
        }
    }
    __syncthreads();
}

namespace pg8 {
constexpr int BM = 256, BK = 64, HALF = 128, HTB = HALF * BK * 2, STAGE_BYTES = 8 * HTB, NXCD = 8, WGM = 8;
__host__ __device__ __forceinline__ int lds_byte(int r, int c) { const int st = (r >> 4) * 2 + (c >> 5), rr = r & 15, cc = c & 31, ob = rr * 64 + cc * 2; return st * 1024 + (ob ^ (((ob >> 9) & 1) << 5)); }
__host__ __device__ __forceinline__ void stage_rc(int b, int& R, int& C) { const int st = b / 1024, sb = b % 1024, swz = sb ^ (((sb >> 9) & 1) << 5); R = (st >> 1) * 16 + swz / 64; C = (st & 1) * 32 + (swz % 64) / 2; }
__host__ __device__ __forceinline__ int perm32(int rho) { const int n = rho >> 4, i = rho & 15; return 8 * (i >> 2) + 4 * n + (i & 3); }

struct Unit { int pm, pn, e, lt; };
__device__ __forceinline__ void map_tile(int wgid, int nwg, int nM, int nN, int& pm, int& pn) {
    { const int q = nwg / NXCD, r = nwg % NXCD, xcd = wgid % NXCD, off = wgid / NXCD; wgid = (xcd < r ? xcd * (q + 1) : r * (q + 1) + (xcd - r) * q) + off; }
    const int nig = WGM * nN, gid = wgid / nig, fm = gid * WGM, gsz = (nM - fm) < WGM ? (nM - fm) : WGM;
    pm = fm + ((wgid % nig) % gsz); pn = (wgid % nig) / gsz;
}
struct PlainSched {
    const bf16* A; const bf16* Bt; int K, nM, nN, G, c;
    __device__ __forceinline__ bool next(int i, Unit& u) const { const long L = (long)i * G + c; if (L >= (long)nM * nN) return false; map_tile((int)L, nM * nN, nM, nN, u.pm, u.pn); u.e = 0; u.lt = 0; return true; }
    __device__ __forceinline__ const char* aptr(const Unit& u) const { return (const char*)A + (size_t)u.pm * BM * K * 2; }
    __device__ __forceinline__ const char* bptr(const Unit& u) const { return (const char*)Bt + (size_t)u.pn * BM * K * 2; }
    __device__ __forceinline__ void rows(const Unit&, const int (&)[2], const int (&)[2], unsigned (&)[2][2]) const {}
};
struct InProjSched {
    const bf16* A; const bf16* Bt; int G, c;
    __device__ __forceinline__ bool next(int i, Unit& u) const {
        const int L = i * G + c; constexpr int NL = 64 * 38, NCX = 8 * 14;
        if (L >= NL + NCX) return false;
        if (L < NL) map_tile(L, NL, 64, 38, u.pm, u.pn); else { map_tile(L - NL, NCX, 8, 14, u.pm, u.pn); u.pm += 64; u.pn += 8; }
        u.e = 0; u.lt = 0; return true; }
    __device__ __forceinline__ const char* aptr(const Unit& u) const { return (const char*)A + (size_t)u.pm * BM * D * 2; }
    __device__ __forceinline__ const char* bptr(const Unit& u) const { return (const char*)Bt + (size_t)u.pn * BM * D * 2; }
    __device__ __forceinline__ void rows(const Unit&, const int (&)[2], const int (&)[2], unsigned (&)[2][2]) const {}
};
struct MoeSched {
    const bf16* A; const bf16* Bt; const int* rowtok; int K, N, nN, G, c; const LAS int* cnt; const LAS int* tst; const LAS unsigned char* te;
    __device__ __forceinline__ bool next(int i, Unit& u) const { const int nM = tst[NE]; const int L = i * G + c; if (L >= nM * nN) return false;
        map_tile(L, nM * nN, nM, nN, u.pm, u.pn); u.e = te[u.pm]; u.lt = u.pm - tst[u.e]; return true; }
    __device__ __forceinline__ const char* aptr(const Unit& u) const { return (const char*)A + (size_t)u.pm * BM * K * 2; }
    __device__ __forceinline__ const char* bptr(const Unit& u) const { return (const char*)Bt + ((size_t)u.e * N + (size_t)u.pn * BM) * K * 2; }
    __device__ __forceinline__ void rows(const Unit& u, const int (&sR)[2], const int (&sC2)[2], unsigned (&g)[2][2]) const {
        const int n = cnt[u.e]; const int* rt = rowtok + (size_t)u.e * ECAP;
#pragma unroll
        for (int h = 0; h < 2; ++h)
#pragma unroll
            for (int i = 0; i < 2; ++i) { const int j = u.lt * BM + h * HALF + sR[i]; const int tok = (j < n) ? rt[j] : 0; g[h][i] = (unsigned)tok * (unsigned)(K * 2) + (unsigned)sC2[i]; }
        asm volatile("s_waitcnt vmcnt(0)" ::: "memory");
    }
};

template <class Epi, class Sched, bool GATHER>
__device__ __forceinline__ void gemm_phase(LAS unsigned char* lds, const int K, const Sched& S, const Epi& E, const char* gatherA) {
    const int tid = threadIdx.x, wid = __builtin_amdgcn_readfirstlane(tid >> 6), lane = tid & 63, wr = wid >> 2, wc = wid & 3, fr = lane & 15, fq = lane >> 4;
    const int nt = K / BK;
    unsigned voffA[2], voffB[2]; int sR[2], sC2[2];
#pragma unroll
    for (int i = 0; i < 2; ++i) { int R, C; stage_rc(tid * 16 + i * 8192, R, C); const int Rb = Epi::PERM ? ((R & ~31) + perm32(R & 31)) : R;
        voffA[i] = (unsigned)(R * K + C) * 2u; voffB[i] = (unsigned)(Rb * K + C) * 2u; sR[i] = R; sC2[i] = C * 2; }
    const size_t kstep = (size_t)(BK * 2);
    const size_t hstep = (size_t)HALF * K * 2;
    const unsigned ldsw = (unsigned)wid * 1024u;
    const int aoff = lds_byte(wr * 64 + fr, fq * 8), boff = lds_byte(wc * 32 + fr, fq * 8);
#define PG8_SA(b, h) (((b) * 2 + (h)) * HTB)
#define PG8_SB(b, h) ((4 + (b) * 2 + (h)) * HTB)
#define PG8_STAGE(bufoff, gbase, voff) do { _Pragma("unroll") for (int _i = 0; _i < 2; ++_i) \
        __builtin_amdgcn_global_load_lds((const unsigned*)((const char*)(gbase) + (voff)[_i]), (LAS unsigned*)(lds + (bufoff) + ldsw + _i * 8192), 16, 0, 0); } while (0)
#define PG8_STG_A(bufoff, gbase, h, OFF) do { if constexpr (GATHER) { PG8_STAGE(bufoff, gbase, OFF); } else { PG8_STAGE(bufoff, (gbase) + (h) * hstep, voffA); } } while (0)
#define PG8_LDA(dst, b, h) do { _Pragma("unroll") for (int m = 0; m < 4; ++m) _Pragma("unroll") for (int k = 0; k < 2; ++k) dst[m][k] = *(const LAS bf16x8*)(lds + PG8_SA(b, h) + aoff + m * 2048 + k * 1024); } while (0)
#define PG8_LDB(dst, b, h) do { _Pragma("unroll") for (int n = 0; n < 2; ++n) _Pragma("unroll") for (int k = 0; k < 2; ++k) dst[n][k] = *(const LAS bf16x8*)(lds + PG8_SB(b, h) + boff + n * 2048 + k * 1024); } while (0)
#define PG8_MMA(ai, bj, At, Bt) do { __builtin_amdgcn_s_setprio(1); _Pragma("unroll") for (int m = 0; m < 4; ++m) _Pragma("unroll") for (int n = 0; n < 2; ++n) _Pragma("unroll") for (int k = 0; k < 2; ++k) \
        acc[ai][bj][m][n] = __builtin_amdgcn_mfma_f32_16x16x32_bf16(Bt[n][k], At[m][k], acc[ai][bj][m][n], 0, 0, 0); __builtin_amdgcn_s_setprio(0); } while (0)
#define PG8_WAIT_V(n) asm volatile("s_waitcnt vmcnt(" #n ")" ::: "memory")
#define PG8_WAIT_L(n) asm volatile("s_waitcnt lgkmcnt(" #n ")" ::: "memory")
#define PG8_BAR __builtin_amdgcn_s_barrier()
#define PG8_SCHED __builtin_amdgcn_sched_barrier(0)
    Unit cur, nxt; int ui = 0;
    if (!S.next(0, cur)) return;
    f32x4 acc[2][2][4][2];
#pragma unroll
    for (int a = 0; a < 2; ++a)
#pragma unroll
        for (int b = 0; b < 2; ++b)
#pragma unroll
            for (int m = 0; m < 4; ++m)
#pragma unroll
                for (int n = 0; n < 2; ++n) acc[a][b][m][n] = (f32x4){0.f, 0.f, 0.f, 0.f};
    bf16x8 At[4][2], B0[2][2], B1[2][2];
    const char* cA = GATHER ? gatherA : S.aptr(cur); const char* cB = S.bptr(cur);
    unsigned gA[2][2] = {{0u, 0u}, {0u, 0u}}, gA1[2] = {0u, 0u};
    if constexpr (GATHER) S.rows(cur, sR, sC2, gA);
    PG8_STAGE(PG8_SB(0, 0), cB, voffB); PG8_STAGE(PG8_SB(0, 1), cB + hstep, voffB); PG8_STG_A(PG8_SA(0, 0), cA, 0, gA[0]); PG8_STG_A(PG8_SA(0, 1), cA, 1, gA[1]);
    if (wr == 1) PG8_BAR;
    PG8_WAIT_V(2); PG8_BAR;
    PG8_STAGE(PG8_SB(1, 0), cB + kstep, voffB); PG8_STG_A(PG8_SA(1, 0), cA + kstep, 0, gA[0]); PG8_STAGE(PG8_SB(1, 1), cB + hstep + kstep, voffB);
    PG8_WAIT_V(6); PG8_BAR;
    for (;;) {
        const bool has_next = S.next(ui + 1, nxt);
        const char* nA = GATHER ? gatherA : (has_next ? S.aptr(nxt) : cA); const char* nB = has_next ? S.bptr(nxt) : cB;
        for (int t = 0; t < nt; t += 2) {
            const bool last = (t == nt - 2);
            const char* a1 = cA + (size_t)(t + 1) * kstep;
            const char* a2 = last ? nA : cA + (size_t)(t + 2) * kstep; const char* b2 = last ? nB : cB + (size_t)(t + 2) * kstep;
            const char* a3 = a2 + kstep; const char* b3 = b2 + kstep;
            if constexpr (GATHER) { gA1[0] = gA[1][0]; gA1[1] = gA[1][1]; if (last && has_next) S.rows(nxt, sR, sC2, gA); }
            PG8_LDB(B0, 0, 0); PG8_LDB(B1, 0, 1); PG8_SCHED; PG8_LDA(At, 0, 0); PG8_STG_A(PG8_SA(1, 1), a1, 1, gA1);
            PG8_WAIT_V(8); PG8_WAIT_L(0); PG8_BAR; PG8_MMA(0, 0, At, B0); PG8_MMA(0, 1, At, B1); PG8_BAR; PG8_SCHED;
            PG8_LDA(At, 0, 1); PG8_STAGE(PG8_SB(0, 0), b2, voffB); PG8_STAGE(PG8_SB(0, 1), b2 + hstep, voffB); PG8_STG_A(PG8_SA(0, 0), a2, 0, gA[0]);
            PG8_WAIT_V(8); PG8_WAIT_L(0); PG8_BAR; PG8_MMA(1, 0, At, B0); PG8_MMA(1, 1, At, B1); PG8_BAR; PG8_SCHED;
            PG8_LDB(B0, 1, 0); PG8_LDB(B1, 1, 1); PG8_SCHED; PG8_LDA(At, 1, 0); PG8_STG_A(PG8_SA(0, 1), a2, 1, gA[1]);
            PG8_WAIT_V(8); PG8_WAIT_L(0); PG8_BAR; PG8_MMA(0, 0, At, B0); PG8_MMA(0, 1, At, B1); PG8_BAR; PG8_SCHED;
            PG8_LDA(At, 1, 1); PG8_STAGE(PG8_SB(1, 0), b3, voffB); PG8_STAGE(PG8_SB(1, 1), b3 + hstep, voffB); PG8_STG_A(PG8_SA(1, 0), a3, 0, gA[0]);
            PG8_WAIT_V(8); PG8_WAIT_L(0); PG8_BAR; PG8_MMA(1, 0, At, B0); PG8_MMA(1, 1, At, B1); PG8_BAR; PG8_SCHED;
        }
        if (wr == 0) PG8_BAR;
        E(acc, cur, wr, wc, fr, fq);
        if (!has_next) break;
#pragma unroll
        for (int a = 0; a < 2; ++a)
#pragma unroll
            for (int b = 0; b < 2; ++b)
#pragma unroll
                for (int m = 0; m < 4; ++m)
#pragma unroll
                    for (int n = 0; n < 2; ++n) acc[a][b][m][n] = (f32x4){0.f, 0.f, 0.f, 0.f};
        cur = nxt; cA = nA; cB = nB; ++ui;
        if (wr == 1) PG8_BAR;
    }
    PG8_WAIT_V(0);
    PG8_BAR;
#undef PG8_SA
#undef PG8_SB
#undef PG8_STAGE
#undef PG8_STG_A
#undef PG8_LDA
#undef PG8_LDB
#undef PG8_MMA
#undef PG8_WAIT_V
#undef PG8_WAIT_L
#undef PG8_BAR
#undef PG8_SCHED
}

typedef const f32x4 (&AccT)[2][2][4][2];
__device__ __forceinline__ u32x4 pack8(f32x4 v0, f32x4 v1) { u32x4 w; w.x = cvt_pk_bf16(v0[0], v0[1]); w.y = cvt_pk_bf16(v0[2], v0[3]); w.z = cvt_pk_bf16(v1[0], v1[1]); w.w = cvt_pk_bf16(v1[2], v1[3]); return w; }
__device__ __forceinline__ void unpack8(u32x4 w, f32x4& v0, f32x4& v1) { v0 = (f32x4){bflo(w.x), bfhi(w.x), bflo(w.y), bfhi(w.y)}; v1 = (f32x4){bflo(w.z), bfhi(w.z), bflo(w.w), bfhi(w.w)}; }
__device__ __forceinline__ f32x4 sig4(f32x4 v) { return (f32x4){sigm(v[0]), sigm(v[1]), sigm(v[2]), sigm(v[3])}; }

struct EpiBf16Plain {
    static constexpr bool PERM = true;
    bf16* O; int ldc; const float* bias;
    __device__ __forceinline__ void operator()(AccT acc, const Unit& u, int wr, int wc, int fr, int fq) const {
        const int row0 = u.pm * BM + wr * 64 + fr, col0 = u.pn * BM + wc * 32 + 8 * fq;
        f32x4 bv[2][2];
#pragma unroll
        for (int bj = 0; bj < 2; ++bj)
#pragma unroll
            for (int n = 0; n < 2; ++n) bv[bj][n] = bias ? *(const f32x4*)(bias + col0 + bj * HALF + 4 * n) : (f32x4){0.f, 0.f, 0.f, 0.f};
#pragma unroll
        for (int ai = 0; ai < 2; ++ai)
#pragma unroll
            for (int m = 0; m < 4; ++m) { bf16* rowp = O + (size_t)(row0 + ai * HALF + m * 16) * ldc + col0;
#pragma unroll
                for (int bj = 0; bj < 2; ++bj) *(u32x4*)(rowp + bj * HALF) = pack8(acc[ai][bj][m][0] + bv[bj][0], acc[ai][bj][m][1] + bv[bj][1]); }
    }
};
struct EpiInProj {
    static constexpr bool PERM = true;
    bf16* ZL; bf16* ZC; const float* bias;
    __device__ __forceinline__ void operator()(AccT acc, const Unit& u, int wr, int wc, int fr, int fq) const {
        const int row0 = u.pm * BM + wr * 64 + fr, col0 = u.pn * BM + wc * 32 + 8 * fq;
        f32x4 bv[2][2];
#pragma unroll
        for (int bj = 0; bj < 2; ++bj)
#pragma unroll
            for (int n = 0; n < 2; ++n) bv[bj][n] = *(const f32x4*)(bias + col0 + bj * HALF + 4 * n);
        const bool lat = u.pm < 64;
#pragma unroll
        for (int ai = 0; ai < 2; ++ai)
#pragma unroll
            for (int m = 0; m < 4; ++m) { const int r = row0 + ai * HALF + m * 16;
                bf16* rowp = lat ? ZL + (size_t)r * ZN + col0 : ZC + (size_t)(r - TL) * ZCN + (col0 - ZR0);
#pragma unroll
                for (int bj = 0; bj < 2; ++bj) *(u32x4*)(rowp + bj * HALF) = pack8(acc[ai][bj][m][0] + bv[bj][0], acc[ai][bj][m][1] + bv[bj][1]); }
    }
};
struct EpiConvO {
    static constexpr bool PERM = true;
    bf16* MIX; const bf16* ZL; const float* bias;
    __device__ __forceinline__ void operator()(AccT acc, const Unit& u, int wr, int wc, int fr, int fq) const {
        const int row0 = u.pm * BM + wr * 64 + fr, col0 = u.pn * BM + wc * 32 + 8 * fq;
        f32x4 bv[2][2];
#pragma unroll
        for (int bj = 0; bj < 2; ++bj)
#pragma unroll
            for (int n = 0; n < 2; ++n) bv[bj][n] = *(const f32x4*)(bias + col0 + bj * HALF + 4 * n);
#pragma unroll
        for (int ai = 0; ai < 2; ++ai)
#pragma unroll
            for (int m = 0; m < 4; ++m) { const size_t r = (size_t)(row0 + ai * HALF + m * 16);
#pragma unroll
                for (int bj = 0; bj < 2; ++bj) { const int c = col0 + bj * HALF; f32x4 g0, g1; unpack8(*(const u32x4*)(ZL + r * ZN + ZG0 + c), g0, g1);
                    *(u32x4*)(MIX + r * D + c) = pack8(sig4(g0) * (acc[ai][bj][m][0] + bv[bj][0]), sig4(g1) * (acc[ai][bj][m][1] + bv[bj][1])); } }
    }
};
struct EpiRwkvO {
    static constexpr bool PERM = true;
    bf16* MIX; const bf16* ZL;
    __device__ __forceinline__ void operator()(AccT acc, const Unit& u, int wr, int wc, int fr, int fq) const {
        const int row0 = u.pm * BM + wr * 64 + fr, col0 = u.pn * BM + wc * 32 + 8 * fq;
#pragma unroll
        for (int ai = 0; ai < 2; ++ai)
#pragma unroll
            for (int m = 0; m < 4; ++m) { const size_t r = (size_t)(row0 + ai * HALF + m * 16);
#pragma unroll
                for (int bj = 0; bj < 2; ++bj) { const int c = col0 + bj * HALF; f32x4 g0, g1, m0, m1; unpack8(*(const u32x4*)(ZL + r * ZN + ZG0 + D + c), g0, g1); unpack8(*(const u32x4*)(MIX + r * D + c), m0, m1);
                    *(u32x4*)(MIX + r * D + c) = pack8(m0 + sig4(g0) * acc[ai][bj][m][0], m1 + sig4(g1) * acc[ai][bj][m][1]); } }
    }
};
struct EpiOut {
    static constexpr bool PERM = false;
    float* T1; const float* x; const float* mod; const float* bias;
    __device__ __forceinline__ void operator()(AccT acc, const Unit& u, int wr, int wc, int fr, int fq) const {
        const int row0 = u.pm * BM + wr * 64 + fr, col0 = u.pn * BM + wc * 32 + 4 * fq;
        const float* gate = mod + (size_t)(u.pm / 8) * (6 * D) + 2 * D;
        f32x4 bv[2][2], gv[2][2];
#pragma unroll
        for (int bj = 0; bj < 2; ++bj)
#pragma unroll
            for (int n = 0; n < 2; ++n) { bv[bj][n] = *(const f32x4*)(bias + col0 + bj * HALF + n * 16); gv[bj][n] = *(const f32x4*)(gate + col0 + bj * HALF + n * 16); }
#pragma unroll
        for (int ai = 0; ai < 2; ++ai)
#pragma unroll
            for (int m = 0; m < 4; ++m) { const size_t off = (size_t)(row0 + ai * HALF + m * 16) * D + col0;
#pragma unroll
                for (int bj = 0; bj < 2; ++bj)
#pragma unroll
                    for (int n = 0; n < 2; ++n) { const f32x4 xv = *(const f32x4*)(x + off + bj * HALF + n * 16);
                        *(f32x4*)(T1 + off + bj * HALF + n * 16) = xv * DN_ALPHA + gv[bj][n] * (acc[ai][bj][m][n] + bv[bj][n]); } }
    }
};
struct EpiGateUp {
    static constexpr bool PERM = true;
    bf16* HID; const float* bias;
    __device__ __forceinline__ void operator()(AccT acc, const Unit& u, int wr, int wc, int fr, int fq) const {
        const int row0 = u.pm * BM + wr * 64 + fr, cb = u.pn * BM + wc * 32 + 8 * fq, co = u.pn * HALF + wc * 32 + 8 * fq;
        const float* bp = bias + (size_t)u.e * 4096 + cb;
        f32x4 bv[2][2];
#pragma unroll
        for (int bj = 0; bj < 2; ++bj)
#pragma unroll
            for (int n = 0; n < 2; ++n) bv[bj][n] = *(const f32x4*)(bp + bj * HALF + 4 * n);
#pragma unroll
        for (int ai = 0; ai < 2; ++ai)
#pragma unroll
            for (int m = 0; m < 4; ++m) { f32x4 h[2];
#pragma unroll
                for (int n = 0; n < 2; ++n) { const f32x4 g = acc[ai][0][m][n] + bv[0][n], up = acc[ai][1][m][n] + bv[1][n];
#pragma unroll
                    for (int j = 0; j < 4; ++j) { const float gg = fminf(g[j], SW_LIMIT), uu = fminf(fmaxf(up[j], -SW_LIMIT), SW_LIMIT); h[n][j] = (uu + 1.0f) * (gg * sigm(SW_ALPHA * gg)); } }
                *(u32x4*)(HID + (size_t)(row0 + ai * HALF + m * 16) * D + co) = pack8(h[0], h[1]); }
    }
};
struct EpiDown {
    static constexpr bool PERM = true;
    bf16* DOWN; const float* bias; const float* roww; const LAS int* cnt;
    __device__ __forceinline__ void operator()(AccT acc, const Unit& u, int wr, int wc, int fr, int fq) const {
        const int rl0 = wr * 64 + fr, col0 = u.pn * BM + wc * 32 + 8 * fq; const int n_e = cnt[u.e];
        const float* bp = bias + (size_t)u.e * D + col0; const float* rw = roww + (size_t)u.e * ECAP + u.lt * BM;
        f32x4 bv[2][2];
#pragma unroll
        for (int bj = 0; bj < 2; ++bj)
#pragma unroll
            for (int n = 0; n < 2; ++n) bv[bj][n] = *(const f32x4*)(bp + bj * HALF + 4 * n);
#pragma unroll
        for (int ai = 0; ai < 2; ++ai)
#pragma unroll
            for (int m = 0; m < 4; ++m) { const int rl = rl0 + ai * HALF + m * 16; const float gw = (u.lt * BM + rl < n_e) ? rw[rl] : 0.f;
                bf16* rowp = DOWN + (size_t)(u.pm * BM + rl) * D + col0;
#pragma unroll
                for (int bj = 0; bj < 2; ++bj) *(u32x4*)(rowp + bj * HALF) = pack8((acc[ai][bj][m][0] + bv[bj][0]) * gw, (acc[ai][bj][m][1] + bv[bj][1]) * gw); }
    }
};
}
__device__ __forceinline__ void unpack8(u32x4 w, f32x4& a, f32x4& b) { pg8::unpack8(w, a, b); }

struct Params { const float* in[38]; float* out; unsigned char* ws; int ph_lo, ph_hi; };
enum { I_X = 0, I_C, I_CTX, I_CCTX, I_WADA, I_BADA, I_WIN, I_BIN, I_SMU, I_CONVW, I_CONVB, I_CLNG, I_CLNB, I_WCO, I_BCO, I_W0, I_W2, I_A0, I_A2, I_G2,
       I_KK, I_KA, I_RK, I_LNXG, I_LNXB, I_WRO, I_WOUT, I_BOUT, I_LN1G, I_LN1B, I_WROUTER, I_BROUTER, I_WGU, I_BGU, I_WDN, I_BDN, I_LN2G, I_LN2B };

struct Ctx { LAS unsigned char* lds; int tid, lane, wave, G, bid, gw, NGW; };

__device__ __forceinline__ void cvt_item(const float* W, int N, int K, int k0, int n0, bf16* WT, int drow0, int lane) {
    const int ko = lane & 7, ng = lane >> 3;
    const float* src = W + (size_t)(k0 + 8 * ko) * N + n0 + 4 * ng;
    f32x4 v[8];
#pragma unroll
    for (int j = 0; j < 8; ++j) v[j] = *(const f32x4*)(src + (size_t)j * N);
#pragma unroll
    for (int jn = 0; jn < 4; ++jn) { u32x4 o; o.x = cvt_pk_bf16(v[0][jn], v[1][jn]); o.y = cvt_pk_bf16(v[2][jn], v[3][jn]); o.z = cvt_pk_bf16(v[4][jn], v[5][jn]); o.w = cvt_pk_bf16(v[6][jn], v[7][jn]);
        *(u32x4*)(WT + (size_t)(drow0 + 4 * ng + jn) * K + k0 + 8 * ko) = o; }
}
__device__ __forceinline__ void p0_convert(const Params& p, const Ctx& c) {
    unsigned char* ws = p.ws;
    constexpr int I_IN = 32 * 301, I_CO = 16 * 64, I_RO = 16 * 64, I_OUT = 32 * 64, I_GU1 = 32 * 128, I_GU = NE * I_GU1, I_DN1 = 32 * 64, I_DN = NE * I_DN1;
    constexpr int NITEMS = I_IN + I_CO + I_RO + I_OUT + I_GU + I_DN;
    for (int it = c.gw; it < NITEMS; it += c.NGW) {
        int r = it;
        if (r < I_IN) { const int kb = r / 301, nb = r % 301, n0 = 32 * nb; cvt_item(p.in[I_WIN], PIN, D, 64 * kb, n0, (bf16*)(ws + WS_WIN), n0 < 5536 ? n0 : n0 + 96, c.lane); continue; } r -= I_IN;
        if (r < I_CO) { const int kb = r / 64, nb = r % 64; cvt_item(p.in[I_WCO], D, DCV, 64 * kb, 32 * nb, (bf16*)(ws + WS_WCO), 32 * nb, c.lane); continue; } r -= I_CO;
        if (r < I_RO) { const int kb = r / 64, nb = r % 64; cvt_item(p.in[I_WRO], D, DR, 64 * kb, 32 * nb, (bf16*)(ws + WS_WRO), 32 * nb, c.lane); continue; } r -= I_RO;
        if (r < I_OUT) { const int kb = r / 64, nb = r % 64; cvt_item(p.in[I_WOUT], D, D, 64 * kb, 32 * nb, (bf16*)(ws + WS_WOUT), 32 * nb, c.lane); continue; } r -= I_OUT;
        if (r < I_GU) { const int e = r / I_GU1, q = r % I_GU1, kb = q / 128, nb = q % 128, n0 = 32 * nb; const int nn = n0 & 2047;
            const int drow = (nn >> 7) * 256 + (n0 >= 2048 ? 128 : 0) + (nn & 127);
            cvt_item(p.in[I_WGU] + (size_t)e * D * 4096, 4096, D, 64 * kb, n0, (bf16*)(ws + WS_WGU) + (size_t)e * 4096 * D, drow, c.lane); continue; } r -= I_GU;
        { const int e = r / I_DN1, q = r % I_DN1, kb = q / 64, nb = q % 64;
            cvt_item(p.in[I_WDN] + (size_t)e * D * D, D, D, 64 * kb, 32 * nb, (bf16*)(ws + WS_WDN) + (size_t)e * D * D, 32 * nb, c.lane); }
    }
}
__device__ __forceinline__ void p0_small(const Params& p, const Ctx& c) {
    unsigned char* ws = p.ws;
    const int gt = c.bid * 512 + c.tid, NT = c.G * 512;
    bf16* WL = (bf16*)(ws + WS_WLORA);
    for (int t = gt; t < LORA_N * (LORA_K / 8); t += NT) {
        const int n = t / (LORA_K / 8), k0 = (t % (LORA_K / 8)) * 8, g = n >> 10, ch = n & 1023; float v[8];
#pragma unroll
        for (int j = 0; j < 8; ++j) { const int k = k0 + j; float x = 0.f;
            if (g < 4) { if (k >= 64 * g && k < 64 * g + 64) { const float* src = (g < 2) ? p.in[I_W2] : p.in[I_A2]; x = src[((size_t)(g & 1) * 64 + (k - 64 * g)) * DR + ch]; } }
            else { if (k >= 256 && k < 416) x = p.in[I_G2][(size_t)(k - 256) * DR + ch]; }
            v[j] = x; }
        u32x4 o; o.x = cvt_pk_bf16(v[0], v[1]); o.y = cvt_pk_bf16(v[2], v[3]); o.z = cvt_pk_bf16(v[4], v[5]); o.w = cvt_pk_bf16(v[6], v[7]);
        *(u32x4*)(WL + (size_t)n * LORA_K + k0) = o;
    }
    bf16* WRt = (bf16*)(ws + WS_WR);
    for (int t = gt; t < NE * D; t += NT) { const int e = t / D, k = t % D; const float w = p.in[I_WROUTER][(size_t)k * NE + e]; const unsigned hi = f2bf(w); const float lo = w - bflo(hi);
        WRt[t] = (bf16)hi; WRt[NE * D + t] = (bf16)f2bf(lo); }
    float* bin = (float*)(ws + WS_BIN);
    for (int t = gt; t < ZN; t += NT) bin[t] = t < 5536 ? p.in[I_BIN][t] : (t < ZG0 ? 0.f : p.in[I_BIN][t - 96]);
    float* bgu = (float*)(ws + WS_BGU);
    for (int t = gt; t < NE * 4096; t += NT) { const int e = t >> 12, q = t & 4095, pn = q >> 8, rr = q & 255; bgu[t] = p.in[I_BGU][(size_t)e * 4096 + (rr < 128 ? 128 * pn + rr : 2048 + 128 * pn + rr - 128)]; }
    bf16* WI = (bf16*)(ws + WS_WIN);
    for (int t = gt; t < 96 * D / 8; t += NT) *(u32x4*)(WI + (size_t)5536 * D + (size_t)t * 8) = (u32x4){0u, 0u, 0u, 0u};
}
__device__ __forceinline__ void p0_adaln(const Params& p, const Ctx& c) {
    LAS float* act = (LAS float*)c.lds; LAS float* red = (LAS float*)(c.lds + 73728);
    for (int i = c.tid; i < 9 * D; i += 512) { const int r = i / D, k = i % D; const float v = r < 8 ? p.in[I_C][r * D + k] : p.in[I_CCTX][k]; act[i] = v * sigm(v); }
    __syncthreads();
    const int cg = c.tid & 15, ks = c.tid >> 4;
    float* mod = (float*)(p.ws + WS_MOD);
    for (int u = c.bid; u < 192; u += c.G) {
        f32x4 acc[9];
#pragma unroll
        for (int r = 0; r < 9; ++r) acc[r] = (f32x4){0.f, 0.f, 0.f, 0.f};
        const float* wp = p.in[I_WADA] + 64 * u + 4 * cg;
#pragma unroll 4
        for (int k = ks; k < D; k += 32) { const f32x4 w = *(const f32x4*)(wp + (size_t)k * (6 * D));
#pragma unroll
            for (int r = 0; r < 9; ++r) acc[r] += w * act[r * D + k]; }
#pragma unroll
        for (int r = 0; r < 9; ++r)
#pragma unroll
            for (int j = 0; j < 4; ++j) { float v = acc[r][j]; v += __shfl_xor(v, 16); v += __shfl_xor(v, 32); acc[r][j] = v; }
        if (c.lane < 16) {
#pragma unroll
            for (int r = 0; r < 9; ++r) *(LAS f32x4*)(red + (c.wave * 9 + r) * 64 + 4 * cg) = acc[r]; }
        __syncthreads();
        for (int i = c.tid; i < 9 * 64; i += 512) { const int r = i / 64, col = i % 64; float s = 0.f;
#pragma unroll
            for (int w = 0; w < 8; ++w) s += red[(w * 9 + r) * 64 + col];
            mod[r * (6 * D) + 64 * u + col] = s + p.in[I_BADA][64 * u + col]; }
        __syncthreads();
    }
}

__device__ __forceinline__ void p1_modulate(const Params& p, const Ctx& c) {
    const float* mod = (const float*)(p.ws + WS_MOD); bf16* U = (bf16*)(p.ws + WS_U);
    for (int row = c.gw; row < TT; row += c.NGW) {
        const float* src = row < TL ? p.in[I_X] + (size_t)row * D : p.in[I_CTX] + (size_t)(row - TL) * D;
        const int b = row < TL ? row / SEQ : 8;
        const float* sh = mod + (size_t)b * (6 * D); const float* sc = sh + D;
        f32x4 v[8]; float s = 0.f;
#pragma unroll
        for (int j = 0; j < 8; ++j) { v[j] = *(const f32x4*)(src + 4 * c.lane + 256 * j); s += (v[j][0] + v[j][1]) + (v[j][2] + v[j][3]); }
        const float mean = wave_sum(s) * (1.f / D); float s2 = 0.f;
#pragma unroll
        for (int j = 0; j < 8; ++j) { v[j] = v[j] - mean; s2 += (v[j][0] * v[j][0] + v[j][1] * v[j][1]) + (v[j][2] * v[j][2] + v[j][3] * v[j][3]); }
        const float rstd = __builtin_amdgcn_rsqf(wave_sum(s2) * (1.f / D) + LN_EPS);
#pragma unroll
        for (int j = 0; j < 8; ++j) { const int col = 4 * c.lane + 256 * j; const f32x4 a = *(const f32x4*)(sc + col), bb = *(const f32x4*)(sh + col);
            const f32x4 o = v[j] * rstd * (a + 1.0f) + bb; u32x2 w; w.x = cvt_pk_bf16(o[0], o[1]); w.y = cvt_pk_bf16(o[2], o[3]);
            *(u32x2*)(U + (size_t)row * D + col) = w; }
    }
}

__device__ __forceinline__ void p3_conv(const Params& p, const Ctx& c) {
    const bf16* ZL = (const bf16*)(p.ws + WS_ZL); bf16* AC = (bf16*)(p.ws + WS_ACONV);
    LAS unsigned* tile = (LAS unsigned*)c.lds;
    for (int gr = c.bid; gr < TL / 64; gr += c.G) {
        const int row0 = gr * 64, c0 = 2 * c.tid;
#pragma unroll 4
        for (int i = 0; i < 16; ++i) { const int ch = c.tid + 512 * i, t = ch >> 7, cg = ch & 127;
            f32x4 a0, a1, g0, g1; unpack8(*(const u32x4*)(ZL + (size_t)(row0 + t) * ZN + 8 * cg), a0, a1); unpack8(*(const u32x4*)(ZL + (size_t)(row0 + t) * ZN + DCV + 8 * cg), g0, g1);
            *(LAS u32x4*)(tile + t * 512 + 4 * cg) = pg8::pack8(a0 * pg8::sig4(g0), a1 * pg8::sig4(g1)); }
        __syncthreads();
#pragma unroll 1
        for (int cc = 0; cc < 2; ++cc) {
            float w[CWID];
#pragma unroll
            for (int j = 0; j < CWID; ++j) w[j] = p.in[I_CONVW][j * DCV + c0 + cc];
            const float cb = p.in[I_CONVB][c0 + cc];
            float h[64];
#pragma unroll
            for (int t = 0; t < 64; ++t) { const unsigned a = tile[t * 512 + c.tid]; h[t] = cc ? bfhi(a) : bflo(a); }
#pragma clang loop unroll(full)
            for (int t = 0; t < 64; ++t) { float a = cb;
#pragma clang loop unroll(full)
                for (int j = 0; j < CWID; ++j) { const int tt = t + j - CWID / 2; if (tt >= 0 && tt < 64) a += w[j] * h[tt]; }
                ((LAS bf16*)tile)[t * DCV + c0 + cc] = (bf16)f2bf(a); }
        }
        __syncthreads();
        f32x4 g[4], bb[4];
#pragma unroll
        for (int q = 0; q < 4; ++q) { g[q] = *(const f32x4*)(p.in[I_CLNG] + 16 * c.lane + 4 * q); bb[q] = *(const f32x4*)(p.in[I_CLNB] + 16 * c.lane + 4 * q); }
#pragma unroll 2
        for (int i = 0; i < 8; ++i) { const int t = c.wave * 8 + i;
            const u32x4 r0 = *(const LAS u32x4*)(tile + t * 512 + 8 * c.lane), r1 = *(const LAS u32x4*)(tile + t * 512 + 8 * c.lane + 4);
            f32x4 v[4]; unpack8(r0, v[0], v[1]); unpack8(r1, v[2], v[3]);
            float s = 0.f;
#pragma unroll
            for (int q = 0; q < 4; ++q) s += (v[q][0] + v[q][1]) + (v[q][2] + v[q][3]);
            const float mean = wave_sum(s) * (1.f / DCV); float s2 = 0.f;
#pragma unroll
            for (int q = 0; q < 4; ++q) { v[q] = v[q] - mean; s2 += (v[q][0] * v[q][0] + v[q][1] * v[q][1]) + (v[q][2] * v[q][2] + v[q][3] * v[q][3]); }
            const float rstd = __builtin_amdgcn_rsqf(wave_sum(s2) * (1.f / DCV) + LN_EPS);
#pragma unroll
            for (int q = 0; q < 4; ++q) { v[q] = v[q] * rstd * g[q] + bb[q];
#pragma unroll
                for (int j = 0; j < 4; ++j) v[q][j] = v[q][j] * sigm(v[q][j]); }
            bf16* o = AC + (size_t)(row0 + t) * DCV + 16 * c.lane;
            *(u32x4*)o = pg8::pack8(v[0], v[1]); *(u32x4*)(o + 8) = pg8::pack8(v[2], v[3]); }
        __syncthreads();
    }
}
__device__ __forceinline__ void p3_alora(const Params& p, const Ctx& c) {
    const bf16* ZL = (const bf16*)(p.ws + WS_ZL); const bf16* ZC = (const bf16*)(p.ws + WS_ZC); bf16* AL = (bf16*)(p.ws + WS_ALORA);
    const float* mu = p.in[I_SMU];
    for (int row = c.gw; row < TT; row += c.NGW) {
        const bool lat = row < TL; const int pitch = lat ? ZN : ZCN; const int len = lat ? SEQ : CTXL; const int t = lat ? row % SEQ : (row - TL) % CTXL;
        const bf16* zp = lat ? ZL + (size_t)row * ZN + ZR0 : ZC + (size_t)(row - TL) * ZCN;
        const bool hp = t > 0, hn = t < len - 1;
#pragma unroll
        for (int i = 0; i < 8; ++i) { const int j = c.lane + 64 * i; float o = 0.f;
            if (j < 416) { const int col = 3072 + j; const float z = bf1(zp[col]); const float pv = hp ? bf1(zp[col - pitch]) : 0.f, nv = hn ? bf1(zp[col + pitch]) : 0.f;
                const float zs = z + mu[col] * (pv - z) + mu[DSHIFT + col] * (nv - z);
                o = j < 128 ? (1.f - 2.f * __builtin_amdgcn_rcpf(__expf(2.f * zs) + 1.f)) : (j < 256 ? zs : sigm(zs)); }
            AL[(size_t)row * LORA_K + j] = (bf16)f2bf(o); }
    }
}

__device__ __forceinline__ void p5_prep(const Params& p, const Ctx& c) {
    const bf16* ZL = (const bf16*)(p.ws + WS_ZL); const bf16* ZC = (const bf16*)(p.ws + WS_ZC); const bf16* LO = (const bf16*)(p.ws + WS_LORA);
    unsigned char* SC = p.ws + WS_SC; bf16* VS = (bf16*)(p.ws + WS_VS); float* RK = (float*)(p.ws + WS_RK);
    const float* mu = p.in[I_SMU];
    for (int it = c.gw; it < NB * NH * NOCT; it += c.NGW) {
        const int oct = it % NOCT, bh = it / NOCT, h = bh % NH, b = bh / NH, hc = h * HS + c.lane;
        const bool lat = oct >= 32; const int pitch = lat ? ZN : ZCN, len = lat ? SEQ : CTXL, t0 = lat ? (oct - 32) * 8 : oct * 8;
        const size_t rowbase = lat ? (size_t)b * SEQ + t0 : (size_t)b * CTXL + t0;
        const bf16* zp = lat ? ZL + rowbase * ZN + ZR0 : ZC + rowbase * ZCN;
        const size_t lrow = lat ? rowbase : (size_t)TL + rowbase;
        const float mpr = mu[hc], mnr = mu[DSHIFT + hc], mpk = mu[DR + hc], mnk = mu[DSHIFT + DR + hc], mpv = mu[2 * DR + hc], mnv = mu[DSHIFT + 2 * DR + hc];
        const float kk_ = p.in[I_KK][hc], ka_ = p.in[I_KA][hc], rk_ = p.in[I_RK][hc];
        const float w00 = p.in[I_W0][hc], w01 = p.in[I_W0][DR + hc], a00 = p.in[I_A0][hc], a01 = p.in[I_A0][DR + hc];
        float zr[10], zk[10], zv[10];
#pragma unroll
        for (int i = 0; i < 10; ++i) { const int t = t0 - 1 + i; const bool ok = t >= 0 && t < len; const bf16* q = zp + (ptrdiff_t)(i - 1) * pitch;
            zr[i] = ok ? bf1(q[hc]) : 0.f; zk[i] = ok ? bf1(q[DR + hc]) : 0.f; zv[i] = ok ? bf1(q[2 * DR + hc]) : 0.f; }
        float o_r[8], o_v[8], o_na[8], o_w[2][8], o_b[2][8], o_kd[2][8];
#pragma unroll
        for (int i = 0; i < 8; ++i) {
            const float r = zr[i + 1] + mpr * (zr[i] - zr[i + 1]) + mnr * (zr[i + 2] - zr[i + 1]);
            const float k = zk[i + 1] + mpk * (zk[i] - zk[i + 1]) + mnk * (zk[i + 2] - zk[i + 1]);
            const float v = zv[i + 1] + mpv * (zv[i] - zv[i + 1]) + mnv * (zv[i + 2] - zv[i + 1]);
            const float kr = k * kk_; const float nrm = sqrtf(wave_sum(kr * kr)); const float kk = kr / fmaxf(nrm, 1e-12f);
            const bf16* lp = LO + (lrow + i) * LORA_N + hc;
            const float wl0 = bf1(lp[0]), wl1 = bf1(lp[DR]), al0 = bf1(lp[2 * DR]), al1 = bf1(lp[3 * DR]);
            const float aa0 = sigm(a00 + al0), aa1 = sigm(a01 + al1);
            o_r[i] = r; o_v[i] = v; o_na[i] = -kk;
            o_w[0][i] = __expf(-0.6065306597f * sigm(w00 + wl0)); o_w[1][i] = __expf(-0.6065306597f * sigm(w01 + wl1));
            o_b[0][i] = kk * aa0; o_b[1][i] = kk * aa1;
            o_kd[0][i] = k * (1.f + (aa0 - 1.f) * ka_); o_kd[1][i] = k * (1.f + (aa1 - 1.f) * ka_);
            if (lat) { const float s = wave_sum(r * (o_kd[0][i] + o_kd[1][i]) * rk_); if (c.lane == 0) RK[(rowbase + i) * NH + h] = s;
                VS[(rowbase + i) * DR + hc] = (bf16)f2bf(v); }
        }
        unsigned char* rec = SC + (size_t)it * SC_REC;
        auto pk = [](const float (&x)[8]) { u32x4 o; o.x = cvt_pk_bf16(x[0], x[1]); o.y = cvt_pk_bf16(x[2], x[3]); o.z = cvt_pk_bf16(x[4], x[5]); o.w = cvt_pk_bf16(x[6], x[7]); return o; };
        *(u32x4*)(rec + 0 + 16 * c.lane) = pk(o_r); *(u32x4*)(rec + 1024 + 16 * c.lane) = pk(o_v); *(u32x4*)(rec + 2048 + 16 * c.lane) = pk(o_na);
#pragma unroll
        for (int d = 0; d < 2; ++d) { unsigned char* dr = rec + 3072 + 4096 * d;
            *(f32x4*)(dr + 32 * c.lane) = (f32x4){o_w[d][0], o_w[d][1], o_w[d][2], o_w[d][3]}; *(f32x4*)(dr + 32 * c.lane + 16) = (f32x4){o_w[d][4], o_w[d][5], o_w[d][6], o_w[d][7]};
            *(u32x4*)(dr + 2048 + 16 * c.lane) = pk(o_b[d]); *(u32x4*)(dr + 3072 + 16 * c.lane) = pk(o_kd[d]); }
    }
}

constexpr int SCH = 16, SBUF = SCH * 1280 + 256, SNB = 3, S_FULL = SNB * SBUF, S_DONE = S_FULL + 64;
struct RawOct { u32x4 r, v, na, b, kd; f32x4 w0, w1; };
__device__ __forceinline__ RawOct scan_load(const unsigned char* SCb, int p, int d, int lane) {
    const int oct = d == 0 ? p : (p < 32 ? 31 - p : 319 - p);
    const unsigned char* rec = SCb + (size_t)oct * SC_REC; const unsigned char* dr = rec + 3072 + 4096 * d;
    RawOct o; o.r = *(const u32x4*)(rec + 16 * lane); o.v = *(const u32x4*)(rec + 1024 + 16 * lane); o.na = *(const u32x4*)(rec + 2048 + 16 * lane);
    o.w0 = *(const f32x4*)(dr + 32 * lane); o.w1 = *(const f32x4*)(dr + 32 * lane + 16); o.b = *(const u32x4*)(dr + 2048 + 16 * lane); o.kd = *(const u32x4*)(dr + 3072 + 16 * lane);
    return o;
}
__device__ __forceinline__ float dpp_xor1(float x) { return __builtin_bit_cast(float, __builtin_amdgcn_update_dpp(0, __builtin_bit_cast(int, x), 0xB1, 0xf, 0xf, true)); }
__device__ __forceinline__ float dpp_xor2(float x) { return __builtin_bit_cast(float, __builtin_amdgcn_update_dpp(0, __builtin_bit_cast(int, x), 0x4E, 0xf, 0xf, true)); }
__device__ __forceinline__ float dpp_hmir(float x) { return __builtin_bit_cast(float, __builtin_amdgcn_update_dpp(0, __builtin_bit_cast(int, x), 0x141, 0xf, 0xf, true)); }
__device__ __forceinline__ float red8(float x) { x += dpp_xor1(x); x += dpp_xor2(x); x += dpp_hmir(x); return x; }

__device__ __forceinline__ void p6_scan(const Params& p, const Ctx& c) {
    LAS unsigned char* L = c.lds; volatile LAS unsigned* full = (volatile LAS unsigned*)(L + S_FULL); volatile LAS unsigned* done = (volatile LAS unsigned*)(L + S_DONE);
    float* Y = (float*)(p.ws + WS_Y);
    for (int sid = c.bid; sid < NB * NH * 2; sid += c.G) {
        if (c.tid < 8) { full[c.tid] = 0u; done[c.tid] = 0u; }
        __syncthreads();
        const int d = sid & 1, bh = sid >> 1, h = bh % NH, b = bh / NH;
        constexpr int NCH = (CTXL + SEQ) / SCH;
        if (c.wave == 4) {
            const unsigned char* SCb = p.ws + WS_SC + (size_t)bh * NOCT * SC_REC;
            RawOct ring[4];
#pragma unroll
            for (int j = 0; j < 4; ++j) ring[j] = scan_load(SCb, j, d, c.lane);
            float gam = 1.f;
            for (int p0 = 0; p0 < NOCT; p0 += 4) {
#pragma unroll
                for (int j = 0; j < 4; ++j) {
                    const int pp = p0 + j, ch = pp >> 1, oi = pp & 1, buf = ch % SNB;
                    if (oi == 0 && ch >= SNB) { const unsigned want = 4u * (unsigned)(ch / SNB); unsigned sp = 0; while (done[buf] < want) { __builtin_amdgcn_s_sleep(1); if (++sp > (1u << 24)) break; } }
                    const RawOct o = ring[j];
                    if (pp + 4 < NOCT) ring[j] = scan_load(SCb, pp + 4, d, c.lane);
                    const unsigned rr[4] = {o.r.x, o.r.y, o.r.z, o.r.w}, vv[4] = {o.v.x, o.v.y, o.v.z, o.v.w}, nn[4] = {o.na.x, o.na.y, o.na.z, o.na.w}, bb[4] = {o.b.x, o.b.y, o.b.z, o.b.w}, kk[4] = {o.kd.x, o.kd.y, o.kd.z, o.kd.w};
                    const float ww[8] = {o.w0[0], o.w0[1], o.w0[2], o.w0[3], o.w1[0], o.w1[1], o.w1[2], o.w1[3]};
                    LAS float* dst = (LAS float*)(L + buf * SBUF + oi * 8 * 1280) + c.lane;
#pragma unroll
                    for (int i = 0; i < 8; ++i) {
                        const int ia = i, ib = 7 - i;
                        const float r_ = d ? ((ib & 1) ? bfhi(rr[ib >> 1]) : bflo(rr[ib >> 1])) : ((ia & 1) ? bfhi(rr[ia >> 1]) : bflo(rr[ia >> 1]));
                        const float v_ = d ? ((ib & 1) ? bfhi(vv[ib >> 1]) : bflo(vv[ib >> 1])) : ((ia & 1) ? bfhi(vv[ia >> 1]) : bflo(vv[ia >> 1]));
                        const float n_ = d ? ((ib & 1) ? bfhi(nn[ib >> 1]) : bflo(nn[ib >> 1])) : ((ia & 1) ? bfhi(nn[ia >> 1]) : bflo(nn[ia >> 1]));
                        const float b_ = d ? ((ib & 1) ? bfhi(bb[ib >> 1]) : bflo(bb[ib >> 1])) : ((ia & 1) ? bfhi(bb[ia >> 1]) : bflo(bb[ia >> 1]));
                        const float k_ = d ? ((ib & 1) ? bfhi(kk[ib >> 1]) : bflo(kk[ib >> 1])) : ((ia & 1) ? bfhi(kk[ia >> 1]) : bflo(kk[ia >> 1]));
                        const float w_ = d ? ww[ib] : ww[ia];
                        const float gprev = gam; gam *= w_; const float inv = __builtin_amdgcn_rcpf(gam);
                        LAS float* s = dst + i * 320;
                        s[0] = gprev * n_; s[64] = b_ * inv; s[128] = k_ * inv; s[192] = gam * r_; s[256] = v_;
                    }
                    if (oi == 1) { ((LAS float*)(L + buf * SBUF + SCH * 1280))[c.lane] = gam; gam = 1.f;
                        asm volatile("s_waitcnt lgkmcnt(0)" ::: "memory");
                        if (c.lane == 0) full[buf] = (unsigned)(ch + 1); }
                }
            }
        } else if (c.wave < 4) {
            const int vp = c.lane >> 3, q = c.lane & 7, v0 = 16 * c.wave + 2 * vp;
            float S0[8], S1[8];
#pragma unroll
            for (int j = 0; j < 8; ++j) { S0[j] = 0.f; S1[j] = 0.f; }
            for (int ch = 0; ch < NCH; ++ch) {
                const int buf = ch % SNB; { unsigned sp = 0; while (full[buf] != (unsigned)(ch + 1)) { __builtin_amdgcn_s_sleep(1); if (++sp > (1u << 24)) break; } }
                const LAS unsigned char* base = L + buf * SBUF;
                const bool lat = ch >= CTXL / SCH;
#pragma unroll 4
                for (int s = 0; s < SCH; ++s) {
                    const LAS unsigned char* sb = base + s * 1280 + 32 * q;
                    const f32x4 a0 = *(const LAS f32x4*)(sb), a1 = *(const LAS f32x4*)(sb + 16), b0 = *(const LAS f32x4*)(sb + 256), b1 = *(const LAS f32x4*)(sb + 272);
                    const f32x4 k0 = *(const LAS f32x4*)(sb + 512), k1 = *(const LAS f32x4*)(sb + 528), r0 = *(const LAS f32x4*)(sb + 768), r1 = *(const LAS f32x4*)(sb + 784);
                    const f32x2 vv = *(const LAS f32x2*)(base + s * 1280 + 1024 + 4 * v0);
                    const float A[8] = {a0[0], a0[1], a0[2], a0[3], a1[0], a1[1], a1[2], a1[3]}, Bc[8] = {b0[0], b0[1], b0[2], b0[3], b1[0], b1[1], b1[2], b1[3]};
                    const float Kc[8] = {k0[0], k0[1], k0[2], k0[3], k1[0], k1[1], k1[2], k1[3]}, Rc[8] = {r0[0], r0[1], r0[2], r0[3], r1[0], r1[1], r1[2], r1[3]};
                    float p0 = 0.f, p1 = 0.f;
#pragma unroll
                    for (int j = 0; j < 8; ++j) { p0 += S0[j] * A[j]; p1 += S1[j] * A[j]; }
                    p0 = red8(p0); p1 = red8(p1);
#pragma unroll
                    for (int j = 0; j < 8; ++j) { S0[j] += p0 * Bc[j] + vv[0] * Kc[j]; S1[j] += p1 * Bc[j] + vv[1] * Kc[j]; }
                    if (lat) { float y0 = 0.f, y1 = 0.f;
#pragma unroll
                        for (int j = 0; j < 8; ++j) { y0 += S0[j] * Rc[j]; y1 += S1[j] * Rc[j]; }
                        y0 = red8(y0); y1 = red8(y1);
                        if (q == 0) { const int P = ch * SCH + s - CTXL; const int t = d == 0 ? P : SEQ - 1 - P;
                            *(f32x2*)(Y + ((size_t)d * TL + (size_t)b * SEQ + t) * DR + h * HS + v0) = (f32x2){y0, y1}; } }
                }
                const f32x4 g0 = *(const LAS f32x4*)(base + SCH * 1280 + 32 * q), g1 = *(const LAS f32x4*)(base + SCH * 1280 + 32 * q + 16);
                const float Gm[8] = {g0[0], g0[1], g0[2], g0[3], g1[0], g1[1], g1[2], g1[3]};
#pragma unroll
                for (int j = 0; j < 8; ++j) { S0[j] *= Gm[j]; S1[j] *= Gm[j]; }
                asm volatile("s_waitcnt lgkmcnt(0)" ::: "memory");
                if (c.lane == 0) __hip_atomic_fetch_add((LAS unsigned*)(L + S_DONE) + buf, 1u, __ATOMIC_RELAXED, __HIP_MEMORY_SCOPE_WORKGROUP);
            }
        }
        __syncthreads();
    }
}

__device__ __forceinline__ void p7_rwkvout(const Params& p, const Ctx& c) {
    const float* Y = (const float*)(p.ws + WS_Y); const float* RK = (const float*)(p.ws + WS_RK); const bf16* VS = (const bf16*)(p.ws + WS_VS);
    const bf16* LO = (const bf16*)(p.ws + WS_LORA); bf16* AR = (bf16*)(p.ws + WS_ARWKV);
    const int c0 = 16 * c.lane, hd = c.lane >> 2;
    f32x4 g[4], bb[4];
#pragma unroll
    for (int q = 0; q < 4; ++q) { g[q] = *(const f32x4*)(p.in[I_LNXG] + c0 + 4 * q); bb[q] = *(const f32x4*)(p.in[I_LNXB] + c0 + 4 * q); }
    for (int row = c.gw; row < TL; row += c.NGW) {
        f32x4 y[4]; float s = 0.f;
#pragma unroll
        for (int q = 0; q < 4; ++q) { y[q] = *(const f32x4*)(Y + (size_t)row * DR + c0 + 4 * q) + *(const f32x4*)(Y + ((size_t)TL + row) * DR + c0 + 4 * q); s += (y[q][0] + y[q][1]) + (y[q][2] + y[q][3]); }
        s += __shfl_xor(s, 1); s += __shfl_xor(s, 2); const float mean = s * (1.f / HS); float s2 = 0.f;
#pragma unroll
        for (int q = 0; q < 4; ++q) { y[q] = y[q] - mean; s2 += (y[q][0] * y[q][0] + y[q][1] * y[q][1]) + (y[q][2] * y[q][2] + y[q][3] * y[q][3]); }
        s2 += __shfl_xor(s2, 1); s2 += __shfl_xor(s2, 2); const float rstd = __builtin_amdgcn_rsqf(s2 * (1.f / HS) + GN_EPS);
        const float rk = RK[(size_t)row * NH + hd];
        f32x4 v[4], gt[4];
        unpack8(*(const u32x4*)(VS + (size_t)row * DR + c0), v[0], v[1]); unpack8(*(const u32x4*)(VS + (size_t)row * DR + c0 + 8), v[2], v[3]);
        unpack8(*(const u32x4*)(LO + (size_t)row * LORA_N + 4 * DR + c0), gt[0], gt[1]); unpack8(*(const u32x4*)(LO + (size_t)row * LORA_N + 4 * DR + c0 + 8), gt[2], gt[3]);
#pragma unroll
        for (int q = 0; q < 4; ++q) y[q] = (y[q] * rstd * g[q] + bb[q] + v[q] * rk) * gt[q];
        bf16* o = AR + (size_t)row * DR + c0; *(u32x4*)o = pg8::pack8(y[0], y[1]); *(u32x4*)(o + 8) = pg8::pack8(y[2], y[3]);
    }
}

__device__ __forceinline__ void p10_router(const Params& p, const Ctx& c) {
    const float* T1 = (const float*)(p.ws + WS_T1); float* XM = (float*)(p.ws + WS_XMID); bf16* UH = (bf16*)(p.ws + WS_U2HI); bf16* UL = (bf16*)(p.ws + WS_U2LO);
    const float* mod = (const float*)(p.ws + WS_MOD); const bf16* WRt = (const bf16*)(p.ws + WS_WR);
    unsigned* cntg = (unsigned*)(p.ws + WS_CTL) + CW_CNT; int* rowtok = (int*)(p.ws + WS_ROWTOK); float* roww = (float*)(p.ws + WS_ROWW); unsigned* sel = (unsigned*)(p.ws + WS_SEL);
    for (int un = c.bid; un < TL / 64; un += c.G) {
        const int r0 = un * 64, b = r0 / SEQ;
        const float* sh = mod + (size_t)b * (6 * D) + 3 * D; const float* sc = sh + D;
        for (int i = 0; i < 8; ++i) { const int row = r0 + c.wave * 8 + i;
            f32x4 v[8]; float s = 0.f;
#pragma unroll
            for (int j = 0; j < 8; ++j) { v[j] = *(const f32x4*)(T1 + (size_t)row * D + 4 * c.lane + 256 * j); s += (v[j][0] + v[j][1]) + (v[j][2] + v[j][3]); }
            float mean = wave_sum(s) * (1.f / D), s2 = 0.f;
#pragma unroll
            for (int j = 0; j < 8; ++j) { v[j] = v[j] - mean; s2 += (v[j][0] * v[j][0] + v[j][1] * v[j][1]) + (v[j][2] * v[j][2] + v[j][3] * v[j][3]); }
            float rstd = __builtin_amdgcn_rsqf(wave_sum(s2) * (1.f / D) + LN_EPS); s = 0.f;
#pragma unroll
            for (int j = 0; j < 8; ++j) { const int col = 4 * c.lane + 256 * j; v[j] = v[j] * rstd * *(const f32x4*)(p.in[I_LN1G] + col) + *(const f32x4*)(p.in[I_LN1B] + col);
                *(f32x4*)(XM + (size_t)row * D + col) = v[j]; s += (v[j][0] + v[j][1]) + (v[j][2] + v[j][3]); }
            mean = wave_sum(s) * (1.f / D); s2 = 0.f;
#pragma unroll
            for (int j = 0; j < 8; ++j) { v[j] = v[j] - mean; s2 += (v[j][0] * v[j][0] + v[j][1] * v[j][1]) + (v[j][2] * v[j][2] + v[j][3] * v[j][3]); }
            rstd = __builtin_amdgcn_rsqf(wave_sum(s2) * (1.f / D) + LN_EPS);
#pragma unroll
            for (int j = 0; j < 8; ++j) { const int col = 4 * c.lane + 256 * j; const f32x4 o = v[j] * rstd * (*(const f32x4*)(sc + col) + 1.0f) + *(const f32x4*)(sh + col);
                u32x2 hi; hi.x = cvt_pk_bf16(o[0], o[1]); hi.y = cvt_pk_bf16(o[2], o[3]);
                u32x2 lo; lo.x = cvt_pk_bf16(o[0] - bflo(hi.x), o[1] - bfhi(hi.x)); lo.y = cvt_pk_bf16(o[2] - bflo(hi.y), o[3] - bfhi(hi.y));
                *(u32x2*)(UH + (size_t)row * D + col) = hi; *(u32x2*)(UL + (size_t)row * D + col) = lo; }
        }
        asm volatile("s_waitcnt vmcnt(0)" ::: "memory");
        __syncthreads();
        if (c.wave < 4) {
            const int tr = r0 + 16 * c.wave + (c.lane & 15), kq = 8 * (c.lane >> 4);
            f32x4 acc0 = (f32x4){0.f, 0.f, 0.f, 0.f}, acc1 = acc0;
            const bf16* ah = UH + (size_t)tr * D + kq; const bf16* al = UL + (size_t)tr * D + kq;
            const bf16* bh0 = WRt + (size_t)(c.lane & 15) * D + kq; const bf16* bh1 = bh0 + 16 * D; const bf16* bl0 = bh0 + NE * D; const bf16* bl1 = bl0 + 16 * D;
#pragma unroll 4
            for (int s = 0; s < D / 32; ++s) {
                const bf16x8 xh = *(const bf16x8*)(ah + 32 * s), xl = *(const bf16x8*)(al + 32 * s);
                const bf16x8 wh0 = *(const bf16x8*)(bh0 + 32 * s), wh1 = *(const bf16x8*)(bh1 + 32 * s), wl0 = *(const bf16x8*)(bl0 + 32 * s), wl1 = *(const bf16x8*)(bl1 + 32 * s);
                acc0 = __builtin_amdgcn_mfma_f32_16x16x32_bf16(xh, wh0, acc0, 0, 0, 0); acc1 = __builtin_amdgcn_mfma_f32_16x16x32_bf16(xh, wh1, acc1, 0, 0, 0);
                acc0 = __builtin_amdgcn_mfma_f32_16x16x32_bf16(xl, wh0, acc0, 0, 0, 0); acc1 = __builtin_amdgcn_mfma_f32_16x16x32_bf16(xl, wh1, acc1, 0, 0, 0);
                acc0 = __builtin_amdgcn_mfma_f32_16x16x32_bf16(xh, wl0, acc0, 0, 0, 0); acc1 = __builtin_amdgcn_mfma_f32_16x16x32_bf16(xh, wl1, acc1, 0, 0, 0);
            }
            LAS float* lg = (LAS float*)(c.lds + c.wave * 2048);
            const float br0 = p.in[I_BROUTER][c.lane & 15], br1 = p.in[I_BROUTER][16 + (c.lane & 15)];
#pragma unroll
            for (int i = 0; i < 4; ++i) { const int tk = (c.lane >> 4) * 4 + i; lg[tk * 32 + (c.lane & 15)] = acc0[i] + br0; lg[tk * 32 + 16 + (c.lane & 15)] = acc1[i] + br1; }
            asm volatile("s_waitcnt lgkmcnt(0)" ::: "memory");
            if (c.lane < 16) {
                float l[32];
#pragma unroll
                for (int q = 0; q < 8; ++q) { const f32x4 t = *(const LAS f32x4*)(lg + c.lane * 32 + 4 * q); l[4 * q] = t[0]; l[4 * q + 1] = t[1]; l[4 * q + 2] = t[2]; l[4 * q + 3] = t[3]; }
                unsigned used = 0u; float tv[4]; int ti[4];
#pragma unroll
                for (int s = 0; s < 4; ++s) { float best = -3.0e38f; int bi = 0;
#pragma unroll
                    for (int e = 0; e < 32; ++e) { const bool ok = !((used >> e) & 1u) && (l[e] > best); best = ok ? l[e] : best; bi = ok ? e : bi; }
                    used |= 1u << bi; tv[s] = best; ti[s] = bi; }
                const float e1 = __expf(tv[1] - tv[0]), e2 = __expf(tv[2] - tv[0]), e3 = __expf(tv[3] - tv[0]); const float inv = 1.f / (1.f + e1 + e2 + e3);
                const float gw[4] = {inv, e1 * inv, e2 * inv, e3 * inv};
                const int row = r0 + 16 * c.wave + c.lane;
#pragma unroll
                for (int s = 0; s < 4; ++s) { const unsigned j = __hip_atomic_fetch_add(cntg + 16 * ti[s], 1u, RLX_AGENT);
                    rowtok[(size_t)ti[s] * ECAP + j] = row; roww[(size_t)ti[s] * ECAP + j] = gw[s]; sel[row * 4 + s] = ((unsigned)ti[s] << 16) | j; }
            }
        }
        __syncthreads();
    }
}
__device__ __forceinline__ void moe_plan(const Params& p, const Ctx& c) {
    LAS int* cnt = (LAS int*)(c.lds + LX_CNT); LAS int* tst = (LAS int*)(c.lds + LX_TST); LAS unsigned char* te = (LAS unsigned char*)(c.lds + LX_TE);
    const unsigned* cntg = (const unsigned*)(p.ws + WS_CTL) + CW_CNT;
    __syncthreads();
    if (c.tid < NE) cnt[c.tid] = (int)__hip_atomic_load(cntg + 16 * c.tid, RLX_AGENT);
    __syncthreads();
    if (c.tid == 0) { int a = 0; for (int e = 0; e < NE; ++e) { tst[e] = a; a += (cnt[e] + 255) >> 8; } tst[NE] = a; }
    __syncthreads();
    if (c.tid < NE) { for (int t = tst[c.tid]; t < tst[c.tid + 1]; ++t) te[t] = (unsigned char)c.tid; }
    __syncthreads();
}
__device__ __forceinline__ void p13_final(const Params& p, const Ctx& c) {
    const float* XM = (const float*)(p.ws + WS_XMID); const bf16* DN = (const bf16*)(p.ws + WS_DOWN); const unsigned* sel = (const unsigned*)(p.ws + WS_SEL);
    const float* mod = (const float*)(p.ws + WS_MOD); const LAS int* tst = (const LAS int*)(c.lds + LX_TST);
    for (int row = c.gw; row < TL; row += c.NGW) {
        const int b = row / SEQ; const float* gate = mod + (size_t)b * (6 * D) + 5 * D;
        f32x4 a[4][2];
#pragma unroll
        for (int j = 0; j < 4; ++j) { a[j][0] = (f32x4){0.f, 0.f, 0.f, 0.f}; a[j][1] = a[j][0]; }
#pragma unroll
        for (int s = 0; s < 4; ++s) { const unsigned sv = sel[row * 4 + s]; const int e = (int)(sv >> 16), jj = (int)(sv & 0xffffu); const size_t pos = (size_t)tst[e] * 256 + jj;
#pragma unroll
            for (int j = 0; j < 4; ++j) { f32x4 x0, x1; pg8::unpack8(*(const u32x4*)(DN + pos * D + 8 * c.lane + 512 * j), x0, x1); a[j][0] += x0; a[j][1] += x1; } }
        float s = 0.f;
#pragma unroll
        for (int j = 0; j < 4; ++j)
#pragma unroll
            for (int hh = 0; hh < 2; ++hh) { const int col = 8 * c.lane + 512 * j + 4 * hh; a[j][hh] = *(const f32x4*)(XM + (size_t)row * D + col) * DN_ALPHA + *(const f32x4*)(gate + col) * a[j][hh];
                s += (a[j][hh][0] + a[j][hh][1]) + (a[j][hh][2] + a[j][hh][3]); }
        const float mean = wave_sum(s) * (1.f / D); float s2 = 0.f;
#pragma unroll
        for (int j = 0; j < 4; ++j)
#pragma unroll
            for (int hh = 0; hh < 2; ++hh) { a[j][hh] = a[j][hh] - mean; s2 += (a[j][hh][0] * a[j][hh][0] + a[j][hh][1] * a[j][hh][1]) + (a[j][hh][2] * a[j][hh][2] + a[j][hh][3] * a[j][hh][3]); }
        const float rstd = __builtin_amdgcn_rsqf(wave_sum(s2) * (1.f / D) + LN_EPS);
#pragma unroll
        for (int j = 0; j < 4; ++j)
#pragma unroll
            for (int hh = 0; hh < 2; ++hh) { const int col = 8 * c.lane + 512 * j + 4 * hh;
                *(f32x4*)(p.out + (size_t)row * D + col) = a[j][hh] * rstd * *(const f32x4*)(p.in[I_LN2G] + col) + *(const f32x4*)(p.in[I_LN2B] + col); }
    }
}

constexpr int N_PHASES = 14;
__global__ void __launch_bounds__(512, 2) fwd(Params p) {
    extern __shared__ __attribute__((aligned(16))) unsigned char lds_raw[];
    Ctx c; c.lds = (LAS unsigned char*)lds_raw; c.tid = threadIdx.x; c.lane = c.tid & 63; c.wave = __builtin_amdgcn_readfirstlane(c.tid >> 6);
    c.G = gridDim.x; c.bid = blockIdx.x; c.gw = c.bid * 8 + c.wave; c.NGW = c.G * 8;
    unsigned char* ws = p.ws;
    const int lo = p.ph_lo, hi = p.ph_hi;
    volatile LAS unsigned* MISC = (volatile LAS unsigned*)(c.lds + LX_MISC);
    if (c.tid < 64) MISC[c.tid] = 0u;
    __syncthreads();
    XcdBarrier bar; bar.bar = (unsigned*)(ws + WS_CTL) + CW_BAR; bar.x = 0; bar.st = nullptr;
    if (hi - lo > 1) bar = xcd_barrier_post((unsigned*)(ws + WS_CTL) + CW_BAR, MISC + 8);
#ifndef ONLY_PHASE
#define ONLY_PHASE -1
#endif
#define IN(k) ((ONLY_PHASE < 0 || ONLY_PHASE == (k)) && lo <= (k) && (k) < hi)
#define SEAM(k) do { if (IN(k) && IN((k) + 1)) xcd_barrier(bar); } while (0)
    LAS unsigned char* ring = c.lds;

    if (IN(0)) { p0_adaln(p, c); p0_small(p, c); p0_convert(p, c); } SEAM(0);
    if (IN(1)) { p1_modulate(p, c); } SEAM(1);
    if (IN(2)) { pg8::InProjSched S{(const bf16*)(ws + WS_U), (const bf16*)(ws + WS_WIN), c.G, c.bid};
        pg8::EpiInProj E{(bf16*)(ws + WS_ZL), (bf16*)(ws + WS_ZC), (const float*)(ws + WS_BIN)};
        pg8::gemm_phase<pg8::EpiInProj, pg8::InProjSched, false>(ring, D, S, E, nullptr); } SEAM(2);
    if (IN(3)) { p3_conv(p, c); p3_alora(p, c); } SEAM(3);
    if (IN(4)) {
        { pg8::PlainSched S{(const bf16*)(ws + WS_ALORA), (const bf16*)(ws + WS_WLORA), LORA_K, TT / 256, LORA_N / 256, c.G, c.bid};
          pg8::EpiBf16Plain E{(bf16*)(ws + WS_LORA), LORA_N, nullptr};
          pg8::gemm_phase<pg8::EpiBf16Plain, pg8::PlainSched, false>(ring, LORA_K, S, E, nullptr); }
        { pg8::PlainSched S{(const bf16*)(ws + WS_ACONV), (const bf16*)(ws + WS_WCO), DCV, TL / 256, D / 256, c.G, c.bid};
          pg8::EpiConvO E{(bf16*)(ws + WS_MIX), (const bf16*)(ws + WS_ZL), p.in[I_BCO]};
          pg8::gemm_phase<pg8::EpiConvO, pg8::PlainSched, false>(ring, DCV, S, E, nullptr); }
    } SEAM(4);
    if (IN(5)) { p5_prep(p, c); } SEAM(5);
    if (IN(6)) { p6_scan(p, c); } SEAM(6);
    if (IN(7)) { p7_rwkvout(p, c); } SEAM(7);
    if (IN(8)) { pg8::PlainSched S{(const bf16*)(ws + WS_ARWKV), (const bf16*)(ws + WS_WRO), DR, TL / 256, D / 256, c.G, c.bid};
        pg8::EpiRwkvO E{(bf16*)(ws + WS_MIX), (const bf16*)(ws + WS_ZL)};
        pg8::gemm_phase<pg8::EpiRwkvO, pg8::PlainSched, false>(ring, DR, S, E, nullptr); } SEAM(8);
    if (IN(9)) { pg8::PlainSched S{(const bf16*)(ws + WS_MIX), (const bf16*)(ws + WS_WOUT), D, TL / 256, D / 256, c.G, c.bid};
        pg8::EpiOut E{(float*)(ws + WS_T1), p.in[I_X], (const float*)(ws + WS_MOD), p.in[I_BOUT]};
        pg8::gemm_phase<pg8::EpiOut, pg8::PlainSched, false>(ring, D, S, E, nullptr); } SEAM(9);
    if (IN(10)) { p10_router(p, c); } SEAM(10);
    if (IN(11)) { moe_plan(p, c);
        pg8::MoeSched S{nullptr, (const bf16*)(ws + WS_WGU), (const int*)(ws + WS_ROWTOK), D, 4096, 16, c.G, c.bid, (const LAS int*)(c.lds + LX_CNT), (const LAS int*)(c.lds + LX_TST), (const LAS unsigned char*)(c.lds + LX_TE)};
        pg8::EpiGateUp E{(bf16*)(ws + WS_HID), (const float*)(ws + WS_BGU)};
        pg8::gemm_phase<pg8::EpiGateUp, pg8::MoeSched, true>(ring, D, S, E, (const char*)(ws + WS_U2HI)); } SEAM(11);
    if (IN(12)) { moe_plan(p, c);
        pg8::MoeSched S{(const bf16*)(ws + WS_HID), (const bf16*)(ws + WS_WDN), (const int*)(ws + WS_ROWTOK), D, D, 8, c.G, c.bid, (const LAS int*)(c.lds + LX_CNT), (const LAS int*)(c.lds + LX_TST), (const LAS unsigned char*)(c.lds + LX_TE)};
        pg8::EpiDown E{(bf16*)(ws + WS_DOWN), p.in[I_BDN], (const float*)(ws + WS_ROWW), (const LAS int*)(c.lds + LX_CNT)};
        pg8::gemm_phase<pg8::EpiDown, pg8::MoeSched, false>(ring, D, S, E, nullptr); } SEAM(12);
    if (IN(13)) { moe_plan(p, c); p13_final(p, c); }
#undef IN
#undef SEAM
}

extern "C" void kernel_launch(void* const* d_in, const int* in_sizes, int n_in, void* d_out, int out_size, void* d_ws, size_t ws_size, hipStream_t stream) {
    static int grid = 0;
    if (grid == 0) {
        if (n_in != 38 || out_size != TL * D || ws_size < WS_END) { fprintf(stderr, "kernel_launch: unexpected shapes: n_in %d out %d ws %zu (need %zu)\n", n_in, out_size, ws_size, (size_t)WS_END); grid = -1; return; }
        int dev = 0, cus = 0, per_cu = 0;
        if (hipGetDevice(&dev) != hipSuccess || hipDeviceGetAttribute(&cus, hipDeviceAttributeMultiprocessorCount, dev) != hipSuccess) { grid = -1; return; }
        if (hipFuncSetAttribute((const void*)fwd, hipFuncAttributeMaxDynamicSharedMemorySize, LDS_BYTES) != hipSuccess) { fprintf(stderr, "kernel_launch: hipFuncSetAttribute failed\n"); grid = -1; return; }
        if (hipOccupancyMaxActiveBlocksPerMultiprocessor(&per_cu, (const void*)fwd, 512, LDS_BYTES) != hipSuccess || per_cu < 1) { fprintf(stderr, "kernel_launch: occupancy query says %d\n", per_cu); }
        (void)hipGetLastError();
        grid = cus;
    }
    if (grid < 0) return;
    (void)in_sizes;
    (void)hipMemsetAsync((char*)d_ws + WS_CTL, 0, CTL_ZERO_BYTES, stream);
    Params p; memset(&p, 0, sizeof(p));
    for (int i = 0; i < 38; ++i) p.in[i] = (const float*)d_in[i];
    p.out = (float*)d_out; p.ws = (unsigned char*)d_ws;
#if MK_FUSED
    p.ph_lo = 0; p.ph_hi = N_PHASES;
    hipLaunchKernelGGL(fwd, dim3(grid), dim3(512), LDS_BYTES, stream, p);
#else
    for (int k = 0; k < N_PHASES; ++k) { p.ph_lo = k; p.ph_hi = k + 1; hipLaunchKernelGGL(fwd, dim3(grid), dim3(512), LDS_BYTES, stream, p); }
#endif
}
```

```cpp
#include <hip/hip_runtime.h>
#include <cstdio>
#include <cstdint>
#include <cstring>

#ifndef MK_FUSED
#define MK_FUSED 1
#endif

#define GAS __attribute__((address_space(1)))
#define LAS __attribute__((address_space(3)))
typedef unsigned short bf16;
typedef short bf16x8 __attribute__((ext_vector_type(8)));
typedef float f32x4 __attribute__((ext_vector_type(4)));
typedef float f32x2 __attribute__((ext_vector_type(2)));
typedef unsigned u32x4 __attribute__((ext_vector_type(4)));
typedef unsigned u32x2 __attribute__((ext_vector_type(2)));

constexpr int D = 2048, NB = 8, SEQ = 2048, CTXL = 256, TL = NB * SEQ, TC = NB * CTXL, TT = TL + TC;
constexpr int DCV = 1024, DR = 1024, NH = 16, HS = 64, CWID = 31;
constexpr int DSHIFT = 3488, PIN = 9632;
constexpr int ZN = 9728, ZCN = 3584, ZR0 = 2048, ZG0 = 5632;
constexpr int NE = 32, ECAP = 16384, MAXMT = 288;
constexpr int LORA_K = 512, LORA_N = 5120;
constexpr int NOCT = (CTXL + SEQ) / 8;
constexpr int SC_REC = 11264;
constexpr float LN_EPS = 1e-5f, GN_EPS = 64e-5f, DN_ALPHA = 1.189207115002721f;
constexpr float SW_LIMIT = 7.0f, SW_ALPHA = 1.702f;

constexpr size_t MiB = 1u << 20;
constexpr size_t WS_CTL = 0, CTL_ZERO_BYTES = 1 * MiB;
constexpr size_t WS_MOD = 1 * MiB, WS_BIN = 2 * MiB, WS_BGU = 2 * MiB + 65536, WS_WR = 3 * MiB, WS_SEL = 4 * MiB, WS_RK = 5 * MiB;
constexpr size_t WS_ROWTOK = 6 * MiB, WS_ROWW = 8 * MiB, WS_WCO = 10 * MiB, WS_WRO = 14 * MiB, WS_WOUT = 18 * MiB, WS_WLORA = 26 * MiB;
constexpr size_t WS_WIN = 32 * MiB, WS_U = 70 * MiB, WS_ACONV = 142 * MiB, WS_ALORA = 174 * MiB, WS_ARWKV = 192 * MiB, WS_VS = 224 * MiB;
constexpr size_t WS_MIX = 256 * MiB, WS_U2HI = 320 * MiB, WS_U2LO = 384 * MiB, WS_T1 = 448 * MiB, WS_XMID = 576 * MiB, WS_Y = 704 * MiB;
constexpr size_t WS_ZC = 832 * MiB, WS_LORA = 848 * MiB, WS_ZL = 1028 * MiB, WS_SC = 1332 * MiB, WS_WGU = 1728 * MiB, WS_WDN = 2240 * MiB;
constexpr size_t WS_HID = 2496 * MiB, WS_DOWN = 2784 * MiB, WS_END = 3072 * MiB;
constexpr int CW_BAR = 4096;
constexpr int CW_CNT = 1024;

constexpr int RING_BYTES = 131072;
constexpr int LDSX_OFF = RING_BYTES;
constexpr int LX_MISC = LDSX_OFF;
constexpr int LX_CNT = LDSX_OFF + 256;
constexpr int LX_TST = LDSX_OFF + 512;
constexpr int LX_TE = LDSX_OFF + 768;
constexpr int LDS_BYTES = 147456;

__device__ __forceinline__ unsigned f2bf(float f) { unsigned u = __builtin_bit_cast(unsigned, f); return (u + 0x7fffu + ((u >> 16) & 1u)) >> 16; }
__device__ __forceinline__ unsigned cvt_pk_bf16(float lo, float hi) { unsigned r; asm volatile("v_cvt_pk_bf16_f32 %0, %1, %2" : "=v"(r) : "v"(lo), "v"(hi)); return r; }
__device__ __forceinline__ float bflo(unsigned u) { return __builtin_bit_cast(float, u << 16); }
__device__ __forceinline__ float bfhi(unsigned u) { return __builtin_bit_cast(float, u & 0xffff0000u); }
__device__ __forceinline__ float bf1(bf16 h) { return __builtin_bit_cast(float, ((unsigned)h) << 16); }
__device__ __forceinline__ float sigm(float x) { return __builtin_amdgcn_rcpf(1.f + __expf(-x)); }
__device__ __forceinline__ float wave_sum(float v) {
#pragma unroll
    for (int o = 1; o < 64; o <<= 1) v += __shfl_xor(v, o);
    return v;
}
#define RLX_AGENT __ATOMIC_RELAXED, __HIP_MEMORY_SCOPE_AGENT

#define XB_TMO      128
#define XB_XCNT(j)  (256  + 64 * (j))
#define XB_XSUB(j)  (1280 + 64 * (j))
#define XB_XGEN(j)  (2304 + 64 * (j))
#define XB_TOP      3328
#define XB_TOPGEN   3392
#define XCD_BAR_WORDS 3456
#define XB_SPIN_CAP (1u << 22)
__device__ __forceinline__ unsigned xb_ld(unsigned* p)              { return __hip_atomic_load(p, __ATOMIC_RELAXED, __HIP_MEMORY_SCOPE_AGENT); }
__device__ __forceinline__ unsigned xb_add(unsigned* p, unsigned v) { return __hip_atomic_fetch_add(p, v, __ATOMIC_RELAXED, __HIP_MEMORY_SCOPE_AGENT); }
__device__ __forceinline__ unsigned xb_xcc_id() { return (unsigned)__builtin_amdgcn_s_getreg((3 << 11) | 20) & 0xFu; }
#define XB_SPIN(cond, bar) do { unsigned _sp = 0; while (cond) { __builtin_amdgcn_s_sleep(1); \
    if ((++_sp & 255u) == 0u) { if (xb_ld(&(bar)[XB_TMO])) break; if (_sp > XB_SPIN_CAP) { atomicAdd(&(bar)[XB_TMO], 1u); break; } } } } while (0)
struct XcdBarrier { unsigned* bar; unsigned x; volatile LAS unsigned* st; };
__device__ __forceinline__ XcdBarrier xcd_barrier_post(unsigned* bar, volatile LAS unsigned* st) {
    XcdBarrier b; b.bar = bar; b.x = xb_xcc_id(); b.st = st;
    if (threadIdx.x == 0) (void)xb_add(&bar[XB_XCNT(b.x)], 1u);
    return b;
}
__device__ __forceinline__ void xcd_barrier_complete(unsigned* bar, unsigned x, unsigned& nloc, unsigned& nx) {
    const unsigned G = gridDim.x * gridDim.y * gridDim.z;
    unsigned sum, cnt, mine, sp = 0u;
    for (;;) {
        sum = 0u; cnt = 0u; mine = 0u;
#pragma unroll
        for (unsigned j = 0; j < 16; ++j) { const unsigned c = xb_ld(&bar[XB_XCNT(j)]); sum += c; cnt += (c > 0u) ? 1u : 0u; mine = (j == x) ? c : mine; }
        if (sum == G) break;
        __builtin_amdgcn_s_sleep(1);
        if ((++sp & 255u) == 0u) { if (xb_ld(&bar[XB_TMO])) break; if (sp > XB_SPIN_CAP) { atomicAdd(&bar[XB_TMO], 1u); break; } }
    }
    nloc = mine > 0u ? mine : 1u; nx = cnt > 0u ? cnt : 1u;
}
__device__ __forceinline__ void xcd_barrier(const XcdBarrier& b) {
    asm volatile("s_waitcnt vmcnt(0)" ::: "memory");
    __syncthreads();
    if (threadIdx.x == 0) {
        unsigned* bar = b.bar;
        __builtin_amdgcn_s_waitcnt(0);
        unsigned nloc = b.st[0], nx = b.st[1];
        if (nloc == 0u) { xcd_barrier_complete(bar, b.x, nloc, nx); b.st[0] = nloc; b.st[1] = nx; }
        const unsigned old = xb_add(&bar[XB_XSUB(b.x)], 1u);
        const unsigned gen = old / nloc;
        if (old + 1u == (gen + 1u) * nloc) {
            __builtin_amdgcn_fence(__ATOMIC_RELEASE, "agent");
            asm volatile("s_waitcnt vmcnt(0)" ::: "memory");
            const unsigned og = xb_add(&bar[XB_TOP], 1u);
            const unsigned tg = og / nx;
            if (og + 1u == (tg + 1u) * nx) xb_add(&bar[XB_TOPGEN], 1u);
            else XB_SPIN(xb_ld(&bar[XB_TOPGEN]) == tg, bar);
            __builtin_amdgcn_fence(__ATOMIC_ACQUIRE, "agent");
            xb_add(&bar[XB_XGEN(b.x)], 1u);
            asm volatile("s_waitcnt vmcnt(0)" ::: "memory");
        } else {
            XB_SPIN(xb_ld(&bar[XB_XGEN(b.x)]) == gen, bar);
            __builtin_amdgcn_fence(__ATOMIC_ACQUIRE, "agent");
            asm volatile("s_waitcnt vmcnt(0)" ::: "memory");
        }
    }
    __syncthreads();
}

namespace pg8 {
constexpr int BM = 256, BK = 64, HALF = 128, HTB = HALF * BK * 2, STAGE_BYTES = 8 * HTB, NXCD = 8, WGM = 8;
__host__ __device__ __forceinline__ int lds_byte(int r, int c) { const int st = (r >> 4) * 2 + (c >> 5), rr = r & 15, cc = c & 31, ob = rr * 64 + cc * 2; return st * 1024 + (ob ^ (((ob >> 9) & 1) << 5)); }
__host__ __device__ __forceinline__ void stage_rc(int b, int& R, int& C) { const int st = b / 1024, sb = b % 1024, swz = sb ^ (((sb >> 9) & 1) << 5); R = (st >> 1) * 16 + swz / 64; C = (st & 1) * 32 + (swz % 64) / 2; }
__host__ __device__ __forceinline__ int perm32(int rho) { const int n = rho >> 4, i = rho & 15; return 8 * (i >> 2) + 4 * n + (i & 3); }

struct Unit { int pm, pn, e, lt; };
__device__ __forceinline__ void map_tile(int wgid, int nwg, int nM, int nN, int& pm, int& pn) {
    { const int q = nwg / NXCD, r = nwg % NXCD, xcd = wgid % NXCD, off = wgid / NXCD; wgid = (xcd < r ? xcd * (q + 1) : r * (q + 1) + (xcd - r) * q) + off; }
    const int nig = WGM * nN, gid = wgid / nig, fm = gid * WGM, gsz = (nM - fm) < WGM ? (nM - fm) : WGM;
    pm = fm + ((wgid % nig) % gsz); pn = (wgid % nig) / gsz;
}
struct PlainSched {
    const bf16* A; const bf16* Bt; int K, nM, nN, G, c;
    __device__ __forceinline__ bool next(int i, Unit& u) const { const long L = (long)i * G + c; if (L >= (long)nM * nN) return false; map_tile((int)L, nM * nN, nM, nN, u.pm, u.pn); u.e = 0; u.lt = 0; return true; }
    __device__ __forceinline__ const char* aptr(const Unit& u) const { return (const char*)A + (size_t)u.pm * BM * K * 2; }
    __device__ __forceinline__ const char* bptr(const Unit& u) const { return (const char*)Bt + (size_t)u.pn * BM * K * 2; }
    __device__ __forceinline__ void rows(const Unit&, const int (&)[2], const int (&)[2], unsigned (&)[2][2]) const {}
};
struct InProjSched {
    const bf16* A; const bf16* Bt; int G, c;
    __device__ __forceinline__ bool next(int i, Unit& u) const {
        const int L = i * G + c; constexpr int NL = 64 * 38, NCX = 8 * 14;
        if (L >= NL + NCX) return false;
        if (L < NL) map_tile(L, NL, 64, 38, u.pm, u.pn); else { map_tile(L - NL, NCX, 8, 14, u.pm, u.pn); u.pm += 64; u.pn += 8; }
        u.e = 0; u.lt = 0; return true; }
    __device__ __forceinline__ const char* aptr(const Unit& u) const { return (const char*)A + (size_t)u.pm * BM * D * 2; }
    __device__ __forceinline__ const char* bptr(const Unit& u) const { return (const char*)Bt + (size_t)u.pn * BM * D * 2; }
    __device__ __forceinline__ void rows(const Unit&, const int (&)[2], const int (&)[2], unsigned (&)[2][2]) const {}
};
struct MoeSched {
    const bf16* A; const bf16* Bt; const int* rowtok; int K, N, nN, G, c; const LAS int* cnt; const LAS int* tst; const LAS unsigned char* te;
    __device__ __forceinline__ bool next(int i, Unit& u) const { const int nM = tst[NE]; const int L = i * G + c; if (L >= nM * nN) return false;
        map_tile(L, nM * nN, nM, nN, u.pm, u.pn); u.e = te[u.pm]; u.lt = u.pm - tst[u.e]; return true; }
    __device__ __forceinline__ const char* aptr(const Unit& u) const { return (const char*)A + (size_t)u.pm * BM * K * 2; }
    __device__ __forceinline__ const char* bptr(const Unit& u) const { return (const char*)Bt + ((size_t)u.e * N + (size_t)u.pn * BM) * K * 2; }
    __device__ __forceinline__ void rows(const Unit& u, const int (&sR)[2], const int (&sC2)[2], unsigned (&g)[2][2]) const {
        const int n = cnt[u.e]; const int* rt = rowtok + (size_t)u.e * ECAP;
#pragma unroll
        for (int h = 0; h < 2; ++h)
#pragma unroll
            for (int i = 0; i < 2; ++i) { const int j = u.lt * BM + h * HALF + sR[i]; const int tok = (j < n) ? rt[j] : 0; g[h][i] = (unsigned)tok * (unsigned)(K * 2) + (unsigned)sC2[i]; }
        asm volatile("s_waitcnt vmcnt(0)" ::: "memory");
    }
};

template <class Epi, class Sched, bool GATHER>
__device__ __forceinline__ void gemm_phase(LAS unsigned char* lds, const int K, const Sched& S, const Epi& E, const char* gatherA) {
    const int tid = threadIdx.x, wid = __builtin_amdgcn_readfirstlane(tid >> 6), lane = tid & 63, wr = wid >> 2, wc = wid & 3, fr = lane & 15, fq = lane >> 4;
    const int nt = K / BK;
    unsigned voffA[2], voffB[2]; int sR[2], sC2[2];
#pragma unroll
    for (int i = 0; i < 2; ++i) { int R, C; stage_rc(tid * 16 + i * 8192, R, C); const int Rb = Epi::PERM ? ((R & ~31) + perm32(R & 31)) : R;
        voffA[i] = (unsigned)(R * K + C) * 2u; voffB[i] = (unsigned)(Rb * K + C) * 2u; sR[i] = R; sC2[i] = C * 2; }
    const size_t kstep = (size_t)(BK * 2);
    const size_t hstep = (size_t)HALF * K * 2;
    const unsigned ldsw = (unsigned)wid * 1024u;
    const int aoff = lds_byte(wr * 64 + fr, fq * 8), boff = lds_byte(wc * 32 + fr, fq * 8);
#define PG8_SA(b, h) (((b) * 2 + (h)) * HTB)
#define PG8_SB(b, h) ((4 + (b) * 2 + (h)) * HTB)
#define PG8_STAGE(bufoff, gbase, voff) do { _Pragma("unroll") for (int _i = 0; _i < 2; ++_i) \
        __builtin_amdgcn_global_load_lds((const unsigned*)((const char*)(gbase) + (voff)[_i]), (LAS unsigned*)(lds + (bufoff) + ldsw + _i * 8192), 16, 0, 0); } while (0)
#define PG8_STG_A(bufoff, gbase, h, OFF) do { if constexpr (GATHER) { PG8_STAGE(bufoff, gbase, OFF); } else { PG8_STAGE(bufoff, (gbase) + (h) * hstep, voffA); } } while (0)
#define PG8_LDA(dst, b, h) do { _Pragma("unroll") for (int m = 0; m < 4; ++m) _Pragma("unroll") for (int k = 0; k < 2; ++k) dst[m][k] = *(const LAS bf16x8*)(lds + PG8_SA(b, h) + aoff + m * 2048 + k * 1024); } while (0)
#define PG8_LDB(dst, b, h) do { _Pragma("unroll") for (int n = 0; n < 2; ++n) _Pragma("unroll") for (int k = 0; k < 2; ++k) dst[n][k] = *(const LAS bf16x8*)(lds + PG8_SB(b, h) + boff + n * 2048 + k * 1024); } while (0)
#define PG8_MMA(ai, bj, At, Bt) do { __builtin_amdgcn_s_setprio(1); _Pragma("unroll") for (int m = 0; m < 4; ++m) _Pragma("unroll") for (int n = 0; n < 2; ++n) _Pragma("unroll") for (int k = 0; k < 2; ++k) \
        acc[ai][bj][m][n] = __builtin_amdgcn_mfma_f32_16x16x32_bf16(Bt[n][k], At[m][k], acc[ai][bj][m][n], 0, 0, 0); __builtin_amdgcn_s_setprio(0); } while (0)
#define PG8_WAIT_V(n) asm volatile("s_waitcnt vmcnt(" #n ")" ::: "memory")
#define PG8_WAIT_L(n) asm volatile("s_waitcnt lgkmcnt(" #n ")" ::: "memory")
#define PG8_BAR __builtin_amdgcn_s_barrier()
#define PG8_SCHED __builtin_amdgcn_sched_barrier(0)
    Unit cur, nxt; int ui = 0;
    if (!S.next(0, cur)) return;
    f32x4 acc[2][2][4][2];
#pragma unroll
    for (int a = 0; a < 2; ++a)
#pragma unroll
        for (int b = 0; b < 2; ++b)
#pragma unroll
            for (int m = 0; m < 4; ++m)
#pragma unroll
                for (int n = 0; n < 2; ++n) acc[a][b][m][n] = (f32x4){0.f, 0.f, 0.f, 0.f};
    bf16x8 At[4][2], B0[2][2], B1[2][2];
    const char* cA = GATHER ? gatherA : S.aptr(cur); const char* cB = S.bptr(cur);
    unsigned gA[2][2] = {{0u, 0u}, {0u, 0u}}, gA1[2] = {0u, 0u};
    if constexpr (GATHER) S.rows(cur, sR, sC2, gA);
    PG8_STAGE(PG8_SB(0, 0), cB, voffB); PG8_STAGE(PG8_SB(0, 1), cB + hstep, voffB); PG8_STG_A(PG8_SA(0, 0), cA, 0, gA[0]); PG8_STG_A(PG8_SA(0, 1), cA, 1, gA[1]);
    if (wr == 1) PG8_BAR;
    PG8_WAIT_V(2); PG8_BAR;
    PG8_STAGE(PG8_SB(1, 0), cB + kstep, voffB); PG8_STG_A(PG8_SA(1, 0), cA + kstep, 0, gA[0]); PG8_STAGE(PG8_SB(1, 1), cB + hstep + kstep, voffB);
    PG8_WAIT_V(6); PG8_BAR;
    for (;;) {
        const bool has_next = S.next(ui + 1, nxt);
        const char* nA = GATHER ? gatherA : (has_next ? S.aptr(nxt) : cA); const char* nB = has_next ? S.bptr(nxt) : cB;
        for (int t = 0; t < nt; t += 2) {
            const bool last = (t == nt - 2);
            const char* a1 = cA + (size_t)(t + 1) * kstep;
            const char* a2 = last ? nA : cA + (size_t)(t + 2) * kstep; const char* b2 = last ? nB : cB + (size_t)(t + 2) * kstep;
            const char* a3 = a2 + kstep; const char* b3 = b2 + kstep;
            if constexpr (GATHER) { gA1[0] = gA[1][0]; gA1[1] = gA[1][1]; if (last && has_next) S.rows(nxt, sR, sC2, gA); }
            PG8_LDB(B0, 0, 0); PG8_LDB(B1, 0, 1); PG8_SCHED; PG8_LDA(At, 0, 0); PG8_STG_A(PG8_SA(1, 1), a1, 1, gA1);
            PG8_WAIT_V(8); PG8_WAIT_L(0); PG8_BAR; PG8_MMA(0, 0, At, B0); PG8_MMA(0, 1, At, B1); PG8_BAR; PG8_SCHED;
            PG8_LDA(At, 0, 1); PG8_STAGE(PG8_SB(0, 0), b2, voffB); PG8_STAGE(PG8_SB(0, 1), b2 + hstep, voffB); PG8_STG_A(PG8_SA(0, 0), a2, 0, gA[0]);
            PG8_WAIT_V(8); PG8_WAIT_L(0); PG8_BAR; PG8_MMA(1, 0, At, B0); PG8_MMA(1, 1, At, B1); PG8_BAR; PG8_SCHED;
            PG8_LDB(B0, 1, 0); PG8_LDB(B1, 1, 1); PG8_SCHED; PG8_LDA(At, 1, 0); PG8_STG_A(PG8_SA(0, 1), a2, 1, gA[1]);
            PG8_WAIT_V(8); PG8_WAIT_L(0); PG8_BAR; PG8_MMA(0, 0, At, B0); PG8_MMA(0, 1, At, B1); PG8_BAR; PG8_SCHED;
            PG8_LDA(At, 1, 1); PG8_STAGE(PG8_SB(1, 0), b3, voffB); PG8_STAGE(PG8_SB(1, 1), b3 + hstep, voffB); PG8_STG_A(PG8_SA(1, 0), a3, 0, gA[0]);
            PG8_WAIT_V(8); PG8_WAIT_L(0); PG8_BAR; PG8_MMA(1, 0, At, B0); PG8_MMA(1, 1, At, B1); PG8_BAR; PG8_SCHED;
        }
        if (wr == 0) PG8_BAR;
        E(acc, cur, wr, wc, fr, fq);
        if (!has_next) break;
#pragma unroll
        for (int a = 0; a < 2; ++a)
#pragma unroll
            for (int b = 0; b < 2; ++b)
#pragma unroll
                for (int m = 0; m < 4; ++m)
#pragma unroll
                    for (int n = 0; n < 2; ++n) acc[a][b][m][n] = (f32x4){0.f, 0.f, 0.f, 0.f};
        cur = nxt; cA = nA; cB = nB; ++ui;
        if (wr == 1) PG8_BAR;
    }
    PG8_WAIT_V(0);
    PG8_BAR;
#undef PG8_SA
#undef PG8_SB
#undef PG8_STAGE
#undef PG8_STG_A
#undef PG8_LDA
#undef PG8_LDB
#undef PG8_MMA
#undef PG8_WAIT_V
#undef PG8_WAIT_L
#undef PG8_BAR
#undef PG8_SCHED
}

typedef const f32x4 (&AccT)[2][2][4][2];
__device__ __forceinline__ u32x4 pack8(f32x4 v0, f32x4 v1) { u32x4 w; w.x = cvt_pk_bf16(v0[0], v0[1]); w.y = cvt_pk_bf16(v0[2], v0[3]); w.z = cvt_pk_bf16(v1[0], v1[1]); w.w = cvt_pk_bf16(v1[2], v1[3]); return w; }
__device__ __forceinline__ void unpack8(u32x4 w, f32x4& v0, f32x4& v1) { v0 = (f32x4){bflo(w.x), bfhi(w.x), bflo(w.y), bfhi(w.y)}; v1 = (f32x4){bflo(w.z), bfhi(w.z), bflo(w.w), bfhi(w.w)}; }
__device__ __forceinline__ f32x4 sig4(f32x4 v) { return (f32x4){sigm(v[0]), sigm(v[1]), sigm(v[2]), sigm(v[3])}; }

struct EpiBf16Plain {
    static constexpr bool PERM = true;
    bf16* O; int ldc; const float* bias;
    __device__ __forceinline__ void operator()(AccT acc, const Unit& u, int wr, int wc, int fr, int fq) const {
        const int row0 = u.pm * BM + wr * 64 + fr, col0 = u.pn * BM + wc * 32 + 8 * fq;
        f32x4 bv[2][2];
#pragma unroll
        for (int bj = 0; bj < 2; ++bj)
#pragma unroll
            for (int n = 0; n < 2; ++n) bv[bj][n] = bias ? *(const f32x4*)(bias + col0 + bj * HALF + 4 * n) : (f32x4){0.f, 0.f, 0.f, 0.f};
#pragma unroll
        for (int ai = 0; ai < 2; ++ai)
#pragma unroll
            for (int m = 0; m < 4; ++m) { bf16* rowp = O + (size_t)(row0 + ai * HALF + m * 16) * ldc + col0;
#pragma unroll
                for (int bj = 0; bj < 2; ++bj) *(u32x4*)(rowp + bj * HALF) = pack8(acc[ai][bj][m][0] + bv[bj][0], acc[ai][bj][m][1] + bv[bj][1]); }
    }
};
struct EpiInProj {
    static constexpr bool PERM = true;
    bf16* ZL; bf16* ZC; const float* bias;
    __device__ __forceinline__ void operator()(AccT acc, const Unit& u, int wr, int wc, int fr, int fq) const {
        const int row0 = u.pm * BM + wr * 64 + fr, col0 = u.pn * BM + wc * 32 + 8 * fq;
        f32x4 bv[2][2];
#pragma unroll
        for (int bj = 0; bj < 2; ++bj)
#pragma unroll
            for (int n = 0; n < 2; ++n) bv[bj][n] = *(const f32x4*)(bias + col0 + bj * HALF + 4 * n);
        const bool lat = u.pm < 64;
#pragma unroll
        for (int ai = 0; ai < 2; ++ai)
#pragma unroll
            for (int m = 0; m < 4; ++m) { const int r = row0 + ai * HALF + m * 16;
                bf16* rowp = lat ? ZL + (size_t)r * ZN + col0 : ZC + (size_t)(r - TL) * ZCN + (col0 - ZR0);
#pragma unroll
                for (int bj = 0; bj < 2; ++bj) *(u32x4*)(rowp + bj * HALF) = pack8(acc[ai][bj][m][0] + bv[bj][0], acc[ai][bj][m][1] + bv[bj][1]); }
    }
};
struct EpiConvO {
    static constexpr bool PERM = true;
    bf16* MIX; const bf16* ZL; const float* bias;
    __device__ __forceinline__ void operator()(AccT acc, const Unit& u, int wr, int wc, int fr, int fq) const {
        const int row0 = u.pm * BM + wr * 64 + fr, col0 = u.pn * BM + wc * 32 + 8 * fq;
        f32x4 bv[2][2];
#pragma unroll
        for (int bj = 0; bj < 2; ++bj)
#pragma unroll
            for (int n = 0; n < 2; ++n) bv[bj][n] = *(const f32x4*)(bias + col0 + bj * HALF + 4 * n);
#pragma unroll
        for (int ai = 0; ai < 2; ++ai)
#pragma unroll
            for (int m = 0; m < 4; ++m) { const size_t r = (size_t)(row0 + ai * HALF + m * 16);
#pragma unroll
                for (int bj = 0; bj < 2; ++bj) { const int c = col0 + bj * HALF; f32x4 g0, g1; unpack8(*(const u32x4*)(ZL + r * ZN + ZG0 + c), g0, g1);
                    *(u32x4*)(MIX + r * D + c) = pack8(sig4(g0) * (acc[ai][bj][m][0] + bv[bj][0]), sig4(g1) * (acc[ai][bj][m][1] + bv[bj][1])); } }
    }
};
struct EpiRwkvO {
    static constexpr bool PERM = true;
    bf16* MIX; const bf16* ZL;
    __device__ __forceinline__ void operator()(AccT acc, const Unit& u, int wr, int wc, int fr, int fq) const {
        const int row0 = u.pm * BM + wr * 64 + fr, col0 = u.pn * BM + wc * 32 + 8 * fq;
#pragma unroll
        for (int ai = 0; ai < 2; ++ai)
#pragma unroll
            for (int m = 0; m < 4; ++m) { const size_t r = (size_t)(row0 + ai * HALF + m * 16);
#pragma unroll
                for (int bj = 0; bj < 2; ++bj) { const int c = col0 + bj * HALF; f32x4 g0, g1, m0, m1; unpack8(*(const u32x4*)(ZL + r * ZN + ZG0 + D + c), g0, g1); unpack8(*(const u32x4*)(MIX + r * D + c), m0, m1);
                    *(u32x4*)(MIX + r * D + c) = pack8(m0 + sig4(g0) * acc[ai][bj][m][0], m1 + sig4(g1) * acc[ai][bj][m][1]); } }
    }
};
struct EpiOut {
    static constexpr bool PERM = false;
    float* T1; const float* x; const float* mod; const float* bias;
    __device__ __forceinline__ void operator()(AccT acc, const Unit& u, int wr, int wc, int fr, int fq) const {
        const int row0 = u.pm * BM + wr * 64 + fr, col0 = u.pn * BM + wc * 32 + 4 * fq;
        const float* gate = mod + (size_t)(u.pm / 8) * (6 * D) + 2 * D;
        f32x4 bv[2][2], gv[2][2];
#pragma unroll
        for (int bj = 0; bj < 2; ++bj)
#pragma unroll
            for (int n = 0; n < 2; ++n) { bv[bj][n] = *(const f32x4*)(bias + col0 + bj * HALF + n * 16); gv[bj][n] = *(const f32x4*)(gate + col0 + bj * HALF + n * 16); }
#pragma unroll
        for (int ai = 0; ai < 2; ++ai)
#pragma unroll
            for (int m = 0; m < 4; ++m) { const size_t off = (size_t)(row0 + ai * HALF + m * 16) * D + col0;
#pragma unroll
                for (int bj = 0; bj < 2; ++bj)
#pragma unroll
                    for (int n = 0; n < 2; ++n) { const f32x4 xv = *(const f32x4*)(x + off + bj * HALF + n * 16);
                        *(f32x4*)(T1 + off + bj * HALF + n * 16) = xv * DN_ALPHA + gv[bj][n] * (acc[ai][bj][m][n] + bv[bj][n]); } }
    }
};
struct EpiGateUp {
    static constexpr bool PERM = true;
    bf16* HID; const float* bias;
    __device__ __forceinline__ void operator()(AccT acc, const Unit& u, int wr, int wc, int fr, int fq) const {
        const int row0 = u.pm * BM + wr * 64 + fr, cb = u.pn * BM + wc * 32 + 8 * fq, co = u.pn * HALF + wc * 32 + 8 * fq;
        const float* bp = bias + (size_t)u.e * 4096 + cb;
        f32x4 bv[2][2];
#pragma unroll
        for (int bj = 0; bj < 2; ++bj)
#pragma unroll
            for (int n = 0; n < 2; ++n) bv[bj][n] = *(const f32x4*)(bp + bj * HALF + 4 * n);
#pragma unroll
        for (int ai = 0; ai < 2; ++ai)
#pragma unroll
            for (int m = 0; m < 4; ++m) { f32x4 h[2];
#pragma unroll
                for (int n = 0; n < 2; ++n) { const f32x4 g = acc[ai][0][m][n] + bv[0][n], up = acc[ai][1][m][n] + bv[1][n];
#pragma unroll
                    for (int j = 0; j < 4; ++j) { const float gg = fminf(g[j], SW_LIMIT), uu = fminf(fmaxf(up[j], -SW_LIMIT), SW_LIMIT); h[n][j] = (uu + 1.0f) * (gg * sigm(SW_ALPHA * gg)); } }
                *(u32x4*)(HID + (size_t)(row0 + ai * HALF + m * 16) * D + co) = pack8(h[0], h[1]); }
    }
};
struct EpiDown {
    static constexpr bool PERM = true;
    bf16* DOWN; const float* bias; const float* roww; const LAS int* cnt;
    __device__ __forceinline__ void operator()(AccT acc, const Unit& u, int wr, int wc, int fr, int fq) const {
        const int rl0 = wr * 64 + fr, col0 = u.pn * BM + wc * 32 + 8 * fq; const int n_e = cnt[u.e];
        const float* bp = bias + (size_t)u.e * D + col0; const float* rw = roww + (size_t)u.e * ECAP + u.lt * BM;
        f32x4 bv[2][2];
#pragma unroll
        for (int bj = 0; bj < 2; ++bj)
#pragma unroll
            for (int n = 0; n < 2; ++n) bv[bj][n] = *(const f32x4*)(bp + bj * HALF + 4 * n);
#pragma unroll
        for (int ai = 0; ai < 2; ++ai)
#pragma unroll
            for (int m = 0; m < 4; ++m) { const int rl = rl0 + ai * HALF + m * 16; const float gw = (u.lt * BM + rl < n_e) ? rw[rl] : 0.f;
                bf16* rowp = DOWN + (size_t)(u.pm * BM + rl) * D + col0;
#pragma unroll
                for (int bj = 0; bj < 2; ++bj) *(u32x4*)(rowp + bj * HALF) = pack8((acc[ai][bj][m][0] + bv[bj][0]) * gw, (acc[ai][bj][m][1] + bv[bj][1]) * gw); }
    }
};
}
__device__ __forceinline__ void unpack8(u32x4 w, f32x4& a, f32x4& b) { pg8::unpack8(w, a, b); }

struct Params { const float* in[38]; float* out; unsigned char* ws; int ph_lo, ph_hi; };
enum { I_X = 0, I_C, I_CTX, I_CCTX, I_WADA, I_BADA, I_WIN, I_BIN, I_SMU, I_CONVW, I_CONVB, I_CLNG, I_CLNB, I_WCO, I_BCO, I_W0, I_W2, I_A0, I_A2, I_G2,
       I_KK, I_KA, I_RK, I_LNXG, I_LNXB, I_WRO, I_WOUT, I_BOUT, I_LN1G, I_LN1B, I_WROUTER, I_BROUTER, I_WGU, I_BGU, I_WDN, I_BDN, I_LN2G, I_LN2B };

struct Ctx { LAS unsigned char* lds; int tid, lane, wave, G, bid, gw, NGW; };

__device__ __forceinline__ void cvt_item(const float* W, int N, int K, int k0, int n0, bf16* WT, int drow0, int lane) {
    const int ko = lane & 7, ng = lane >> 3;
    const float* src = W + (size_t)(k0 + 8 * ko) * N + n0 + 4 * ng;
    f32x4 v[8];
#pragma unroll
    for (int j = 0; j < 8; ++j) v[j] = *(const f32x4*)(src + (size_t)j * N);
#pragma unroll
    for (int jn = 0; jn < 4; ++jn) { u32x4 o; o.x = cvt_pk_bf16(v[0][jn], v[1][jn]); o.y = cvt_pk_bf16(v[2][jn], v[3][jn]); o.z = cvt_pk_bf16(v[4][jn], v[5][jn]); o.w = cvt_pk_bf16(v[6][jn], v[7][jn]);
        *(u32x4*)(WT + (size_t)(drow0 + 4 * ng + jn) * K + k0 + 8 * ko) = o; }
}
__device__ __forceinline__ void p0_convert(const Params& p, const Ctx& c) {
    unsigned char* ws = p.ws;
    constexpr int I_IN = 32 * 301, I_CO = 16 * 64, I_RO = 16 * 64, I_OUT = 32 * 64, I_GU1 = 32 * 128, I_GU = NE * I_GU1, I_DN1 = 32 * 64, I_DN = NE * I_DN1;
    constexpr int NITEMS = I_IN + I_CO + I_RO + I_OUT + I_GU + I_DN;
    for (int it = c.gw; it < NITEMS; it += c.NGW) {
        int r = it;
        if (r < I_IN) { const int kb = r / 301, nb = r % 301, n0 = 32 * nb; cvt_item(p.in[I_WIN], PIN, D, 64 * kb, n0, (bf16*)(ws + WS_WIN), n0 < 5536 ? n0 : n0 + 96, c.lane); continue; } r -= I_IN;
        if (r < I_CO) { const int kb = r / 64, nb = r % 64; cvt_item(p.in[I_WCO], D, DCV, 64 * kb, 32 * nb, (bf16*)(ws + WS_WCO), 32 * nb, c.lane); continue; } r -= I_CO;
        if (r < I_RO) { const int kb = r / 64, nb = r % 64; cvt_item(p.in[I_WRO], D, DR, 64 * kb, 32 * nb, (bf16*)(ws + WS_WRO), 32 * nb, c.lane); continue; } r -= I_RO;
        if (r < I_OUT) { const int kb = r / 64, nb = r % 64; cvt_item(p.in[I_WOUT], D, D, 64 * kb, 32 * nb, (bf16*)(ws + WS_WOUT), 32 * nb, c.lane); continue; } r -= I_OUT;
        if (r < I_GU) { const int e = r / I_GU1, q = r % I_GU1, kb = q / 128, nb = q % 128, n0 = 32 * nb; const int nn = n0 & 2047;
            const int drow = (nn >> 7) * 256 + (n0 >= 2048 ? 128 : 0) + (nn & 127);
            cvt_item(p.in[I_WGU] + (size_t)e * D * 4096, 4096, D, 64 * kb, n0, (bf16*)(ws + WS_WGU) + (size_t)e * 4096 * D, drow, c.lane); continue; } r -= I_GU;
        { const int e = r / I_DN1, q = r % I_DN1, kb = q / 64, nb = q % 64;
            cvt_item(p.in[I_WDN] + (size_t)e * D * D, D, D, 64 * kb, 32 * nb, (bf16*)(ws + WS_WDN) + (size_t)e * D * D, 32 * nb, c.lane); }
    }
}
__device__ __forceinline__ void p0_small(const Params& p, const Ctx& c) {
    unsigned char* ws = p.ws;
    const int gt = c.bid * 512 + c.tid, NT = c.G * 512;
    bf16* WL = (bf16*)(ws + WS_WLORA);
    for (int t = gt; t < LORA_N * (LORA_K / 8); t += NT) {
        const int n = t / (LORA_K / 8), k0 = (t % (LORA_K / 8)) * 8, g = n >> 10, ch = n & 1023; float v[8];
#pragma unroll
        for (int j = 0; j < 8; ++j) { const int k = k0 + j; float x = 0.f;
            if (g < 4) { if (k >= 64 * g && k < 64 * g + 64) { const float* src = (g < 2) ? p.in[I_W2] : p.in[I_A2]; x = src[((size_t)(g & 1) * 64 + (k - 64 * g)) * DR + ch]; } }
            else { if (k >= 256 && k < 416) x = p.in[I_G2][(size_t)(k - 256) * DR + ch]; }
            v[j] = x; }
        u32x4 o; o.x = cvt_pk_bf16(v[0], v[1]); o.y = cvt_pk_bf16(v[2], v[3]); o.z = cvt_pk_bf16(v[4], v[5]); o.w = cvt_pk_bf16(v[6], v[7]);
        *(u32x4*)(WL + (size_t)n * LORA_K + k0) = o;
    }
    bf16* WRt = (bf16*)(ws + WS_WR);
    for (int t = gt; t < NE * D; t += NT) { const int e = t / D, k = t % D; const float w = p.in[I_WROUTER][(size_t)k * NE + e]; const unsigned hi = f2bf(w); const float lo = w - bflo(hi);
        WRt[t] = (bf16)hi; WRt[NE * D + t] = (bf16)f2bf(lo); }
    float* bin = (float*)(ws + WS_BIN);
    for (int t = gt; t < ZN; t += NT) bin[t] = t < 5536 ? p.in[I_BIN][t] : (t < ZG0 ? 0.f : p.in[I_BIN][t - 96]);
    float* bgu = (float*)(ws + WS_BGU);
    for (int t = gt; t < NE * 4096; t += NT) { const int e = t >> 12, q = t & 4095, pn = q >> 8, rr = q & 255; bgu[t] = p.in[I_BGU][(size_t)e * 4096 + (rr < 128 ? 128 * pn + rr : 2048 + 128 * pn + rr - 128)]; }
    bf16* WI = (bf16*)(ws + WS_WIN);
    for (int t = gt; t < 96 * D / 8; t += NT) *(u32x4*)(WI + (size_t)5536 * D + (size_t)t * 8) = (u32x4){0u, 0u, 0u, 0u};
}
__device__ __forceinline__ void p0_adaln(const Params& p, const Ctx& c) {
    LAS float* act = (LAS float*)c.lds; LAS float* red = (LAS float*)(c.lds + 73728);
    for (int i = c.tid; i < 9 * D; i += 512) { const int r = i / D, k = i % D; const float v = r < 8 ? p.in[I_C][r * D + k] : p.in[I_CCTX][k]; act[i] = v * sigm(v); }
    __syncthreads();
    const int cg = c.tid & 15, ks = c.tid >> 4;
    float* mod = (float*)(p.ws + WS_MOD);
    for (int u = c.bid; u < 192; u += c.G) {
        f32x4 acc[9];
#pragma unroll
        for (int r = 0; r < 9; ++r) acc[r] = (f32x4){0.f, 0.f, 0.f, 0.f};
        const float* wp = p.in[I_WADA] + 64 * u + 4 * cg;
#pragma unroll 4
        for (int k = ks; k < D; k += 32) { const f32x4 w = *(const f32x4*)(wp + (size_t)k * (6 * D));
#pragma unroll
            for (int r = 0; r < 9; ++r) acc[r] += w * act[r * D + k]; }
#pragma unroll
        for (int r = 0; r < 9; ++r)
#pragma unroll
            for (int j = 0; j < 4; ++j) { float v = acc[r][j]; v += __shfl_xor(v, 16); v += __shfl_xor(v, 32); acc[r][j] = v; }
        if (c.lane < 16) {
#pragma unroll
            for (int r = 0; r < 9; ++r) *(LAS f32x4*)(red + (c.wave * 9 + r) * 64 + 4 * cg) = acc[r]; }
        __syncthreads();
        for (int i = c.tid; i < 9 * 64; i += 512) { const int r = i / 64, col = i % 64; float s = 0.f;
#pragma unroll
            for (int w = 0; w < 8; ++w) s += red[(w * 9 + r) * 64 + col];
            mod[r * (6 * D) + 64 * u + col] = s + p.in[I_BADA][64 * u + col]; }
        __syncthreads();
    }
}

__device__ __forceinline__ void p1_modulate(const Params& p, const Ctx& c) {
    const float* mod = (const float*)(p.ws + WS_MOD); bf16* U = (bf16*)(p.ws + WS_U);
    for (int row = c.gw; row < TT; row += c.NGW) {
        const float* src = row < TL ? p.in[I_X] + (size_t)row * D : p.in[I_CTX] + (size_t)(row - TL) * D;
        const int b = row < TL ? row / SEQ : 8;
        const float* sh = mod + (size_t)b * (6 * D); const float* sc = sh + D;
        f32x4 v[8]; float s = 0.f;
#pragma unroll
        for (int j = 0; j < 8; ++j) { v[j] = *(const f32x4*)(src + 4 * c.lane + 256 * j); s += (v[j][0] + v[j][1]) + (v[j][2] + v[j][3]); }
        const float mean = wave_sum(s) * (1.f / D); float s2 = 0.f;
#pragma unroll
        for (int j = 0; j < 8; ++j) { v[j] = v[j] - mean; s2 += (v[j][0] * v[j][0] + v[j][1] * v[j][1]) + (v[j][2] * v[j][2] + v[j][3] * v[j][3]); }
        const float rstd = __builtin_amdgcn_rsqf(wave_sum(s2) * (1.f / D) + LN_EPS);
#pragma unroll
        for (int j = 0; j < 8; ++j) { const int col = 4 * c.lane + 256 * j; const f32x4 a = *(const f32x4*)(sc + col), bb = *(const f32x4*)(sh + col);
            const f32x4 o = v[j] * rstd * (a + 1.0f) + bb; u32x2 w; w.x = cvt_pk_bf16(o[0], o[1]); w.y = cvt_pk_bf16(o[2], o[3]);
            *(u32x2*)(U + (size_t)row * D + col) = w; }
    }
}

__device__ __forceinline__ void p3_conv(const Params& p, const Ctx& c) {
    const bf16* ZL = (const bf16*)(p.ws + WS_ZL); bf16* AC = (bf16*)(p.ws + WS_ACONV);
    LAS unsigned* tile = (LAS unsigned*)c.lds;
    for (int gr = c.bid; gr < TL / 64; gr += c.G) {
        const int row0 = gr * 64, c0 = 2 * c.tid;
#pragma unroll 4
        for (int i = 0; i < 16; ++i) { const int ch = c.tid + 512 * i, t = ch >> 7, cg = ch & 127;
            f32x4 a0, a1, g0, g1; unpack8(*(const u32x4*)(ZL + (size_t)(row0 + t) * ZN + 8 * cg), a0, a1); unpack8(*(const u32x4*)(ZL + (size_t)(row0 + t) * ZN + DCV + 8 * cg), g0, g1);
            *(LAS u32x4*)(tile + t * 512 + 4 * cg) = pg8::pack8(a0 * pg8::sig4(g0), a1 * pg8::sig4(g1)); }
        __syncthreads();
#pragma unroll 1
        for (int cc = 0; cc < 2; ++cc) {
            float w[CWID];
#pragma unroll
            for (int j = 0; j < CWID; ++j) w[j] = p.in[I_CONVW][j * DCV + c0 + cc];
            const float cb = p.in[I_CONVB][c0 + cc];
            float h[64];
#pragma unroll
            for (int t = 0; t < 64; ++t) { const unsigned a = tile[t * 512 + c.tid]; h[t] = cc ? bfhi(a) : bflo(a); }
#pragma clang loop unroll(full)
            for (int t = 0; t < 64; ++t) { float a = cb;
#pragma clang loop unroll(full)
                for (int j = 0; j < CWID; ++j) { const int tt = t + j - CWID / 2; if (tt >= 0 && tt < 64) a += w[j] * h[tt]; }
                ((LAS bf16*)tile)[t * DCV + c0 + cc] = (bf16)f2bf(a); }
        }
        __syncthreads();
        f32x4 g[4], bb[4];
#pragma unroll
        for (int q = 0; q < 4; ++q) { g[q] = *(const f32x4*)(p.in[I_CLNG] + 16 * c.lane + 4 * q); bb[q] = *(const f32x4*)(p.in[I_CLNB] + 16 * c.lane + 4 * q); }
#pragma unroll 2
        for (int i = 0; i < 8; ++i) { const int t = c.wave * 8 + i;
            const u32x4 r0 = *(const LAS u32x4*)(tile + t * 512 + 8 * c.lane), r1 = *(const LAS u32x4*)(tile + t * 512 + 8 * c.lane + 4);
            f32x4 v[4]; unpack8(r0, v[0], v[1]); unpack8(r1, v[2], v[3]);
            float s = 0.f;
#pragma unroll
            for (int q = 0; q < 4; ++q) s += (v[q][0] + v[q][1]) + (v[q][2] + v[q][3]);
            const float mean = wave_sum(s) * (1.f / DCV); float s2 = 0.f;
#pragma unroll
            for (int q = 0; q < 4; ++q) { v[q] = v[q] - mean; s2 += (v[q][0] * v[q][0] + v[q][1] * v[q][1]) + (v[q][2] * v[q][2] + v[q][3] * v[q][3]); }
            const float rstd = __builtin_amdgcn_rsqf(wave_sum(s2) * (1.f / DCV) + LN_EPS);
#pragma unroll
            for (int q = 0; q < 4; ++q) { v[q] = v[q] * rstd * g[q] + bb[q];
#pragma unroll
                for (int j = 0; j < 4; ++j) v[q][j] = v[q][j] * sigm(v[q][j]); }
            bf16* o = AC + (size_t)(row0 + t) * DCV + 16 * c.lane;
            *(u32x4*)o = pg8::pack8(v[0], v[1]); *(u32x4*)(o + 8) = pg8::pack8(v[2], v[3]); }
        __syncthreads();
    }
}
__device__ __forceinline__ void p3_alora(const Params& p, const Ctx& c) {
    const bf16* ZL = (const bf16*)(p.ws + WS_ZL); const bf16* ZC = (const bf16*)(p.ws + WS_ZC); bf16* AL = (bf16*)(p.ws + WS_ALORA);
    const float* mu = p.in[I_SMU];
    for (int row = c.gw; row < TT; row += c.NGW) {
        const bool lat = row < TL; const int pitch = lat ? ZN : ZCN; const int len = lat ? SEQ : CTXL; const int t = lat ? row % SEQ : (row - TL) % CTXL;
        const bf16* zp = lat ? ZL + (size_t)row * ZN + ZR0 : ZC + (size_t)(row - TL) * ZCN;
        const bool hp = t > 0, hn = t < len - 1;
#pragma unroll
        for (int i = 0; i < 8; ++i) { const int j = c.lane + 64 * i; float o = 0.f;
            if (j < 416) { const int col = 3072 + j; const float z = bf1(zp[col]); const float pv = hp ? bf1(zp[col - pitch]) : 0.f, nv = hn ? bf1(zp[col + pitch]) : 0.f;
                const float zs = z + mu[col] * (pv - z) + mu[DSHIFT + col] * (nv - z);
                o = j < 128 ? (1.f - 2.f * __builtin_amdgcn_rcpf(__expf(2.f * zs) + 1.f)) : (j < 256 ? zs : sigm(zs)); }
            AL[(size_t)row * LORA_K + j] = (bf16)f2bf(o); }
    }
}

__device__ __forceinline__ void p5_prep(const Params& p, const Ctx& c) {
    const bf16* ZL = (const bf16*)(p.ws + WS_ZL); const bf16* ZC = (const bf16*)(p.ws + WS_ZC); const bf16* LO = (const bf16*)(p.ws + WS_LORA);
    unsigned char* SC = p.ws + WS_SC; bf16* VS = (bf16*)(p.ws + WS_VS); float* RK = (float*)(p.ws + WS_RK);
    const float* mu = p.in[I_SMU];
    for (int it = c.gw; it < NB * NH * NOCT; it += c.NGW) {
        const int oct = it % NOCT, bh = it / NOCT, h = bh % NH, b = bh / NH, hc = h * HS + c.lane;
        const bool lat = oct >= 32; const int pitch = lat ? ZN : ZCN, len = lat ? SEQ : CTXL, t0 = lat ? (oct - 32) * 8 : oct * 8;
        const size_t rowbase = lat ? (size_t)b * SEQ + t0 : (size_t)b * CTXL + t0;
        const bf16* zp = lat ? ZL + rowbase * ZN + ZR0 : ZC + rowbase * ZCN;
        const size_t lrow = lat ? rowbase : (size_t)TL + rowbase;
        const float mpr = mu[hc], mnr = mu[DSHIFT + hc], mpk = mu[DR + hc], mnk = mu[DSHIFT + DR + hc], mpv = mu[2 * DR + hc], mnv = mu[DSHIFT + 2 * DR + hc];
        const float kk_ = p.in[I_KK][hc], ka_ = p.in[I_KA][hc], rk_ = p.in[I_RK][hc];
        const float w00 = p.in[I_W0][hc], w01 = p.in[I_W0][DR + hc], a00 = p.in[I_A0][hc], a01 = p.in[I_A0][DR + hc];
        float zr[10], zk[10], zv[10];
#pragma unroll
        for (int i = 0; i < 10; ++i) { const int t = t0 - 1 + i; const bool ok = t >= 0 && t < len; const bf16* q = zp + (ptrdiff_t)(i - 1) * pitch;
            zr[i] = ok ? bf1(q[hc]) : 0.f; zk[i] = ok ? bf1(q[DR + hc]) : 0.f; zv[i] = ok ? bf1(q[2 * DR + hc]) : 0.f; }
        float o_r[8], o_v[8], o_na[8], o_w[2][8], o_b[2][8], o_kd[2][8];
#pragma unroll
        for (int i = 0; i < 8; ++i) {
            const float r = zr[i + 1] + mpr * (zr[i] - zr[i + 1]) + mnr * (zr[i + 2] - zr[i + 1]);
            const float k = zk[i + 1] + mpk * (zk[i] - zk[i + 1]) + mnk * (zk[i + 2] - zk[i + 1]);
            const float v = zv[i + 1] + mpv * (zv[i] - zv[i + 1]) + mnv * (zv[i + 2] - zv[i + 1]);
            const float kr = k * kk_; const float nrm = sqrtf(wave_sum(kr * kr)); const float kk = kr / fmaxf(nrm, 1e-12f);
            const bf16* lp = LO + (lrow + i) * LORA_N + hc;
            const float wl0 = bf1(lp[0]), wl1 = bf1(lp[DR]), al0 = bf1(lp[2 * DR]), al1 = bf1(lp[3 * DR]);
            const float aa0 = sigm(a00 + al0), aa1 = sigm(a01 + al1);
            o_r[i] = r; o_v[i] = v; o_na[i] = -kk;
            o_w[0][i] = __expf(-0.6065306597f * sigm(w00 + wl0)); o_w[1][i] = __expf(-0.6065306597f * sigm(w01 + wl1));
            o_b[0][i] = kk * aa0; o_b[1][i] = kk * aa1;
            o_kd[0][i] = k * (1.f + (aa0 - 1.f) * ka_); o_kd[1][i] = k * (1.f + (aa1 - 1.f) * ka_);
            if (lat) { const float s = wave_sum(r * (o_kd[0][i] + o_kd[1][i]) * rk_); if (c.lane == 0) RK[(rowbase + i) * NH + h] = s;
                VS[(rowbase + i) * DR + hc] = (bf16)f2bf(v); }
        }
        unsigned char* rec = SC + (size_t)it * SC_REC;
        auto pk = [](const float (&x)[8]) { u32x4 o; o.x = cvt_pk_bf16(x[0], x[1]); o.y = cvt_pk_bf16(x[2], x[3]); o.z = cvt_pk_bf16(x[4], x[5]); o.w = cvt_pk_bf16(x[6], x[7]); return o; };
        *(u32x4*)(rec + 0 + 16 * c.lane) = pk(o_r); *(u32x4*)(rec + 1024 + 16 * c.lane) = pk(o_v); *(u32x4*)(rec + 2048 + 16 * c.lane) = pk(o_na);
#pragma unroll
        for (int d = 0; d < 2; ++d) { unsigned char* dr = rec + 3072 + 4096 * d;
            *(f32x4*)(dr + 32 * c.lane) = (f32x4){o_w[d][0], o_w[d][1], o_w[d][2], o_w[d][3]}; *(f32x4*)(dr + 32 * c.lane + 16) = (f32x4){o_w[d][4], o_w[d][5], o_w[d][6], o_w[d][7]};
            *(u32x4*)(dr + 2048 + 16 * c.lane) = pk(o_b[d]); *(u32x4*)(dr + 3072 + 16 * c.lane) = pk(o_kd[d]); }
    }
}

constexpr int SCH = 16, SBUF = SCH * 1280 + 256, SNB = 3, S_FULL = SNB * SBUF, S_DONE = S_FULL + 64;
struct RawOct { u32x4 r, v, na, b, kd; f32x4 w0, w1; };
__device__ __forceinline__ RawOct scan_load(const unsigned char* SCb, int p, int d, int lane) {
    const int oct = d == 0 ? p : (p < 32 ? 31 - p : 319 - p);
    const unsigned char* rec = SCb + (size_t)oct * SC_REC; const unsigned char* dr = rec + 3072 + 4096 * d;
    RawOct o; o.r = *(const u32x4*)(rec + 16 * lane); o.v = *(const u32x4*)(rec + 1024 + 16 * lane); o.na = *(const u32x4*)(rec + 2048 + 16 * lane);
    o.w0 = *(const f32x4*)(dr + 32 * lane); o.w1 = *(const f32x4*)(dr + 32 * lane + 16); o.b = *(const u32x4*)(dr + 2048 + 16 * lane); o.kd = *(const u32x4*)(dr + 3072 + 16 * lane);
    return o;
}
__device__ __forceinline__ float dpp_xor1(float x) { return __builtin_bit_cast(float, __builtin_amdgcn_update_dpp(0, __builtin_bit_cast(int, x), 0xB1, 0xf, 0xf, true)); }
__device__ __forceinline__ float dpp_xor2(float x) { return __builtin_bit_cast(float, __builtin_amdgcn_update_dpp(0, __builtin_bit_cast(int, x), 0x4E, 0xf, 0xf, true)); }
__device__ __forceinline__ float dpp_hmir(float x) { return __builtin_bit_cast(float, __builtin_amdgcn_update_dpp(0, __builtin_bit_cast(int, x), 0x141, 0xf, 0xf, true)); }
__device__ __forceinline__ float red8(float x) { x += dpp_xor1(x); x += dpp_xor2(x); x += dpp_hmir(x); return x; }

__device__ __forceinline__ void p6_scan(const Params& p, const Ctx& c) {
    LAS unsigned char* L = c.lds; volatile LAS unsigned* full = (volatile LAS unsigned*)(L + S_FULL); volatile LAS unsigned* done = (volatile LAS unsigned*)(L + S_DONE);
    float* Y = (float*)(p.ws + WS_Y);
    for (int sid = c.bid; sid < NB * NH * 2; sid += c.G) {
        if (c.tid < 8) { full[c.tid] = 0u; done[c.tid] = 0u; }
        __syncthreads();
        const int d = sid & 1, bh = sid >> 1, h = bh % NH, b = bh / NH;
        constexpr int NCH = (CTXL + SEQ) / SCH;
        if (c.wave == 4) {
            const unsigned char* SCb = p.ws + WS_SC + (size_t)bh * NOCT * SC_REC;
            RawOct ring[4];
#pragma unroll
            for (int j = 0; j < 4; ++j) ring[j] = scan_load(SCb, j, d, c.lane);
            float gam = 1.f;
            for (int p0 = 0; p0 < NOCT; p0 += 4) {
#pragma unroll
                for (int j = 0; j < 4; ++j) {
                    const int pp = p0 + j, ch = pp >> 1, oi = pp & 1, buf = ch % SNB;
                    if (oi == 0 && ch >= SNB) { const unsigned want = 4u * (unsigned)(ch / SNB); unsigned sp = 0; while (done[buf] < want) { __builtin_amdgcn_s_sleep(1); if (++sp > (1u << 24)) break; } }
                    const RawOct o = ring[j];
                    if (pp + 4 < NOCT) ring[j] = scan_load(SCb, pp + 4, d, c.lane);
                    const unsigned rr[4] = {o.r.x, o.r.y, o.r.z, o.r.w}, vv[4] = {o.v.x, o.v.y, o.v.z, o.v.w}, nn[4] = {o.na.x, o.na.y, o.na.z, o.na.w}, bb[4] = {o.b.x, o.b.y, o.b.z, o.b.w}, kk[4] = {o.kd.x, o.kd.y, o.kd.z, o.kd.w};
                    const float ww[8] = {o.w0[0], o.w0[1], o.w0[2], o.w0[3], o.w1[0], o.w1[1], o.w1[2], o.w1[3]};
                    LAS float* dst = (LAS float*)(L + buf * SBUF + oi * 8 * 1280) + c.lane;
#pragma unroll
                    for (int i = 0; i < 8; ++i) {
                        const int ia = i, ib = 7 - i;
                        const float r_ = d ? ((ib & 1) ? bfhi(rr[ib >> 1]) : bflo(rr[ib >> 1])) : ((ia & 1) ? bfhi(rr[ia >> 1]) : bflo(rr[ia >> 1]));
                        const float v_ = d ? ((ib & 1) ? bfhi(vv[ib >> 1]) : bflo(vv[ib >> 1])) : ((ia & 1) ? bfhi(vv[ia >> 1]) : bflo(vv[ia >> 1]));
                        const float n_ = d ? ((ib & 1) ? bfhi(nn[ib >> 1]) : bflo(nn[ib >> 1])) : ((ia & 1) ? bfhi(nn[ia >> 1]) : bflo(nn[ia >> 1]));
                        const float b_ = d ? ((ib & 1) ? bfhi(bb[ib >> 1]) : bflo(bb[ib >> 1])) : ((ia & 1) ? bfhi(bb[ia >> 1]) : bflo(bb[ia >> 1]));
                        const float k_ = d ? ((ib & 1) ? bfhi(kk[ib >> 1]) : bflo(kk[ib >> 1])) : ((ia & 1) ? bfhi(kk[ia >> 1]) : bflo(kk[ia >> 1]));
                        const float w_ = d ? ww[ib] : ww[ia];
                        const float gprev = gam; gam *= w_; const float inv = __builtin_amdgcn_rcpf(gam);
                        LAS float* s = dst + i * 320;
                        s[0] = gprev * n_; s[64] = b_ * inv; s[128] = k_ * inv; s[192] = gam * r_; s[256] = v_;
                    }
                    if (oi == 1) { ((LAS float*)(L + buf * SBUF + SCH * 1280))[c.lane] = gam; gam = 1.f;
                        asm volatile("s_waitcnt lgkmcnt(0)" ::: "memory");
                        if (c.lane == 0) full[buf] = (unsigned)(ch + 1); }
                }
            }
        } else if (c.wave < 4) {
            const int vp = c.lane >> 3, q = c.lane & 7, v0 = 16 * c.wave + 2 * vp;
            float S0[8], S1[8];
#pragma unroll
            for (int j = 0; j < 8; ++j) { S0[j] = 0.f; S1[j] = 0.f; }
            for (int ch = 0; ch < NCH; ++ch) {
                const int buf = ch % SNB; { unsigned sp = 0; while (full[buf] != (unsigned)(ch + 1)) { __builtin_amdgcn_s_sleep(1); if (++sp > (1u << 24)) break; } }
                const LAS unsigned char* base = L + buf * SBUF;
                const bool lat = ch >= CTXL / SCH;
#pragma unroll 4
                for (int s = 0; s < SCH; ++s) {
                    const LAS unsigned char* sb = base + s * 1280 + 32 * q;
                    const f32x4 a0 = *(const LAS f32x4*)(sb), a1 = *(const LAS f32x4*)(sb + 16), b0 = *(const LAS f32x4*)(sb + 256), b1 = *(const LAS f32x4*)(sb + 272);
                    const f32x4 k0 = *(const LAS f32x4*)(sb + 512), k1 = *(const LAS f32x4*)(sb + 528), r0 = *(const LAS f32x4*)(sb + 768), r1 = *(const LAS f32x4*)(sb + 784);
                    const f32x2 vv = *(const LAS f32x2*)(base + s * 1280 + 1024 + 4 * v0);
                    const float A[8] = {a0[0], a0[1], a0[2], a0[3], a1[0], a1[1], a1[2], a1[3]}, Bc[8] = {b0[0], b0[1], b0[2], b0[3], b1[0], b1[1], b1[2], b1[3]};
                    const float Kc[8] = {k0[0], k0[1], k0[2], k0[3], k1[0], k1[1], k1[2], k1[3]}, Rc[8] = {r0[0], r0[1], r0[2], r0[3], r1[0], r1[1], r1[2], r1[3]};
                    float p0 = 0.f, p1 = 0.f;
#pragma unroll
                    for (int j = 0; j < 8; ++j) { p0 += S0[j] * A[j]; p1 += S1[j] * A[j]; }
                    p0 = red8(p0); p1 = red8(p1);
#pragma unroll
                    for (int j = 0; j < 8; ++j) { S0[j] += p0 * Bc[j] + vv[0] * Kc[j]; S1[j] += p1 * Bc[j] + vv[1] * Kc[j]; }
                    if (lat) { float y0 = 0.f, y1 = 0.f;
#pragma unroll
                        for (int j = 0; j < 8; ++j) { y0 += S0[j] * Rc[j]; y1 += S1[j] * Rc[j]; }
                        y0 = red8(y0); y1 = red8(y1);
                        if (q == 0) { const int P = ch * SCH + s - CTXL; const int t = d == 0 ? P : SEQ - 1 - P;
                            *(f32x2*)(Y + ((size_t)d * TL + (size_t)b * SEQ + t) * DR + h * HS + v0) = (f32x2){y0, y1}; } }
                }
                const f32x4 g0 = *(const LAS f32x4*)(base + SCH * 1280 + 32 * q), g1 = *(const LAS f32x4*)(base + SCH * 1280 + 32 * q + 16);
                const float Gm[8] = {g0[0], g0[1], g0[2], g0[3], g1[0], g1[1], g1[2], g1[3]};
#pragma unroll
                for (int j = 0; j < 8; ++j) { S0[j] *= Gm[j]; S1[j] *= Gm[j]; }
                asm volatile("s_waitcnt lgkmcnt(0)" ::: "memory");
                if (c.lane == 0) __hip_atomic_fetch_add((LAS unsigned*)(L + S_DONE) + buf, 1u, __ATOMIC_RELAXED, __HIP_MEMORY_SCOPE_WORKGROUP);
            }
        }
        __syncthreads();
    }
}

__device__ __forceinline__ void p7_rwkvout(const Params& p, const Ctx& c) {
    const float* Y = (const float*)(p.ws + WS_Y); const float* RK = (const float*)(p.ws + WS_RK); const bf16* VS = (const bf16*)(p.ws + WS_VS);
    const bf16* LO = (const bf16*)(p.ws + WS_LORA); bf16* AR = (bf16*)(p.ws + WS_ARWKV);
    const int c0 = 16 * c.lane, hd = c.lane >> 2;
    f32x4 g[4], bb[4];
#pragma unroll
    for (int q = 0; q < 4; ++q) { g[q] = *(const f32x4*)(p.in[I_LNXG] + c0 + 4 * q); bb[q] = *(const f32x4*)(p.in[I_LNXB] + c0 + 4 * q); }
    for (int row = c.gw; row < TL; row += c.NGW) {
        f32x4 y[4]; float s = 0.f;
#pragma unroll
        for (int q = 0; q < 4; ++q) { y[q] = *(const f32x4*)(Y + (size_t)row * DR + c0 + 4 * q) + *(const f32x4*)(Y + ((size_t)TL + row) * DR + c0 + 4 * q); s += (y[q][0] + y[q][1]) + (y[q][2] + y[q][3]); }
        s += __shfl_xor(s, 1); s += __shfl_xor(s, 2); const float mean = s * (1.f / HS); float s2 = 0.f;
#pragma unroll
        for (int q = 0; q < 4; ++q) { y[q] = y[q] - mean; s2 += (y[q][0] * y[q][0] + y[q][1] * y[q][1]) + (y[q][2] * y[q][2] + y[q][3] * y[q][3]); }
        s2 += __shfl_xor(s2, 1); s2 += __shfl_xor(s2, 2); const float rstd = __builtin_amdgcn_rsqf(s2 * (1.f / HS) + GN_EPS);
        const float rk = RK[(size_t)row * NH + hd];
        f32x4 v[4], gt[4];
        unpack8(*(const u32x4*)(VS + (size_t)row * DR + c0), v[0], v[1]); unpack8(*(const u32x4*)(VS + (size_t)row * DR + c0 + 8), v[2], v[3]);
        unpack8(*(const u32x4*)(LO + (size_t)row * LORA_N + 4 * DR + c0), gt[0], gt[1]); unpack8(*(const u32x4*)(LO + (size_t)row * LORA_N + 4 * DR + c0 + 8), gt[2], gt[3]);
#pragma unroll
        for (int q = 0; q < 4; ++q) y[q] = (y[q] * rstd * g[q] + bb[q] + v[q] * rk) * gt[q];
        bf16* o = AR + (size_t)row * DR + c0; *(u32x4*)o = pg8::pack8(y[0], y[1]); *(u32x4*)(o + 8) = pg8::pack8(y[2], y[3]);
    }
}

__device__ __forceinline__ void p10_router(const Params& p, const Ctx& c) {
    const float* T1 = (const float*)(p.ws + WS_T1); float* XM = (float*)(p.ws + WS_XMID); bf16* UH = (bf16*)(p.ws + WS_U2HI); bf16* UL = (bf16*)(p.ws + WS_U2LO);
    const float* mod = (const float*)(p.ws + WS_MOD); const bf16* WRt = (const bf16*)(p.ws + WS_WR);
    unsigned* cntg = (unsigned*)(p.ws + WS_CTL) + CW_CNT; int* rowtok = (int*)(p.ws + WS_ROWTOK); float* roww = (float*)(p.ws + WS_ROWW); unsigned* sel = (unsigned*)(p.ws + WS_SEL);
    for (int un = c.bid; un < TL / 64; un += c.G) {
        const int r0 = un * 64, b = r0 / SEQ;
        const float* sh = mod + (size_t)b * (6 * D) + 3 * D; const float* sc = sh + D;
        for (int i = 0; i < 8; ++i) { const int row = r0 + c.wave * 8 + i;
            f32x4 v[8]; float s = 0.f;
#pragma unroll
            for (int j = 0; j < 8; ++j) { v[j] = *(const f32x4*)(T1 + (size_t)row * D + 4 * c.lane + 256 * j); s += (v[j][0] + v[j][1]) + (v[j][2] + v[j][3]); }
            float mean = wave_sum(s) * (1.f / D), s2 = 0.f;
#pragma unroll
            for (int j = 0; j < 8; ++j) { v[j] = v[j] - mean; s2 += (v[j][0] * v[j][0] + v[j][1] * v[j][1]) + (v[j][2] * v[j][2] + v[j][3] * v[j][3]); }
            float rstd = __builtin_amdgcn_rsqf(wave_sum(s2) * (1.f / D) + LN_EPS); s = 0.f;
#pragma unroll
            for (int j = 0; j < 8; ++j) { const int col = 4 * c.lane + 256 * j; v[j] = v[j] * rstd * *(const f32x4*)(p.in[I_LN1G] + col) + *(const f32x4*)(p.in[I_LN1B] + col);
                *(f32x4*)(XM + (size_t)row * D + col) = v[j]; s += (v[j][0] + v[j][1]) + (v[j][2] + v[j][3]); }
            mean = wave_sum(s) * (1.f / D); s2 = 0.f;
#pragma unroll
            for (int j = 0; j < 8; ++j) { v[j] = v[j] - mean; s2 += (v[j][0] * v[j][0] + v[j][1] * v[j][1]) + (v[j][2] * v[j][2] + v[j][3] * v[j][3]); }
            rstd = __builtin_amdgcn_rsqf(wave_sum(s2) * (1.f / D) + LN_EPS);
#pragma unroll
            for (int j = 0; j < 8; ++j) { const int col = 4 * c.lane + 256 * j; const f32x4 o = v[j] * rstd * (*(const f32x4*)(sc + col) + 1.0f) + *(const f32x4*)(sh + col);
                u32x2 hi; hi.x = cvt_pk_bf16(o[0], o[1]); hi.y = cvt_pk_bf16(o[2], o[3]);
                u32x2 lo; lo.x = cvt_pk_bf16(o[0] - bflo(hi.x), o[1] - bfhi(hi.x)); lo.y = cvt_pk_bf16(o[2] - bflo(hi.y), o[3] - bfhi(hi.y));
                *(u32x2*)(UH + (size_t)row * D + col) = hi; *(u32x2*)(UL + (size_t)row * D + col) = lo; }
        }
        asm volatile("s_waitcnt vmcnt(0)" ::: "memory");
        __syncthreads();
        if (c.wave < 4) {
            const int tr = r0 + 16 * c.wave + (c.lane & 15), kq = 8 * (c.lane >> 4);
            f32x4 acc0 = (f32x4){0.f, 0.f, 0.f, 0.f}, acc1 = acc0;
            const bf16* ah = UH + (size_t)tr * D + kq; const bf16* al = UL + (size_t)tr * D + kq;
            const bf16* bh0 = WRt + (size_t)(c.lane & 15) * D + kq; const bf16* bh1 = bh0 + 16 * D; const bf16* bl0 = bh0 + NE * D; const bf16* bl1 = bl0 + 16 * D;
#pragma unroll 4
            for (int s = 0; s < D / 32; ++s) {
                const bf16x8 xh = *(const bf16x8*)(ah + 32 * s), xl = *(const bf16x8*)(al + 32 * s);
                const bf16x8 wh0 = *(const bf16x8*)(bh0 + 32 * s), wh1 = *(const bf16x8*)(bh1 + 32 * s), wl0 = *(const bf16x8*)(bl0 + 32 * s), wl1 = *(const bf16x8*)(bl1 + 32 * s);
                acc0 = __builtin_amdgcn_mfma_f32_16x16x32_bf16(xh, wh0, acc0, 0, 0, 0); acc1 = __builtin_amdgcn_mfma_f32_16x16x32_bf16(xh, wh1, acc1, 0, 0, 0);
                acc0 = __builtin_amdgcn_mfma_f32_16x16x32_bf16(xl, wh0, acc0, 0, 0, 0); acc1 = __builtin_amdgcn_mfma_f32_16x16x32_bf16(xl, wh1, acc1, 0, 0, 0);
                acc0 = __builtin_amdgcn_mfma_f32_16x16x32_bf16(xh, wl0, acc0, 0, 0, 0); acc1 = __builtin_amdgcn_mfma_f32_16x16x32_bf16(xh, wl1, acc1, 0, 0, 0);
            }
            LAS float* lg = (LAS float*)(c.lds + c.wave * 2048);
            const float br0 = p.in[I_BROUTER][c.lane & 15], br1 = p.in[I_BROUTER][16 + (c.lane & 15)];
#pragma unroll
            for (int i = 0; i < 4; ++i) { const int tk = (c.lane >> 4) * 4 + i; lg[tk * 32 + (c.lane & 15)] = acc0[i] + br0; lg[tk * 32 + 16 + (c.lane & 15)] = acc1[i] + br1; }
            asm volatile("s_waitcnt lgkmcnt(0)" ::: "memory");
            if (c.lane < 16) {
                float l[32];
#pragma unroll
                for (int q = 0; q < 8; ++q) { const f32x4 t = *(const LAS f32x4*)(lg + c.lane * 32 + 4 * q); l[4 * q] = t[0]; l[4 * q + 1] = t[1]; l[4 * q + 2] = t[2]; l[4 * q + 3] = t[3]; }
                unsigned used = 0u; float tv[4]; int ti[4];
#pragma unroll
                for (int s = 0; s < 4; ++s) { float best = -3.0e38f; int bi = 0;
#pragma unroll
                    for (int e = 0; e < 32; ++e) { const bool ok = !((used >> e) & 1u) && (l[e] > best); best = ok ? l[e] : best; bi = ok ? e : bi; }
                    used |= 1u << bi; tv[s] = best; ti[s] = bi; }
                const float e1 = __expf(tv[1] - tv[0]), e2 = __expf(tv[2] - tv[0]), e3 = __expf(tv[3] - tv[0]); const float inv = 1.f / (1.f + e1 + e2 + e3);
                const float gw[4] = {inv, e1 * inv, e2 * inv, e3 * inv};
                const int row = r0 + 16 * c.wave + c.lane;
#pragma unroll
                for (int s = 0; s < 4; ++s) { const unsigned j = __hip_atomic_fetch_add(cntg + 16 * ti[s], 1u, RLX_AGENT);
                    rowtok[(size_t)ti[s] * ECAP + j] = row; roww[(size_t)ti[s] * ECAP + j] = gw[s]; sel[row * 4 + s] = ((unsigned)ti[s] << 16) | j; }
            }
        }
        __syncthreads();
    }
}
__device__ __forceinline__ void moe_plan(const Params& p, const Ctx& c) {
    LAS int* cnt = (LAS int*)(c.lds + LX_CNT); LAS int* tst = (LAS int*)(c.lds + LX_TST); LAS unsigned char* te = (LAS unsigned char*)(c.lds + LX_TE);
    const unsigned* cntg = (const unsigned*)(p.ws + WS_CTL) + CW_CNT;
    __syncthreads();
    if (c.tid < NE) cnt[c.tid] = (int)__hip_atomic_load(cntg + 16 * c.tid, RLX_AGENT);
    __syncthreads();
    if (c.tid == 0) { int a = 0; for (int e = 0; e < NE; ++e) { tst[e] = a; a += (cnt[e] + 255) >> 8; } tst[NE] = a; }
    __syncthreads();
    if (c.tid < NE) { for (int t = tst[c.tid]; t < tst[c.tid + 1]; ++t) te[t] = (unsigned char)c.tid; }
    __syncthreads();
}
__device__ __forceinline__ void p13_final(const Params& p, const Ctx& c) {
    const float* XM = (const float*)(p.ws + WS_XMID); const bf16* DN = (const bf16*)(p.ws + WS_DOWN); const unsigned* sel = (const unsigned*)(p.ws + WS_SEL);
    const float* mod = (const float*)(p.ws + WS_MOD); const LAS int* tst = (const LAS int*)(c.lds + LX_TST);
    for (int row = c.gw; row < TL; row += c.NGW) {
        const int b = row / SEQ; const float* gate = mod + (size_t)b * (6 * D) + 5 * D;
        f32x4 a[4][2];
#pragma unroll
        for (int j = 0; j < 4; ++j) { a[j][0] = (f32x4){0.f, 0.f, 0.f, 0.f}; a[j][1] = a[j][0]; }
#pragma unroll
        for (int s = 0; s < 4; ++s) { const unsigned sv = sel[row * 4 + s]; const int e = (int)(sv >> 16), jj = (int)(sv & 0xffffu); const size_t pos = (size_t)tst[e] * 256 + jj;
#pragma unroll
            for (int j = 0; j < 4; ++j) { f32x4 x0, x1; pg8::unpack8(*(const u32x4*)(DN + pos * D + 8 * c.lane + 512 * j), x0, x1); a[j][0] += x0; a[j][1] += x1; } }
        float s = 0.f;
#pragma unroll
        for (int j = 0; j < 4; ++j)
#pragma unroll
            for (int hh = 0; hh < 2; ++hh) { const int col = 8 * c.lane + 512 * j + 4 * hh; a[j][hh] = *(const f32x4*)(XM + (size_t)row * D + col) * DN_ALPHA + *(const f32x4*)(gate + col) * a[j][hh];
                s += (a[j][hh][0] + a[j][hh][1]) + (a[j][hh][2] + a[j][hh][3]); }
        const float mean = wave_sum(s) * (1.f / D); float s2 = 0.f;
#pragma unroll
        for (int j = 0; j < 4; ++j)
#pragma unroll
            for (int hh = 0; hh < 2; ++hh) { a[j][hh] = a[j][hh] - mean; s2 += (a[j][hh][0] * a[j][hh][0] + a[j][hh][1] * a[j][hh][1]) + (a[j][hh][2] * a[j][hh][2] + a[j][hh][3] * a[j][hh][3]); }
        const float rstd = __builtin_amdgcn_rsqf(wave_sum(s2) * (1.f / D) + LN_EPS);
#pragma unroll
        for (int j = 0; j < 4; ++j)
#pragma unroll
            for (int hh = 0; hh < 2; ++hh) { const int col = 8 * c.lane + 512 * j + 4 * hh;
                *(f32x4*)(p.out + (size_t)row * D + col) = a[j][hh] * rstd * *(const f32x4*)(p.in[I_LN2G] + col) + *(const f32x4*)(p.in[I_LN2B] + col); }
    }
}

constexpr int N_PHASES = 14;
__global__ void __launch_bounds__(512, 2) fwd(Params p) {
    extern __shared__ __attribute__((aligned(16))) unsigned char lds_raw[];
    Ctx c; c.lds = (LAS unsigned char*)lds_raw; c.tid = threadIdx.x; c.lane = c.tid & 63; c.wave = __builtin_amdgcn_readfirstlane(c.tid >> 6);
    c.G = gridDim.x; c.bid = blockIdx.x; c.gw = c.bid * 8 + c.wave; c.NGW = c.G * 8;
    unsigned char* ws = p.ws;
    const int lo = p.ph_lo, hi = p.ph_hi;
    volatile LAS unsigned* MISC = (volatile LAS unsigned*)(c.lds + LX_MISC);
    if (c.tid < 64) MISC[c.tid] = 0u;
    __syncthreads();
    XcdBarrier bar; bar.bar = (unsigned*)(ws + WS_CTL) + CW_BAR; bar.x = 0; bar.st = nullptr;
    if (hi - lo > 1) bar = xcd_barrier_post((unsigned*)(ws + WS_CTL) + CW_BAR, MISC + 8);
#ifndef ONLY_PHASE
#define ONLY_PHASE -1
#endif
#define IN(k) ((ONLY_PHASE < 0 || ONLY_PHASE == (k)) && lo <= (k) && (k) < hi)
#define SEAM(k) do { if (IN(k) && IN((k) + 1)) xcd_barrier(bar); } while (0)
    LAS unsigned char* ring = c.lds;

    if (IN(0)) { p0_adaln(p, c); p0_small(p, c); p0_convert(p, c); } SEAM(0);
    if (IN(1)) { p1_modulate(p, c); } SEAM(1);
    if (IN(2)) { pg8::InProjSched S{(const bf16*)(ws + WS_U), (const bf16*)(ws + WS_WIN), c.G, c.bid};
        pg8::EpiInProj E{(bf16*)(ws + WS_ZL), (bf16*)(ws + WS_ZC), (const float*)(ws + WS_BIN)};
        pg8::gemm_phase<pg8::EpiInProj, pg8::InProjSched, false>(ring, D, S, E, nullptr); } SEAM(2);
    if (IN(3)) { p3_conv(p, c); p3_alora(p, c); } SEAM(3);
    if (IN(4)) {
        { pg8::PlainSched S{(const bf16*)(ws + WS_ALORA), (const bf16*)(ws + WS_WLORA), LORA_K, TT / 256, LORA_N / 256, c.G, c.bid};
          pg8::EpiBf16Plain E{(bf16*)(ws + WS_LORA), LORA_N, nullptr};
          pg8::gemm_phase<pg8::EpiBf16Plain, pg8::PlainSched, false>(ring, LORA_K, S, E, nullptr); }
        { pg8::PlainSched S{(const bf16*)(ws + WS_ACONV), (const bf16*)(ws + WS_WCO), DCV, TL / 256, D / 256, c.G, c.bid};
          pg8::EpiConvO E{(bf16*)(ws + WS_MIX), (const bf16*)(ws + WS_ZL), p.in[I_BCO]};
          pg8::gemm_phase<pg8::EpiConvO, pg8::PlainSched, false>(ring, DCV, S, E, nullptr); }
    } SEAM(4);
    if (IN(5)) { p5_prep(p, c); } SEAM(5);
    if (IN(6)) { p6_scan(p, c); } SEAM(6);
    if (IN(7)) { p7_rwkvout(p, c); } SEAM(7);
    if (IN(8)) { pg8::PlainSched S{(const bf16*)(ws + WS_ARWKV), (const bf16*)(ws + WS_WRO), DR, TL / 256, D / 256, c.G, c.bid};
        pg8::EpiRwkvO E{(bf16*)(ws + WS_MIX), (const bf16*)(ws + WS_ZL)};
        pg8::gemm_phase<pg8::EpiRwkvO, pg8::PlainSched, false>(ring, DR, S, E, nullptr); } SEAM(8);
    if (IN(9)) { pg8::PlainSched S{(const bf16*)(ws + WS_MIX), (const bf16*)(ws + WS_WOUT), D, TL / 256, D / 256, c.G, c.bid};
        pg8::EpiOut E{(float*)(ws + WS_T1), p.in[I_X], (const float*)(ws + WS_MOD), p.in[I_BOUT]};
        pg8::gemm_phase<pg8::EpiOut, pg8::PlainSched, false>(ring, D, S, E, nullptr); } SEAM(9);
    if (IN(10)) { p10_router(p, c); } SEAM(10);
    if (IN(11)) { moe_plan(p, c);
        pg8::MoeSched S{nullptr, (const bf16*)(ws + WS_WGU), (const int*)(ws + WS_ROWTOK), D, 4096, 16, c.G, c.bid, (const LAS int*)(c.lds + LX_CNT), (const LAS int*)(c.lds + LX_TST), (const LAS unsigned char*)(c.lds + LX_TE)};
        pg8::EpiGateUp E{(bf16*)(ws + WS_HID), (const float*)(ws + WS_BGU)};
        pg8::gemm_phase<pg8::EpiGateUp, pg8::MoeSched, true>(ring, D, S, E, (const char*)(ws + WS_U2HI)); } SEAM(11);
    if (IN(12)) { moe_plan(p, c);
        pg8::MoeSched S{(const bf16*)(ws + WS_HID), (const bf16*)(ws + WS_WDN), (const int*)(ws + WS_ROWTOK), D, D, 8, c.G, c.bid, (const LAS int*)(c.lds + LX_CNT), (const LAS int*)(c.lds + LX_TST), (const LAS unsigned char*)(c.lds + LX_TE)};
        pg8::EpiDown E{(bf16*)(ws + WS_DOWN), p.in[I_BDN], (const float*)(ws + WS_ROWW), (const LAS int*)(c.lds + LX_CNT)};
        pg8::gemm_phase<pg8::EpiDown, pg8::MoeSched, false>(ring, D, S, E, nullptr); } SEAM(12);
    if (IN(13)) { moe_plan(p, c); p13_final(p, c); }
#undef IN
#undef SEAM
}

extern "C" void kernel_launch(void* const* d_in, const int* in_sizes, int n_in, void* d_out, int out_size, void* d_ws, size_t ws_size, hipStream_t stream) {
    static int grid = 0;
    if (grid == 0) {
        if (n_in != 38 || out_size != TL * D || ws_size < WS_END) { fprintf(stderr, "kernel_launch: unexpected shapes: n_in %d out %d ws %zu (need %zu)\n", n_in, out_size, ws_size, (size_t)WS_END); grid = -1; return; }
        int dev = 0, cus = 0, per_cu = 0;
        if (hipGetDevice(&dev) != hipSuccess || hipDeviceGetAttribute(&cus, hipDeviceAttributeMultiprocessorCount, dev) != hipSuccess) { grid = -1; return; }
        if (hipFuncSetAttribute((const void*)fwd, hipFuncAttributeMaxDynamicSharedMemorySize, LDS_BYTES) != hipSuccess) { fprintf(stderr, "kernel_launch: hipFuncSetAttribute failed\n"); grid = -1; return; }
        if (hipOccupancyMaxActiveBlocksPerMultiprocessor(&per_cu, (const void*)fwd, 512, LDS_BYTES) != hipSuccess || per_cu < 1) { fprintf(stderr, "kernel_launch: occupancy query says %d\n", per_cu); }
        (void)hipGetLastError();
        grid = cus;
    }
    if (grid < 0) return;
    (void)in_sizes;
    (void)hipMemsetAsync((char*)d_ws + WS_CTL, 0, CTL_ZERO_BYTES, stream);
    Params p; memset(&p, 0, sizeof(p));
    for (int i = 0; i < 38; ++i) p.in[i] = (const float*)d_in[i];
    p.out = (float*)d_out; p.ws = (unsigned char*)d_ws;
#if MK_FUSED
    p.ph_lo = 0; p.ph_hi = N_PHASES;
    hipLaunchKernelGGL(fwd, dim3(grid), dim3(512), LDS_BYTES, stream, p);
#else
    for (int k = 0; k < N_PHASES; ++k) { p.ph_lo = k; p.ph_hi = k + 1; hipLaunchKernelGGL(fwd, dim3(grid), dim3(512), LDS_BYTES, stream, p); }
#endif
}
```

```cpp
#include <hip/hip_runtime.h>
#include <cstdio>
#include <cstdint>
#include <cstring>

#ifndef CONV_IN_SCAN
#define CONV_IN_SCAN 1
#endif
#ifndef MK_FUSED
#define MK_FUSED 1
#endif

#define GAS __attribute__((address_space(1)))
#define LAS __attribute__((address_space(3)))
typedef unsigned short bf16;
typedef short bf16x8 __attribute__((ext_vector_type(8)));
typedef float f32x4 __attribute__((ext_vector_type(4)));
typedef float f32x2 __attribute__((ext_vector_type(2)));
typedef unsigned u32x4 __attribute__((ext_vector_type(4)));
typedef unsigned u32x2 __attribute__((ext_vector_type(2)));

constexpr int D = 2048, NB = 8, SEQ = 2048, CTXL = 256, TL = NB * SEQ, TC = NB * CTXL, TT = TL + TC;
constexpr int DCV = 1024, DR = 1024, NH = 16, HS = 64, CWID = 31;
constexpr int DSHIFT = 3488, PIN = 9632;
constexpr int ZN = 9728, ZCN = 3584, ZR0 = 2048, ZG0 = 5632;
constexpr int NE = 32, ECAP = 16384, MAXMT = 288;
constexpr int LORA_K = 512, LORA_N = 5120;
constexpr int SCH = 16, NCHUNK = (CTXL + SEQ) / SCH, SBUF = SCH * 1280 + 256;
constexpr float LN_EPS = 1e-5f, GN_EPS = 64e-5f, DN_ALPHA = 1.189207115002721f;
constexpr float SW_LIMIT = 7.0f, SW_ALPHA = 1.702f;

constexpr size_t MiB = 1u << 20;
constexpr size_t WS_CTL = 0, CTL_ZERO_BYTES = 1 * MiB;
constexpr size_t WS_MOD = 1 * MiB, WS_BIN = 2 * MiB, WS_BGU = 2 * MiB + 65536, WS_WR = 3 * MiB, WS_SEL = 4 * MiB, WS_RK = 5 * MiB;
constexpr size_t WS_ROWTOK = 6 * MiB, WS_ROWW = 8 * MiB, WS_WCO = 10 * MiB, WS_WRO = 14 * MiB, WS_WOUT = 18 * MiB, WS_WLORA = 26 * MiB;
constexpr size_t WS_WIN = 32 * MiB, WS_U = 70 * MiB, WS_ACONV = 142 * MiB, WS_ALORA = 174 * MiB, WS_ARWKV = 192 * MiB, WS_VS = 224 * MiB;
constexpr size_t WS_MIX = 256 * MiB, WS_U2HI = 320 * MiB, WS_U2LO = 384 * MiB, WS_T1 = 448 * MiB, WS_XMID = 576 * MiB, WS_Y = 704 * MiB;
constexpr size_t WS_ZC = 832 * MiB, WS_LORA = 848 * MiB, WS_ZL = 1028 * MiB, WS_SC = 1332 * MiB, WS_WGU = 1728 * MiB, WS_WDN = 2240 * MiB;
constexpr size_t WS_HID = 2496 * MiB, WS_DOWN = 2784 * MiB, WS_SC2 = 3072 * MiB, WS_END = 3804 * MiB;
constexpr int CW_BAR = 4096;
constexpr int CW_CNT = 1024;

constexpr int RING_BYTES = 131072;
constexpr int LDSX_OFF = RING_BYTES;
constexpr int LX_MISC = LDSX_OFF;
constexpr int LX_CNT = LDSX_OFF + 256;
constexpr int LX_TST = LDSX_OFF + 512;
constexpr int LX_TE = LDSX_OFF + 768;
constexpr int LDS_BYTES = 147456;

__device__ __forceinline__ unsigned f2bf(float f) { unsigned u = __builtin_bit_cast(unsigned, f); return (u + 0x7fffu + ((u >> 16) & 1u)) >> 16; }
__device__ __forceinline__ unsigned cvt_pk_bf16(float lo, float hi) { unsigned r; asm volatile("v_cvt_pk_bf16_f32 %0, %1, %2" : "=v"(r) : "v"(lo), "v"(hi)); return r; }
__device__ __forceinline__ float bflo(unsigned u) { return __builtin_bit_cast(float, u << 16); }
__device__ __forceinline__ float bfhi(unsigned u) { return __builtin_bit_cast(float, u & 0xffff0000u); }
__device__ __forceinline__ float bf1(bf16 h) { return __builtin_bit_cast(float, ((unsigned)h) << 16); }
__device__ __forceinline__ float sigm(float x) { return __builtin_amdgcn_rcpf(1.f + __expf(-x)); }
__device__ __forceinline__ float wave_sum(float v) {
#pragma unroll
    for (int o = 1; o < 64; o <<= 1) v += __shfl_xor(v, o);
    return v;
}
#define RLX_AGENT __ATOMIC_RELAXED, __HIP_MEMORY_SCOPE_AGENT

#define XB_TMO      128
#define XB_XCNT(j)  (256  + 64 * (j))
#define XB_XSUB(j)  (1280 + 64 * (j))
#define XB_XGEN(j)  (2304 + 64 * (j))
#define XB_TOP      3328
#define XB_TOPGEN   3392
#define XCD_BAR_WORDS 3456
#define XB_SPIN_CAP (1u << 22)
__device__ __forceinline__ unsigned xb_ld(unsigned* p)              { return __hip_atomic_load(p, __ATOMIC_RELAXED, __HIP_MEMORY_SCOPE_AGENT); }
__device__ __forceinline__ unsigned xb_add(unsigned* p, unsigned v) { return __hip_atomic_fetch_add(p, v, __ATOMIC_RELAXED, __HIP_MEMORY_SCOPE_AGENT); }
__device__ __forceinline__ unsigned xb_xcc_id() { return (unsigned)__builtin_amdgcn_s_getreg((3 << 11) | 20) & 0xFu; }
#define XB_SPIN(cond, bar) do { unsigned _sp = 0; while (cond) { __builtin_amdgcn_s_sleep(1); \
    if ((++_sp & 255u) == 0u) { if (xb_ld(&(bar)[XB_TMO])) break; if (_sp > XB_SPIN_CAP) { atomicAdd(&(bar)[XB_TMO], 1u); break; } } } } while (0)
struct XcdBarrier { unsigned* bar; unsigned x; volatile LAS unsigned* st; };
__device__ __forceinline__ XcdBarrier xcd_barrier_post(unsigned* bar, volatile LAS unsigned* st) {
    XcdBarrier b; b.bar = bar; b.x = xb_xcc_id(); b.st = st;
    if (threadIdx.x == 0) (void)xb_add(&bar[XB_XCNT(b.x)], 1u);
    return b;
}
__device__ __forceinline__ void xcd_barrier_complete(unsigned* bar, unsigned x, unsigned& nloc, unsigned& nx) {
    const unsigned G = gridDim.x * gridDim.y * gridDim.z;
    unsigned sum, cnt, mine, sp = 0u;
    for (;;) {
        sum = 0u; cnt = 0u; mine = 0u;
#pragma unroll
        for (unsigned j = 0; j < 16; ++j) { const unsigned c = xb_ld(&bar[XB_XCNT(j)]); sum += c; cnt += (c > 0u) ? 1u : 0u; mine = (j == x) ? c : mine; }
        if (sum == G) break;
        __builtin_amdgcn_s_sleep(1);
        if ((++sp & 255u) == 0u) { if (xb_ld(&bar[XB_TMO])) break; if (sp > XB_SPIN_CAP) { atomicAdd(&bar[XB_TMO], 1u); break; } }
    }
    nloc = mine > 0u ? mine : 1u; nx = cnt > 0u ? cnt : 1u;
}
__device__ __forceinline__ void xcd_barrier(const XcdBarrier& b) {
    asm volatile("s_waitcnt vmcnt(0)" ::: "memory");
    __syncthreads();
    if (threadIdx.x == 0) {
        unsigned* bar = b.bar;
        __builtin_amdgcn_s_waitcnt(0);
        unsigned nloc = b.st[0], nx = b.st[1];
        if (nloc == 0u) { xcd_barrier_complete(bar, b.x, nloc, nx); b.st[0] = nloc; b.st[1] = nx; }
        const unsigned old = xb_add(&bar[XB_XSUB(b.x)], 1u);
        const unsigned gen = old / nloc;
        if (old + 1u == (gen + 1u) * nloc) {
            __builtin_amdgcn_fence(__ATOMIC_RELEASE, "agent");
            asm volatile("s_waitcnt vmcnt(0)" ::: "memory");
            const unsigned og = xb_add(&bar[XB_TOP], 1u);
            const unsigned tg = og / nx;
            if (og + 1u == (tg + 1u) * nx) xb_add(&bar[XB_TOPGEN], 1u);
            else XB_SPIN(xb_ld(&bar[XB_TOPGEN]) == tg, bar);
            __builtin_amdgcn_fence(__ATOMIC_ACQUIRE, "agent");
            xb_add(&bar[XB_XGEN(b.x)], 1u);
            asm volatile("s_waitcnt vmcnt(0)" ::: "memory");
        } else {
            XB_SPIN(xb_ld(&bar[XB_XGEN(b.x)]) == gen, bar);
            __builtin_amdgcn_fence(__ATOMIC_ACQUIRE, "agent");
            asm volatile("s_waitcnt vmcnt(0)" ::: "memory");
        }
    }
    __syncthreads();
}

namespace pg8 {
constexpr int BM = 256, BK = 64, HALF = 128, HTB = HALF * BK * 2, STAGE_BYTES = 8 * HTB, NXCD = 8, WGM = 8;
__host__ __device__ __forceinline__ int lds_byte(int r, int c) { const int st = (r >> 4) * 2 + (c >> 5), rr = r & 15, cc = c & 31, ob = rr * 64 + cc * 2; return st * 1024 + (ob ^ (((ob >> 9) & 1) << 5)); }
__host__ __device__ __forceinline__ void stage_rc(int b, int& R, int& C) { const int st = b / 1024, sb = b % 1024, swz = sb ^ (((sb >> 9) & 1) << 5); R = (st >> 1) * 16 + swz / 64; C = (st & 1) * 32 + (swz % 64) / 2; }
__host__ __device__ __forceinline__ int perm32(int rho) { const int n = rho >> 4, i = rho & 15; return 8 * (i >> 2) + 4 * n + (i & 3); }

struct Unit { int pm, pn, e, lt; };
__device__ __forceinline__ void map_tile(int wgid, int nwg, int nM, int nN, int& pm, int& pn) {
    { const int q = nwg / NXCD, r = nwg % NXCD, xcd = wgid % NXCD, off = wgid / NXCD; wgid = (xcd < r ? xcd * (q + 1) : r * (q + 1) + (xcd - r) * q) + off; }
    const int nig = WGM * nN, gid = wgid / nig, fm = gid * WGM, gsz = (nM - fm) < WGM ? (nM - fm) : WGM;
    pm = fm + ((wgid % nig) % gsz); pn = (wgid % nig) / gsz;
}
struct PlainSched {
    const bf16* A; const bf16* Bt; int K, nM, nN, G, c;
    __device__ __forceinline__ bool next(int i, Unit& u) const { const long L = (long)i * G + c; if (L >= (long)nM * nN) return false; map_tile((int)L, nM * nN, nM, nN, u.pm, u.pn); u.e = 0; u.lt = 0; return true; }
    __device__ __forceinline__ const char* aptr(const Unit& u) const { return (const char*)A + (size_t)u.pm * BM * K * 2; }
    __device__ __forceinline__ const char* bptr(const Unit& u) const { return (const char*)Bt + (size_t)u.pn * BM * K * 2; }
    __device__ __forceinline__ void rows(const Unit&, const int (&)[2], const int (&)[2], unsigned (&)[2][2]) const {}
};
struct InProjSched {
    const bf16* A; const bf16* Bt; int G, c;
    __device__ __forceinline__ bool next(int i, Unit& u) const {
        const int L = i * G + c; constexpr int NL = 64 * 38, NCX = 8 * 14;
        if (L >= NL + NCX) return false;
        if (L < NL) map_tile(L, NL, 64, 38, u.pm, u.pn); else { map_tile(L - NL, NCX, 8, 14, u.pm, u.pn); u.pm += 64; u.pn += 8; }
        u.e = 0; u.lt = 0; return true; }
    __device__ __forceinline__ const char* aptr(const Unit& u) const { return (const char*)A + (size_t)u.pm * BM * D * 2; }
    __device__ __forceinline__ const char* bptr(const Unit& u) const { return (const char*)Bt + (size_t)u.pn * BM * D * 2; }
    __device__ __forceinline__ void rows(const Unit&, const int (&)[2], const int (&)[2], unsigned (&)[2][2]) const {}
};
struct MoeSched {
    const bf16* A; const bf16* Bt; const int* rowtok; int K, N, nN, G, c; const LAS int* cnt; const LAS int* tst; const LAS unsigned char* te;
    __device__ __forceinline__ bool next(int i, Unit& u) const { const int nM = tst[NE]; const int L = i * G + c; if (L >= nM * nN) return false;
        map_tile(L, nM * nN, nM, nN, u.pm, u.pn); u.e = te[u.pm]; u.lt = u.pm - tst[u.e]; return true; }
    __device__ __forceinline__ const char* aptr(const Unit& u) const { return (const char*)A + (size_t)u.pm * BM * K * 2; }
    __device__ __forceinline__ const char* bptr(const Unit& u) const { return (const char*)Bt + ((size_t)u.e * N + (size_t)u.pn * BM) * K * 2; }
    __device__ __forceinline__ void rows(const Unit& u, const int (&sR)[2], const int (&sC2)[2], unsigned (&g)[2][2]) const {
        const int n = cnt[u.e]; const int* rt = rowtok + (size_t)u.e * ECAP;
#pragma unroll
        for (int h = 0; h < 2; ++h)
#pragma unroll
            for (int i = 0; i < 2; ++i) { const int j = u.lt * BM + h * HALF + sR[i]; const int tok = (j < n) ? rt[j] : 0; g[h][i] = (unsigned)tok * (unsigned)(K * 2) + (unsigned)sC2[i]; }
        asm volatile("s_waitcnt vmcnt(0)" ::: "memory");
    }
};

template <class Epi, class Sched, bool GATHER>
__device__ __forceinline__ void gemm_phase(LAS unsigned char* lds, const int K, const Sched& S, const Epi& E, const char* gatherA) {
    const int tid = threadIdx.x, wid = __builtin_amdgcn_readfirstlane(tid >> 6), lane = tid & 63, wr = wid >> 2, wc = wid & 3, fr = lane & 15, fq = lane >> 4;
    const int nt = K / BK;
    unsigned voffA[2], voffB[2]; int sR[2], sC2[2];
#pragma unroll
    for (int i = 0; i < 2; ++i) { int R, C; stage_rc(tid * 16 + i * 8192, R, C); const int Rb = Epi::PERM ? ((R & ~31) + perm32(R & 31)) : R;
        voffA[i] = (unsigned)(R * K + C) * 2u; voffB[i] = (unsigned)(Rb * K + C) * 2u; sR[i] = R; sC2[i] = C * 2; }
    const size_t kstep = (size_t)(BK * 2);
    const size_t hstep = (size_t)HALF * K * 2;
    const unsigned ldsw = (unsigned)wid * 1024u;
    const int aoff = lds_byte(wr * 64 + fr, fq * 8), boff = lds_byte(wc * 32 + fr, fq * 8);
#define PG8_SA(b, h) (((b) * 2 + (h)) * HTB)
#define PG8_SB(b, h) ((4 + (b) * 2 + (h)) * HTB)
#define PG8_STAGE(bufoff, gbase, voff) do { _Pragma("unroll") for (int _i = 0; _i < 2; ++_i) \
        __builtin_amdgcn_global_load_lds((const unsigned*)((const char*)(gbase) + (voff)[_i]), (LAS unsigned*)(lds + (bufoff) + ldsw + _i * 8192), 16, 0, 0); } while (0)
#define PG8_STG_A(bufoff, gbase, h, OFF) do { if constexpr (GATHER) { PG8_STAGE(bufoff, gbase, OFF); } else { PG8_STAGE(bufoff, (gbase) + (h) * hstep, voffA); } } while (0)
#define PG8_LDA(dst, b, h) do { _Pragma("unroll") for (int m = 0; m < 4; ++m) _Pragma("unroll") for (int k = 0; k < 2; ++k) dst[m][k] = *(const LAS bf16x8*)(lds + PG8_SA(b, h) + aoff + m * 2048 + k * 1024); } while (0)
#define PG8_LDB(dst, b, h) do { _Pragma("unroll") for (int n = 0; n < 2; ++n) _Pragma("unroll") for (int k = 0; k < 2; ++k) dst[n][k] = *(const LAS bf16x8*)(lds + PG8_SB(b, h) + boff + n * 2048 + k * 1024); } while (0)
#define PG8_MMA(ai, bj, At, Bt) do { __builtin_amdgcn_s_setprio(1); _Pragma("unroll") for (int m = 0; m < 4; ++m) _Pragma("unroll") for (int n = 0; n < 2; ++n) _Pragma("unroll") for (int k = 0; k < 2; ++k) \
        acc[ai][bj][m][n] = __builtin_amdgcn_mfma_f32_16x16x32_bf16(Bt[n][k], At[m][k], acc[ai][bj][m][n], 0, 0, 0); __builtin_amdgcn_s_setprio(0); } while (0)
#define PG8_WAIT_V(n) asm volatile("s_waitcnt vmcnt(" #n ")" ::: "memory")
#define PG8_WAIT_L(n) asm volatile("s_waitcnt lgkmcnt(" #n ")" ::: "memory")
#define PG8_BAR __builtin_amdgcn_s_barrier()
#define PG8_SCHED __builtin_amdgcn_sched_barrier(0)
    Unit cur, nxt; int ui = 0;
    if (!S.next(0, cur)) return;
    f32x4 acc[2][2][4][2];
#pragma unroll
    for (int a = 0; a < 2; ++a)
#pragma unroll
        for (int b = 0; b < 2; ++b)
#pragma unroll
            for (int m = 0; m < 4; ++m)
#pragma unroll
                for (int n = 0; n < 2; ++n) acc[a][b][m][n] = (f32x4){0.f, 0.f, 0.f, 0.f};
    bf16x8 At[4][2], B0[2][2], B1[2][2];
    const char* cA = GATHER ? gatherA : S.aptr(cur); const char* cB = S.bptr(cur);
    unsigned gA[2][2] = {{0u, 0u}, {0u, 0u}}, gA1[2] = {0u, 0u};
    if constexpr (GATHER) S.rows(cur, sR, sC2, gA);
    PG8_STAGE(PG8_SB(0, 0), cB, voffB); PG8_STAGE(PG8_SB(0, 1), cB + hstep, voffB); PG8_STG_A(PG8_SA(0, 0), cA, 0, gA[0]); PG8_STG_A(PG8_SA(0, 1), cA, 1, gA[1]);
    if (wr == 1) PG8_BAR;
    PG8_WAIT_V(2); PG8_BAR;
    PG8_STAGE(PG8_SB(1, 0), cB + kstep, voffB); PG8_STG_A(PG8_SA(1, 0), cA + kstep, 0, gA[0]); PG8_STAGE(PG8_SB(1, 1), cB + hstep + kstep, voffB);
    PG8_WAIT_V(6); PG8_BAR;
    for (;;) {
        const bool has_next = S.next(ui + 1, nxt);
        const char* nA = GATHER ? gatherA : (has_next ? S.aptr(nxt) : cA); const char* nB = has_next ? S.bptr(nxt) : cB;
        for (int t = 0; t < nt; t += 2) {
            const bool last = (t == nt - 2);
            const char* a1 = cA + (size_t)(t + 1) * kstep;
            const char* a2 = last ? nA : cA + (size_t)(t + 2) * kstep; const char* b2 = last ? nB : cB + (size_t)(t + 2) * kstep;
            const char* a3 = a2 + kstep; const char* b3 = b2 + kstep;
            if constexpr (GATHER) { gA1[0] = gA[1][0]; gA1[1] = gA[1][1]; if (last && has_next) S.rows(nxt, sR, sC2, gA); }
            PG8_LDB(B0, 0, 0); PG8_LDB(B1, 0, 1); PG8_SCHED; PG8_LDA(At, 0, 0); PG8_STG_A(PG8_SA(1, 1), a1, 1, gA1);
            PG8_WAIT_V(8); PG8_WAIT_L(0); PG8_BAR; PG8_MMA(0, 0, At, B0); PG8_MMA(0, 1, At, B1); PG8_BAR; PG8_SCHED;
            PG8_LDA(At, 0, 1); PG8_STAGE(PG8_SB(0, 0), b2, voffB); PG8_STAGE(PG8_SB(0, 1), b2 + hstep, voffB); PG8_STG_A(PG8_SA(0, 0), a2, 0, gA[0]);
            PG8_WAIT_V(8); PG8_WAIT_L(0); PG8_BAR; PG8_MMA(1, 0, At, B0); PG8_MMA(1, 1, At, B1); PG8_BAR; PG8_SCHED;
            PG8_LDB(B0, 1, 0); PG8_LDB(B1, 1, 1); PG8_SCHED; PG8_LDA(At, 1, 0); PG8_STG_A(PG8_SA(0, 1), a2, 1, gA[1]);
            PG8_WAIT_V(8); PG8_WAIT_L(0); PG8_BAR; PG8_MMA(0, 0, At, B0); PG8_MMA(0, 1, At, B1); PG8_BAR; PG8_SCHED;
            PG8_LDA(At, 1, 1); PG8_STAGE(PG8_SB(1, 0), b3, voffB); PG8_STAGE(PG8_SB(1, 1), b3 + hstep, voffB); PG8_STG_A(PG8_SA(1, 0), a3, 0, gA[0]);
            PG8_WAIT_V(8); PG8_WAIT_L(0); PG8_BAR; PG8_MMA(1, 0, At, B0); PG8_MMA(1, 1, At, B1); PG8_BAR; PG8_SCHED;
        }
        if (wr == 0) PG8_BAR;
        E(acc, cur, wr, wc, fr, fq);
        if (!has_next) break;
#pragma unroll
        for (int a = 0; a < 2; ++a)
#pragma unroll
            for (int b = 0; b < 2; ++b)
#pragma unroll
                for (int m = 0; m < 4; ++m)
#pragma unroll
                    for (int n = 0; n < 2; ++n) acc[a][b][m][n] = (f32x4){0.f, 0.f, 0.f, 0.f};
        cur = nxt; cA = nA; cB = nB; ++ui;
        if (wr == 1) PG8_BAR;
    }
    PG8_WAIT_V(0);
    PG8_BAR;
#undef PG8_SA
#undef PG8_SB
#undef PG8_STAGE
#undef PG8_STG_A
#undef PG8_LDA
#undef PG8_LDB
#undef PG8_MMA
#undef PG8_WAIT_V
#undef PG8_WAIT_L
#undef PG8_BAR
#undef PG8_SCHED
}

typedef const f32x4 (&AccT)[2][2][4][2];
__device__ __forceinline__ u32x4 pack8(f32x4 v0, f32x4 v1) { u32x4 w; w.x = cvt_pk_bf16(v0[0], v0[1]); w.y = cvt_pk_bf16(v0[2], v0[3]); w.z = cvt_pk_bf16(v1[0], v1[1]); w.w = cvt_pk_bf16(v1[2], v1[3]); return w; }
__device__ __forceinline__ void unpack8(u32x4 w, f32x4& v0, f32x4& v1) { v0 = (f32x4){bflo(w.x), bfhi(w.x), bflo(w.y), bfhi(w.y)}; v1 = (f32x4){bflo(w.z), bfhi(w.z), bflo(w.w), bfhi(w.w)}; }
__device__ __forceinline__ f32x4 sig4(f32x4 v) { return (f32x4){sigm(v[0]), sigm(v[1]), sigm(v[2]), sigm(v[3])}; }

struct EpiBf16Plain {
    static constexpr bool PERM = true;
    bf16* O; int ldc; const float* bias;
    __device__ __forceinline__ void operator()(AccT acc, const Unit& u, int wr, int wc, int fr, int fq) const {
        const int row0 = u.pm * BM + wr * 64 + fr, col0 = u.pn * BM + wc * 32 + 8 * fq;
        f32x4 bv[2][2];
#pragma unroll
        for (int bj = 0; bj < 2; ++bj)
#pragma unroll
            for (int n = 0; n < 2; ++n) bv[bj][n] = bias ? *(const f32x4*)(bias + col0 + bj * HALF + 4 * n) : (f32x4){0.f, 0.f, 0.f, 0.f};
#pragma unroll
        for (int ai = 0; ai < 2; ++ai)
#pragma unroll
            for (int m = 0; m < 4; ++m) { bf16* rowp = O + (size_t)(row0 + ai * HALF + m * 16) * ldc + col0;
#pragma unroll
                for (int bj = 0; bj < 2; ++bj) *(u32x4*)(rowp + bj * HALF) = pack8(acc[ai][bj][m][0] + bv[bj][0], acc[ai][bj][m][1] + bv[bj][1]); }
    }
};
struct EpiInProj {
    static constexpr bool PERM = true;
    bf16* ZL; bf16* ZC; const float* bias;
    __device__ __forceinline__ void operator()(AccT acc, const Unit& u, int wr, int wc, int fr, int fq) const {
        const int row0 = u.pm * BM + wr * 64 + fr, col0 = u.pn * BM + wc * 32 + 8 * fq;
        f32x4 bv[2][2];
#pragma unroll
        for (int bj = 0; bj < 2; ++bj)
#pragma unroll
            for (int n = 0; n < 2; ++n) bv[bj][n] = *(const f32x4*)(bias + col0 + bj * HALF + 4 * n);
        const bool lat = u.pm < 64;
#pragma unroll
        for (int ai = 0; ai < 2; ++ai)
#pragma unroll
            for (int m = 0; m < 4; ++m) { const int r = row0 + ai * HALF + m * 16;
                bf16* rowp = lat ? ZL + (size_t)r * ZN + col0 : ZC + (size_t)(r - TL) * ZCN + (col0 - ZR0);
#pragma unroll
                for (int bj = 0; bj < 2; ++bj) *(u32x4*)(rowp + bj * HALF) = pack8(acc[ai][bj][m][0] + bv[bj][0], acc[ai][bj][m][1] + bv[bj][1]); }
    }
};
struct EpiConvO {
    static constexpr bool PERM = true;
    bf16* MIX; const bf16* ZL; const float* bias;
    __device__ __forceinline__ void operator()(AccT acc, const Unit& u, int wr, int wc, int fr, int fq) const {
        const int row0 = u.pm * BM + wr * 64 + fr, col0 = u.pn * BM + wc * 32 + 8 * fq;
        f32x4 bv[2][2];
#pragma unroll
        for (int bj = 0; bj < 2; ++bj)
#pragma unroll
            for (int n = 0; n < 2; ++n) bv[bj][n] = *(const f32x4*)(bias + col0 + bj * HALF + 4 * n);
#pragma unroll
        for (int ai = 0; ai < 2; ++ai)
#pragma unroll
            for (int m = 0; m < 4; ++m) { const size_t r = (size_t)(row0 + ai * HALF + m * 16);
#pragma unroll
                for (int bj = 0; bj < 2; ++bj) { const int c = col0 + bj * HALF; f32x4 g0, g1; unpack8(*(const u32x4*)(ZL + r * ZN + ZG0 + c), g0, g1);
                    *(u32x4*)(MIX + r * D + c) = pack8(sig4(g0) * (acc[ai][bj][m][0] + bv[bj][0]), sig4(g1) * (acc[ai][bj][m][1] + bv[bj][1])); } }
    }
};
struct EpiRwkvO {
    static constexpr bool PERM = true;
    bf16* MIX; const bf16* ZL;
    __device__ __forceinline__ void operator()(AccT acc, const Unit& u, int wr, int wc, int fr, int fq) const {
        const int row0 = u.pm * BM + wr * 64 + fr, col0 = u.pn * BM + wc * 32 + 8 * fq;
#pragma unroll
        for (int ai = 0; ai < 2; ++ai)
#pragma unroll
            for (int m = 0; m < 4; ++m) { const size_t r = (size_t)(row0 + ai * HALF + m * 16);
#pragma unroll
                for (int bj = 0; bj < 2; ++bj) { const int c = col0 + bj * HALF; f32x4 g0, g1, m0, m1; unpack8(*(const u32x4*)(ZL + r * ZN + ZG0 + D + c), g0, g1); unpack8(*(const u32x4*)(MIX + r * D + c), m0, m1);
                    *(u32x4*)(MIX + r * D + c) = pack8(m0 + sig4(g0) * acc[ai][bj][m][0], m1 + sig4(g1) * acc[ai][bj][m][1]); } }
    }
};
struct EpiOut {
    static constexpr bool PERM = false;
    float* T1; const float* x; const float* mod; const float* bias;
    __device__ __forceinline__ void operator()(AccT acc, const Unit& u, int wr, int wc, int fr, int fq) const {
        const int row0 = u.pm * BM + wr * 64 + fr, col0 = u.pn * BM + wc * 32 + 4 * fq;
        const float* gate = mod + (size_t)(u.pm / 8) * (6 * D) + 2 * D;
        f32x4 bv[2][2], gv[2][2];
#pragma unroll
        for (int bj = 0; bj < 2; ++bj)
#pragma unroll
            for (int n = 0; n < 2; ++n) { bv[bj][n] = *(const f32x4*)(bias + col0 + bj * HALF + n * 16); gv[bj][n] = *(const f32x4*)(gate + col0 + bj * HALF + n * 16); }
#pragma unroll
        for (int ai = 0; ai < 2; ++ai)
#pragma unroll
            for (int m = 0; m < 4; ++m) { const size_t off = (size_t)(row0 + ai * HALF + m * 16) * D + col0;
#pragma unroll
                for (int bj = 0; bj < 2; ++bj)
#pragma unroll
                    for (int n = 0; n < 2; ++n) { const f32x4 xv = *(const f32x4*)(x + off + bj * HALF + n * 16);
                        *(f32x4*)(T1 + off + bj * HALF + n * 16) = xv * DN_ALPHA + gv[bj][n] * (acc[ai][bj][m][n] + bv[bj][n]); } }
    }
};
struct EpiGateUp {
    static constexpr bool PERM = true;
    bf16* HID; const float* bias;
    __device__ __forceinline__ void operator()(AccT acc, const Unit& u, int wr, int wc, int fr, int fq) const {
        const int row0 = u.pm * BM + wr * 64 + fr, cb = u.pn * BM + wc * 32 + 8 * fq, co = u.pn * HALF + wc * 32 + 8 * fq;
        const float* bp = bias + (size_t)u.e * 4096 + cb;
        f32x4 bv[2][2];
#pragma unroll
        for (int bj = 0; bj < 2; ++bj)
#pragma unroll
            for (int n = 0; n < 2; ++n) bv[bj][n] = *(const f32x4*)(bp + bj * HALF + 4 * n);
#pragma unroll
        for (int ai = 0; ai < 2; ++ai)
#pragma unroll
            for (int m = 0; m < 4; ++m) { f32x4 h[2];
#pragma unroll
                for (int n = 0; n < 2; ++n) { const f32x4 g = acc[ai][0][m][n] + bv[0][n], up = acc[ai][1][m][n] + bv[1][n];
#pragma unroll
                    for (int j = 0; j < 4; ++j) { const float gg = fminf(g[j], SW_LIMIT), uu = fminf(fmaxf(up[j], -SW_LIMIT), SW_LIMIT); h[n][j] = (uu + 1.0f) * (gg * sigm(SW_ALPHA * gg)); } }
                *(u32x4*)(HID + (size_t)(row0 + ai * HALF + m * 16) * D + co) = pack8(h[0], h[1]); }
    }
};
struct EpiDown {
    static constexpr bool PERM = true;
    bf16* DOWN; const float* bias; const float* roww; const LAS int* cnt;
    __device__ __forceinline__ void operator()(AccT acc, const Unit& u, int wr, int wc, int fr, int fq) const {
        const int rl0 = wr * 64 + fr, col0 = u.pn * BM + wc * 32 + 8 * fq; const int n_e = cnt[u.e];
        const float* bp = bias + (size_t)u.e * D + col0; const float* rw = roww + (size_t)u.e * ECAP + u.lt * BM;
        f32x4 bv[2][2];
#pragma unroll
        for (int bj = 0; bj < 2; ++bj)
#pragma unroll
            for (int n = 0; n < 2; ++n) bv[bj][n] = *(const f32x4*)(bp + bj * HALF + 4 * n);
#pragma unroll
        for (int ai = 0; ai < 2; ++ai)
#pragma unroll
            for (int m = 0; m < 4; ++m) { const int rl = rl0 + ai * HALF + m * 16; const float gw = (u.lt * BM + rl < n_e) ? rw[rl] : 0.f;
                bf16* rowp = DOWN + (size_t)(u.pm * BM + rl) * D + col0;
#pragma unroll
                for (int bj = 0; bj < 2; ++bj) *(u32x4*)(rowp + bj * HALF) = pack8((acc[ai][bj][m][0] + bv[bj][0]) * gw, (acc[ai][bj][m][1] + bv[bj][1]) * gw); }
    }
};
}
__device__ __forceinline__ void unpack8(u32x4 w, f32x4& a, f32x4& b) { pg8::unpack8(w, a, b); }

struct Params { const float* in[38]; float* out; unsigned char* ws; int ph_lo, ph_hi; };
enum { I_X = 0, I_C, I_CTX, I_CCTX, I_WADA, I_BADA, I_WIN, I_BIN, I_SMU, I_CONVW, I_CONVB, I_CLNG, I_CLNB, I_WCO, I_BCO, I_W0, I_W2, I_A0, I_A2, I_G2,
       I_KK, I_KA, I_RK, I_LNXG, I_LNXB, I_WRO, I_WOUT, I_BOUT, I_LN1G, I_LN1B, I_WROUTER, I_BROUTER, I_WGU, I_BGU, I_WDN, I_BDN, I_LN2G, I_LN2B };

struct Ctx { LAS unsigned char* lds; int tid, lane, wave, G, bid, gw, NGW; };

__device__ __forceinline__ void cvt_item(const float* W, int N, int K, int k0, int n0, bf16* WT, int drow0, int lane) {
    const int ko = lane & 7, ng = lane >> 3;
    const float* src = W + (size_t)(k0 + 8 * ko) * N + n0 + 4 * ng;
    f32x4 v[8];
#pragma unroll
    for (int j = 0; j < 8; ++j) v[j] = *(const f32x4*)(src + (size_t)j * N);
#pragma unroll
    for (int jn = 0; jn < 4; ++jn) { u32x4 o; o.x = cvt_pk_bf16(v[0][jn], v[1][jn]); o.y = cvt_pk_bf16(v[2][jn], v[3][jn]); o.z = cvt_pk_bf16(v[4][jn], v[5][jn]); o.w = cvt_pk_bf16(v[6][jn], v[7][jn]);
        *(u32x4*)(WT + (size_t)(drow0 + 4 * ng + jn) * K + k0 + 8 * ko) = o; }
}
__device__ __forceinline__ void p0_convert(const Params& p, const Ctx& c) {
    unsigned char* ws = p.ws;
    constexpr int I_IN = 32 * 301, I_CO = 16 * 64, I_RO = 16 * 64, I_OUT = 32 * 64;
    constexpr int NITEMS = I_IN + I_CO + I_RO + I_OUT;
    for (int it = c.gw; it < NITEMS; it += c.NGW) {
        int r = it;
        if (r < I_IN) { const int kb = r / 301, nb = r % 301, n0 = 32 * nb; cvt_item(p.in[I_WIN], PIN, D, 64 * kb, n0, (bf16*)(ws + WS_WIN), n0 < 5536 ? n0 : n0 + 96, c.lane); continue; } r -= I_IN;
        if (r < I_CO) { const int kb = r / 64, nb = r % 64; cvt_item(p.in[I_WCO], D, DCV, 64 * kb, 32 * nb, (bf16*)(ws + WS_WCO), 32 * nb, c.lane); continue; } r -= I_CO;
        if (r < I_RO) { const int kb = r / 64, nb = r % 64; cvt_item(p.in[I_WRO], D, DR, 64 * kb, 32 * nb, (bf16*)(ws + WS_WRO), 32 * nb, c.lane); continue; } r -= I_RO;
        { const int kb = r / 64, nb = r % 64; cvt_item(p.in[I_WOUT], D, D, 64 * kb, 32 * nb, (bf16*)(ws + WS_WOUT), 32 * nb, c.lane); }
    }
}
__device__ __forceinline__ void moe_cvt_pair(const float* W, int N, int k0, int n0, bf16* WT, int drow0, int lane) {
    const int ko = lane & 7, ng = lane >> 3;
    const float* src = W + (size_t)(k0 + 8 * ko) * N + n0 + 4 * ng;
    f32x4 v[8], u[8];
#pragma unroll
    for (int j = 0; j < 8; ++j) { v[j] = __builtin_nontemporal_load((const f32x4*)(src + (size_t)j * N)); u[j] = __builtin_nontemporal_load((const f32x4*)(src + (size_t)j * N + 32)); }
#pragma unroll
    for (int jn = 0; jn < 4; ++jn) { u32x4 o; o.x = cvt_pk_bf16(v[0][jn], v[1][jn]); o.y = cvt_pk_bf16(v[2][jn], v[3][jn]); o.z = cvt_pk_bf16(v[4][jn], v[5][jn]); o.w = cvt_pk_bf16(v[6][jn], v[7][jn]);
        *(u32x4*)(WT + (size_t)(drow0 + 4 * ng + jn) * D + k0 + 8 * ko) = o; }
#pragma unroll
    for (int jn = 0; jn < 4; ++jn) { u32x4 o; o.x = cvt_pk_bf16(u[0][jn], u[1][jn]); o.y = cvt_pk_bf16(u[2][jn], u[3][jn]); o.z = cvt_pk_bf16(u[4][jn], u[5][jn]); o.w = cvt_pk_bf16(u[6][jn], u[7][jn]);
        *(u32x4*)(WT + (size_t)(drow0 + 32 + 4 * ng + jn) * D + k0 + 8 * ko) = o; }
}
__device__ __forceinline__ void moe_convert(const Params& p, int wi, int nw, int lane) {
    unsigned char* ws = p.ws;
    constexpr int I_GU1 = 32 * 64, I_GU = NE * I_GU1, I_DN1 = 32 * 32, I_DN = NE * I_DN1;
    for (int it = wi; it < I_GU + I_DN; it += nw) {
        if (it < I_GU) { const int e = it / I_GU1, q = it % I_GU1, kb = q / 64, nb = q % 64, n0 = 64 * nb; const int nn = n0 & 2047;
            const int drow = (nn >> 7) * 256 + (n0 >= 2048 ? 128 : 0) + (nn & 127);
            moe_cvt_pair(p.in[I_WGU] + (size_t)e * D * 4096, 4096, 64 * kb, n0, (bf16*)(ws + WS_WGU) + (size_t)e * 4096 * D, drow, lane); }
        else { const int r = it - I_GU; const int e = r / I_DN1, q = r % I_DN1, kb = q / 32, nb = q % 32;
            moe_cvt_pair(p.in[I_WDN] + (size_t)e * D * D, D, 64 * kb, 64 * nb, (bf16*)(ws + WS_WDN) + (size_t)e * D * D, 64 * nb, lane); }
    }
}
__device__ __forceinline__ void p0_small(const Params& p, const Ctx& c) {
    unsigned char* ws = p.ws;
    const int gt = c.bid * 512 + c.tid, NT = c.G * 512;
    bf16* WL = (bf16*)(ws + WS_WLORA);
    for (int t = gt; t < LORA_N * (LORA_K / 8); t += NT) {
        const int n = t / (LORA_K / 8), k0 = (t % (LORA_K / 8)) * 8, g = n >> 10, ch = n & 1023; float v[8];
#pragma unroll
        for (int j = 0; j < 8; ++j) { const int k = k0 + j; float x = 0.f;
            if (g < 4) { if (k >= 64 * g && k < 64 * g + 64) { const float* src = (g < 2) ? p.in[I_W2] : p.in[I_A2]; x = src[((size_t)(g & 1) * 64 + (k - 64 * g)) * DR + ch]; } }
            else { if (k >= 256 && k < 416) x = p.in[I_G2][(size_t)(k - 256) * DR + ch]; }
            v[j] = x; }
        u32x4 o; o.x = cvt_pk_bf16(v[0], v[1]); o.y = cvt_pk_bf16(v[2], v[3]); o.z = cvt_pk_bf16(v[4], v[5]); o.w = cvt_pk_bf16(v[6], v[7]);
        *(u32x4*)(WL + (size_t)n * LORA_K + k0) = o;
    }
    bf16* WRt = (bf16*)(ws + WS_WR);
    for (int t = gt; t < NE * D; t += NT) { const int e = t / D, k = t % D; const float w = p.in[I_WROUTER][(size_t)k * NE + e]; const unsigned hi = f2bf(w); const float lo = w - bflo(hi);
        WRt[t] = (bf16)hi; WRt[NE * D + t] = (bf16)f2bf(lo); }
    float* bin = (float*)(ws + WS_BIN);
    for (int t = gt; t < ZN; t += NT) bin[t] = t < 5536 ? p.in[I_BIN][t] : (t < ZG0 ? 0.f : p.in[I_BIN][t - 96]);
    float* bgu = (float*)(ws + WS_BGU);
    for (int t = gt; t < NE * 4096; t += NT) { const int e = t >> 12, q = t & 4095, pn = q >> 8, rr = q & 255; bgu[t] = p.in[I_BGU][(size_t)e * 4096 + (rr < 128 ? 128 * pn + rr : 2048 + 128 * pn + rr - 128)]; }
    bf16* WI = (bf16*)(ws + WS_WIN);
    for (int t = gt; t < 96 * D / 8; t += NT) *(u32x4*)(WI + (size_t)5536 * D + (size_t)t * 8) = (u32x4){0u, 0u, 0u, 0u};
}
__device__ __forceinline__ void p0_adaln(const Params& p, const Ctx& c) {
    LAS float* act = (LAS float*)c.lds; LAS float* red = (LAS float*)(c.lds + 73728);
    for (int i = c.tid; i < 9 * D; i += 512) { const int r = i / D, k = i % D; const float v = r < 8 ? p.in[I_C][r * D + k] : p.in[I_CCTX][k]; act[i] = v * sigm(v); }
    __syncthreads();
    const int cg = c.tid & 15, ks = c.tid >> 4;
    float* mod = (float*)(p.ws + WS_MOD);
    for (int u = c.bid; u < 192; u += c.G) {
        f32x4 acc[9];
#pragma unroll
        for (int r = 0; r < 9; ++r) acc[r] = (f32x4){0.f, 0.f, 0.f, 0.f};
        const float* wp = p.in[I_WADA] + 64 * u + 4 * cg;
#pragma unroll 4
        for (int k = ks; k < D; k += 32) { const f32x4 w = *(const f32x4*)(wp + (size_t)k * (6 * D));
#pragma unroll
            for (int r = 0; r < 9; ++r) acc[r] += w * act[r * D + k]; }
#pragma unroll
        for (int r = 0; r < 9; ++r)
#pragma unroll
            for (int j = 0; j < 4; ++j) { float v = acc[r][j]; v += __shfl_xor(v, 16); v += __shfl_xor(v, 32); acc[r][j] = v; }
        if (c.lane < 16) {
#pragma unroll
            for (int r = 0; r < 9; ++r) *(LAS f32x4*)(red + (c.wave * 9 + r) * 64 + 4 * cg) = acc[r]; }
        __syncthreads();
        for (int i = c.tid; i < 9 * 64; i += 512) { const int r = i / 64, col = i % 64; float s = 0.f;
#pragma unroll
            for (int w = 0; w < 8; ++w) s += red[(w * 9 + r) * 64 + col];
            mod[r * (6 * D) + 64 * u + col] = s + p.in[I_BADA][64 * u + col]; }
        __syncthreads();
    }
}

__device__ __forceinline__ void p1_modulate(const Params& p, const Ctx& c) {
    const float* mod = (const float*)(p.ws + WS_MOD); bf16* U = (bf16*)(p.ws + WS_U);
    for (int row = c.gw; row < TT; row += c.NGW) {
        const float* src = row < TL ? p.in[I_X] + (size_t)row * D : p.in[I_CTX] + (size_t)(row - TL) * D;
        const int b = row < TL ? row / SEQ : 8;
        const float* sh = mod + (size_t)b * (6 * D); const float* sc = sh + D;
        f32x4 v[8]; float s = 0.f;
#pragma unroll
        for (int j = 0; j < 8; ++j) { v[j] = *(const f32x4*)(src + 4 * c.lane + 256 * j); s += (v[j][0] + v[j][1]) + (v[j][2] + v[j][3]); }
        const float mean = wave_sum(s) * (1.f / D); float s2 = 0.f;
#pragma unroll
        for (int j = 0; j < 8; ++j) { v[j] = v[j] - mean; s2 += (v[j][0] * v[j][0] + v[j][1] * v[j][1]) + (v[j][2] * v[j][2] + v[j][3] * v[j][3]); }
        const float rstd = __builtin_amdgcn_rsqf(wave_sum(s2) * (1.f / D) + LN_EPS);
#pragma unroll
        for (int j = 0; j < 8; ++j) { const int col = 4 * c.lane + 256 * j; const f32x4 a = *(const f32x4*)(sc + col), bb = *(const f32x4*)(sh + col);
            const f32x4 o = v[j] * rstd * (a + 1.0f) + bb; u32x2 w; w.x = cvt_pk_bf16(o[0], o[1]); w.y = cvt_pk_bf16(o[2], o[3]);
            *(u32x2*)(U + (size_t)row * D + col) = w; }
    }
}

__device__ __forceinline__ void p3_conv(const Params& p, const Ctx& c) {
    const bf16* ZL = (const bf16*)(p.ws + WS_ZL); bf16* AC = (bf16*)(p.ws + WS_ACONV);
    LAS unsigned* tile = (LAS unsigned*)c.lds;
    for (int gr = c.bid; gr < TL / 64; gr += c.G) {
        const int row0 = gr * 64, c0 = 2 * c.tid;
#pragma unroll 4
        for (int i = 0; i < 16; ++i) { const int ch = c.tid + 512 * i, t = ch >> 7, cg = ch & 127;
            f32x4 a0, a1, g0, g1; unpack8(*(const u32x4*)(ZL + (size_t)(row0 + t) * ZN + 8 * cg), a0, a1); unpack8(*(const u32x4*)(ZL + (size_t)(row0 + t) * ZN + DCV + 8 * cg), g0, g1);
            *(LAS u32x4*)(tile + t * 512 + 4 * cg) = pg8::pack8(a0 * pg8::sig4(g0), a1 * pg8::sig4(g1)); }
        __syncthreads();
#pragma unroll 1
        for (int cc = 0; cc < 2; ++cc) {
            float w[CWID];
#pragma unroll
            for (int j = 0; j < CWID; ++j) w[j] = p.in[I_CONVW][j * DCV + c0 + cc];
            const float cb = p.in[I_CONVB][c0 + cc];
            float h[64];
#pragma unroll
            for (int t = 0; t < 64; ++t) { const unsigned a = tile[t * 512 + c.tid]; h[t] = cc ? bfhi(a) : bflo(a); }
#pragma clang loop unroll(full)
            for (int t = 0; t < 64; ++t) { float a = cb;
#pragma clang loop unroll(full)
                for (int j = 0; j < CWID; ++j) { const int tt = t + j - CWID / 2; if (tt >= 0 && tt < 64) a += w[j] * h[tt]; }
                ((LAS bf16*)tile)[t * DCV + c0 + cc] = (bf16)f2bf(a); }
        }
        __syncthreads();
        f32x4 g[4], bb[4];
#pragma unroll
        for (int q = 0; q < 4; ++q) { g[q] = *(const f32x4*)(p.in[I_CLNG] + 16 * c.lane + 4 * q); bb[q] = *(const f32x4*)(p.in[I_CLNB] + 16 * c.lane + 4 * q); }
#pragma unroll 2
        for (int i = 0; i < 8; ++i) { const int t = c.wave * 8 + i;
            const u32x4 r0 = *(const LAS u32x4*)(tile + t * 512 + 8 * c.lane), r1 = *(const LAS u32x4*)(tile + t * 512 + 8 * c.lane + 4);
            f32x4 v[4]; unpack8(r0, v[0], v[1]); unpack8(r1, v[2], v[3]);
            float s = 0.f;
#pragma unroll
            for (int q = 0; q < 4; ++q) s += (v[q][0] + v[q][1]) + (v[q][2] + v[q][3]);
            const float mean = wave_sum(s) * (1.f / DCV); float s2 = 0.f;
#pragma unroll
            for (int q = 0; q < 4; ++q) { v[q] = v[q] - mean; s2 += (v[q][0] * v[q][0] + v[q][1] * v[q][1]) + (v[q][2] * v[q][2] + v[q][3] * v[q][3]); }
            const float rstd = __builtin_amdgcn_rsqf(wave_sum(s2) * (1.f / DCV) + LN_EPS);
#pragma unroll
            for (int q = 0; q < 4; ++q) { v[q] = v[q] * rstd * g[q] + bb[q];
#pragma unroll
                for (int j = 0; j < 4; ++j) v[q][j] = v[q][j] * sigm(v[q][j]); }
            bf16* o = AC + (size_t)(row0 + t) * DCV + 16 * c.lane;
            *(u32x4*)o = pg8::pack8(v[0], v[1]); *(u32x4*)(o + 8) = pg8::pack8(v[2], v[3]); }
        __syncthreads();
    }
}
__device__ __forceinline__ void p3_alora(const Params& p, const Ctx& c) {
    const bf16* ZL = (const bf16*)(p.ws + WS_ZL); const bf16* ZC = (const bf16*)(p.ws + WS_ZC); bf16* AL = (bf16*)(p.ws + WS_ALORA);
    const float* mu = p.in[I_SMU];
    for (int row = c.gw; row < TT; row += c.NGW) {
        const bool lat = row < TL; const int pitch = lat ? ZN : ZCN; const int len = lat ? SEQ : CTXL; const int t = lat ? row % SEQ : (row - TL) % CTXL;
        const bf16* zp = lat ? ZL + (size_t)row * ZN + ZR0 : ZC + (size_t)(row - TL) * ZCN;
        const bool hp = t > 0, hn = t < len - 1; const int po = hp ? pitch : 0, no = hn ? pitch : 0; const float mp = hp ? 1.f : 0.f, mn = hn ? 1.f : 0.f;
#pragma unroll
        for (int i = 0; i < 8; ++i) { const int j = c.lane + 64 * i; float o = 0.f;
            if (j < 416) { const int col = 3072 + j; const float z = bf1(zp[col]); const float pv = mp * bf1(zp[col - po]), nv = mn * bf1(zp[col + no]);
                const float zs = z + mu[col] * (pv - z) + mu[DSHIFT + col] * (nv - z);
                o = j < 128 ? (1.f - 2.f * __builtin_amdgcn_rcpf(__expf(2.f * zs) + 1.f)) : (j < 256 ? zs : sigm(zs)); }
            AL[(size_t)row * LORA_K + j] = (bf16)f2bf(o); }
    }
}

__device__ __forceinline__ void p5_prep(const Params& p, const Ctx& c) {
    const bf16* ZL = (const bf16*)(p.ws + WS_ZL); const bf16* ZC = (const bf16*)(p.ws + WS_ZC); const bf16* LO = (const bf16*)(p.ws + WS_LORA);
    unsigned char* SC = p.ws + WS_SC2; bf16* VS = (bf16*)(p.ws + WS_VS); float* RK = (float*)(p.ws + WS_RK);
    const float* mu = p.in[I_SMU];
    for (int it = c.gw; it < NB * NH * NCHUNK; it += c.NGW) {
        const int m = it % NCHUNK, bh = it / NCHUNK, h = bh % NH, b = bh / NH, hc = h * HS + c.lane;
        const bool lat = m >= 16; const int pitch = lat ? ZN : ZCN, len = lat ? SEQ : CTXL, t0 = lat ? (m - 16) * 16 : m * 16;
        const size_t rowbase = lat ? (size_t)b * SEQ + t0 : (size_t)b * CTXL + t0;
        const bf16* zp = lat ? ZL + rowbase * ZN + ZR0 : ZC + rowbase * ZCN;
        const size_t lrow = lat ? rowbase : (size_t)TL + rowbase;
        const float mpr = mu[hc], mnr = mu[DSHIFT + hc], mpk = mu[DR + hc], mnk = mu[DSHIFT + DR + hc], mpv = mu[2 * DR + hc], mnv = mu[DSHIFT + 2 * DR + hc];
        const float kk_ = p.in[I_KK][hc], ka_ = p.in[I_KA][hc], rk_ = p.in[I_RK][hc];
        const float w00 = p.in[I_W0][hc], w01 = p.in[I_W0][DR + hc], a00 = p.in[I_A0][hc], a01 = p.in[I_A0][DR + hc];
        float* rec0 = (float*)(SC + ((size_t)(bh * 2 + 0) * NCHUNK + m) * SBUF) + c.lane;
        float* rec1 = (float*)(SC + ((size_t)(bh * 2 + 1) * NCHUNK + (lat ? 159 - m : 15 - m)) * SBUF) + c.lane;
        float zr[18], zk[18], zv[18];
#pragma unroll
        for (int i = 0; i < 18; ++i) { const int t = t0 - 1 + i; const bool ok = t >= 0 && t < len; const int tc = t < 0 ? 0 : (t >= len ? len - 1 : t); const float msk = ok ? 1.f : 0.f;
            const bf16* q = zp + (ptrdiff_t)(tc - t0) * pitch;
            zr[i] = msk * bf1(q[hc]); zk[i] = msk * bf1(q[DR + hc]); zv[i] = msk * bf1(q[2 * DR + hc]); }
        float s_r[16], s_v[16], s_na[16], s_w[16], s_b[16], s_kd[16];
        bf16 lw0[16], lw1[16], la0[16], la1[16];
#pragma unroll
        for (int i = 0; i < 16; ++i) { const bf16* lp = LO + (lrow + i) * LORA_N + hc; lw0[i] = lp[0]; lw1[i] = lp[DR]; la0[i] = lp[2 * DR]; la1[i] = lp[3 * DR]; }
        float gam = 1.f;
#pragma unroll
        for (int i = 0; i < 16; ++i) {
            const float r = zr[i + 1] + mpr * (zr[i] - zr[i + 1]) + mnr * (zr[i + 2] - zr[i + 1]);
            const float k = zk[i + 1] + mpk * (zk[i] - zk[i + 1]) + mnk * (zk[i + 2] - zk[i + 1]);
            const float v = zv[i + 1] + mpv * (zv[i] - zv[i + 1]) + mnv * (zv[i + 2] - zv[i + 1]);
            const float kr = k * kk_; const float nrm = sqrtf(wave_sum(kr * kr)); const float kk = kr / fmaxf(nrm, 1e-12f);
            const float wl0 = bf1(lw0[i]), wl1 = bf1(lw1[i]), al0 = bf1(la0[i]), al1 = bf1(la1[i]);
            const float aa0 = sigm(a00 + al0), aa1 = sigm(a01 + al1);
            const float w0 = __expf(-0.6065306597f * sigm(w00 + wl0)), w1 = __expf(-0.6065306597f * sigm(w01 + wl1));
            const float kd0 = k * (1.f + (aa0 - 1.f) * ka_), kd1 = k * (1.f + (aa1 - 1.f) * ka_);
            s_r[i] = r; s_v[i] = v; s_na[i] = -kk; s_w[i] = w1; s_b[i] = kk * aa1; s_kd[i] = kd1;
            { const float gprev = gam; gam *= w0; const float inv = __builtin_amdgcn_rcpf(gam); float* o = rec0 + i * 320;
              o[0] = gprev * -kk; o[64] = kk * aa0 * inv; o[128] = kd0 * inv; o[192] = gam * r; o[256] = v; }
            if (lat) { const float s = wave_sum(r * (kd0 + kd1) * rk_); if (c.lane == 0) RK[(rowbase + i) * NH + h] = s;
                VS[(rowbase + i) * DR + hc] = (bf16)f2bf(v); }
        }
        rec0[SCH * 320] = gam;
        gam = 1.f;
#pragma unroll
        for (int s = 0; s < 16; ++s) { const int i = 15 - s;
            const float gprev = gam; gam *= s_w[i]; const float inv = __builtin_amdgcn_rcpf(gam); float* o = rec1 + s * 320;
            o[0] = gprev * s_na[i]; o[64] = s_b[i] * inv; o[128] = s_kd[i] * inv; o[192] = gam * s_r[i]; o[256] = s_v[i]; }
        rec1[SCH * 320] = gam;
    }
}

constexpr int SNB = 4, SLOT = SBUF + 768, S_FULL = SNB * SLOT, S_DONE = S_FULL + 64;
__device__ __forceinline__ float dpp_xor1(float x) { return __builtin_bit_cast(float, __builtin_amdgcn_update_dpp(0, __builtin_bit_cast(int, x), 0xB1, 0xf, 0xf, true)); }
__device__ __forceinline__ float dpp_xor2(float x) { return __builtin_bit_cast(float, __builtin_amdgcn_update_dpp(0, __builtin_bit_cast(int, x), 0x4E, 0xf, 0xf, true)); }
__device__ __forceinline__ float dpp_hmir(float x) { return __builtin_bit_cast(float, __builtin_amdgcn_update_dpp(0, __builtin_bit_cast(int, x), 0x141, 0xf, 0xf, true)); }
__device__ __forceinline__ float red8(float x) { x += dpp_xor1(x); x += dpp_xor2(x); x += dpp_hmir(x); return x; }
struct ScanCoef { f32x4 a0, a1, b0, b1, k0, k1, r0, r1; f32x2 vv; };
__device__ __forceinline__ ScanCoef scan_ld(const LAS unsigned char* sb, const LAS unsigned char* vb) {
    ScanCoef o; o.a0 = *(const LAS f32x4*)(sb); o.a1 = *(const LAS f32x4*)(sb + 16); o.b0 = *(const LAS f32x4*)(sb + 256); o.b1 = *(const LAS f32x4*)(sb + 272);
    o.k0 = *(const LAS f32x4*)(sb + 512); o.k1 = *(const LAS f32x4*)(sb + 528); o.r0 = *(const LAS f32x4*)(sb + 768); o.r1 = *(const LAS f32x4*)(sb + 784);
    o.vv = *(const LAS f32x2*)(vb); return o;
}
__device__ __forceinline__ void p6_scan(const Params& p, const Ctx& c) {
    LAS unsigned char* L = c.lds; volatile LAS unsigned* full = (volatile LAS unsigned*)(L + S_FULL); volatile LAS unsigned* done = (volatile LAS unsigned*)(L + S_DONE);
    float* Y = (float*)(p.ws + WS_Y);
    for (int sid = c.bid; sid < NB * NH * 2; sid += c.G) {
        if (c.tid < 8) { full[c.tid] = 0u; done[c.tid] = 0u; }
        __syncthreads();
        const int d = sid & 1, bh = sid >> 1, h = bh % NH, b = bh / NH;
        if (c.wave == 4) {
            const unsigned char* src = p.ws + WS_SC2 + (size_t)sid * NCHUNK * SBUF + 16 * c.lane;
            for (int ch = 0; ch < NCHUNK; ++ch) {
                const int buf = ch & (SNB - 1);
                if (ch >= SNB) { const unsigned want = 4u * (unsigned)(ch / SNB); unsigned sp = 0; while (done[buf] < want) { __builtin_amdgcn_s_sleep(1); if (++sp > (1u << 24)) break; } }
                const unsigned char* g = src + (size_t)ch * SBUF; LAS unsigned char* dl = L + buf * SLOT;
#pragma unroll
                for (int i = 0; i < 20; ++i) __builtin_amdgcn_global_load_lds((const unsigned*)(g + i * 1024), (LAS unsigned*)(dl + i * 1024), 16, 0, 0);
                if (c.lane < 16) __builtin_amdgcn_global_load_lds((const unsigned*)(g + 20480), (LAS unsigned*)(dl + 20480), 16, 0, 0);
                if (ch >= 1) { asm volatile("s_waitcnt vmcnt(21)" ::: "memory"); if (c.lane == 0) full[(ch - 1) & (SNB - 1)] = (unsigned)ch; }
            }
            asm volatile("s_waitcnt vmcnt(0)" ::: "memory"); if (c.lane == 0) full[(NCHUNK - 1) & (SNB - 1)] = (unsigned)NCHUNK;
        } else if (c.wave < 4) {
            const int vp = c.lane >> 3, q = c.lane & 7, v0 = 16 * c.wave + 2 * vp;
            f32x2 S0[4], S1[4];
#pragma unroll
            for (int j = 0; j < 4; ++j) { S0[j] = (f32x2){0.f, 0.f}; S1[j] = (f32x2){0.f, 0.f}; }
            float* yp = Y + ((size_t)d * TL + (size_t)b * SEQ + (d ? SEQ - 1 : 0)) * DR + h * HS + v0; const ptrdiff_t ystep = d ? -(ptrdiff_t)DR : (ptrdiff_t)DR;
            for (int ch = 0; ch < NCHUNK; ++ch) {
                const int buf = ch & (SNB - 1); { unsigned sp = 0; while (full[buf] != (unsigned)(ch + 1)) { __builtin_amdgcn_s_sleep(1); if (++sp > (1u << 24)) break; } }
                const LAS unsigned char* base = L + buf * SLOT; const LAS unsigned char* sb = base + 32 * q; const LAS unsigned char* vb = base + 1024 + 4 * v0;
                const bool lat = ch >= CTXL / SCH;
                ScanCoef cur = scan_ld(sb, vb);
#pragma unroll 2
                for (int s = 0; s < SCH; ++s) {
                    const int sn = (s + 1 < SCH) ? s + 1 : s;
                    const ScanCoef nx = scan_ld(sb + sn * 1280, vb + sn * 1280);
                    const f32x2 A[4] = {cur.a0.xy, cur.a0.zw, cur.a1.xy, cur.a1.zw}, Bc[4] = {cur.b0.xy, cur.b0.zw, cur.b1.xy, cur.b1.zw};
                    const f32x2 Kc[4] = {cur.k0.xy, cur.k0.zw, cur.k1.xy, cur.k1.zw}, Rc[4] = {cur.r0.xy, cur.r0.zw, cur.r1.xy, cur.r1.zw};
                    f32x2 q0 = S0[0] * A[0], q1 = S1[0] * A[0];
#pragma unroll
                    for (int j = 1; j < 4; ++j) { q0 = __builtin_elementwise_fma(S0[j], A[j], q0); q1 = __builtin_elementwise_fma(S1[j], A[j], q1); }
                    const float p0 = red8(q0.x + q0.y), p1 = red8(q1.x + q1.y);
                    const f32x2 pp0 = (f32x2){p0, p0}, pp1 = (f32x2){p1, p1}, vv0 = (f32x2){cur.vv.x, cur.vv.x}, vv1 = (f32x2){cur.vv.y, cur.vv.y};
#pragma unroll
                    for (int j = 0; j < 4; ++j) { S0[j] = __builtin_elementwise_fma(pp0, Bc[j], __builtin_elementwise_fma(vv0, Kc[j], S0[j])); S1[j] = __builtin_elementwise_fma(pp1, Bc[j], __builtin_elementwise_fma(vv1, Kc[j], S1[j])); }
                    if (lat) { f32x2 y0 = S0[0] * Rc[0], y1 = S1[0] * Rc[0];
#pragma unroll
                        for (int j = 1; j < 4; ++j) { y0 = __builtin_elementwise_fma(S0[j], Rc[j], y0); y1 = __builtin_elementwise_fma(S1[j], Rc[j], y1); }
                        const float z0 = red8(y0.x + y0.y), z1 = red8(y1.x + y1.y);
                        if (q == 0) *(f32x2*)yp = (f32x2){z0, z1};
                        yp += ystep; }
                    cur = nx;
                }
                const f32x4 g0 = *(const LAS f32x4*)(base + SCH * 1280 + 32 * q), g1 = *(const LAS f32x4*)(base + SCH * 1280 + 32 * q + 16);
                const f32x2 Gm[4] = {g0.xy, g0.zw, g1.xy, g1.zw};
#pragma unroll
                for (int j = 0; j < 4; ++j) { S0[j] *= Gm[j]; S1[j] *= Gm[j]; }
                asm volatile("s_waitcnt lgkmcnt(0)" ::: "memory");
                if (c.lane == 0) __hip_atomic_fetch_add((LAS unsigned*)(L + S_DONE) + buf, 1u, __ATOMIC_RELAXED, __HIP_MEMORY_SCOPE_WORKGROUP);
            }
        } else if (CONV_IN_SCAN && sid == c.bid) {
            moe_convert(p, c.bid * 3 + (c.wave - 5), c.G * 3, c.lane);
        }
        __syncthreads();
    }
}

__device__ __forceinline__ void p7_rwkvout(const Params& p, const Ctx& c) {
    const float* Y = (const float*)(p.ws + WS_Y); const float* RK = (const float*)(p.ws + WS_RK); const bf16* VS = (const bf16*)(p.ws + WS_VS);
    const bf16* LO = (const bf16*)(p.ws + WS_LORA); bf16* AR = (bf16*)(p.ws + WS_ARWKV);
    const int c0 = 16 * c.lane, hd = c.lane >> 2;
    f32x4 g[4], bb[4];
#pragma unroll
    for (int q = 0; q < 4; ++q) { g[q] = *(const f32x4*)(p.in[I_LNXG] + c0 + 4 * q); bb[q] = *(const f32x4*)(p.in[I_LNXB] + c0 + 4 * q); }
    for (int row = c.gw; row < TL; row += c.NGW) {
        f32x4 y[4]; float s = 0.f;
#pragma unroll
        for (int q = 0; q < 4; ++q) { y[q] = *(const f32x4*)(Y + (size_t)row * DR + c0 + 4 * q) + *(const f32x4*)(Y + ((size_t)TL + row) * DR + c0 + 4 * q); s += (y[q][0] + y[q][1]) + (y[q][2] + y[q][3]); }
        s += __shfl_xor(s, 1); s += __shfl_xor(s, 2); const float mean = s * (1.f / HS); float s2 = 0.f;
#pragma unroll
        for (int q = 0; q < 4; ++q) { y[q] = y[q] - mean; s2 += (y[q][0] * y[q][0] + y[q][1] * y[q][1]) + (y[q][2] * y[q][2] + y[q][3] * y[q][3]); }
        s2 += __shfl_xor(s2, 1); s2 += __shfl_xor(s2, 2); const float rstd = __builtin_amdgcn_rsqf(s2 * (1.f / HS) + GN_EPS);
        const float rk = RK[(size_t)row * NH + hd];
        f32x4 v[4], gt[4];
        unpack8(*(const u32x4*)(VS + (size_t)row * DR + c0), v[0], v[1]); unpack8(*(const u32x4*)(VS + (size_t)row * DR + c0 + 8), v[2], v[3]);
        unpack8(*(const u32x4*)(LO + (size_t)row * LORA_N + 4 * DR + c0), gt[0], gt[1]); unpack8(*(const u32x4*)(LO + (size_t)row * LORA_N + 4 * DR + c0 + 8), gt[2], gt[3]);
#pragma unroll
        for (int q = 0; q < 4; ++q) y[q] = (y[q] * rstd * g[q] + bb[q] + v[q] * rk) * gt[q];
        bf16* o = AR + (size_t)row * DR + c0; *(u32x4*)o = pg8::pack8(y[0], y[1]); *(u32x4*)(o + 8) = pg8::pack8(y[2], y[3]);
    }
}

__device__ __forceinline__ void p10_router(const Params& p, const Ctx& c) {
    const float* T1 = (const float*)(p.ws + WS_T1); float* XM = (float*)(p.ws + WS_XMID); bf16* UH = (bf16*)(p.ws + WS_U2HI); bf16* UL = (bf16*)(p.ws + WS_U2LO);
    const float* mod = (const float*)(p.ws + WS_MOD); const bf16* WRt = (const bf16*)(p.ws + WS_WR);
    unsigned* cntg = (unsigned*)(p.ws + WS_CTL) + CW_CNT; int* rowtok = (int*)(p.ws + WS_ROWTOK); float* roww = (float*)(p.ws + WS_ROWW); unsigned* sel = (unsigned*)(p.ws + WS_SEL);
    for (int un = c.bid; un < TL / 64; un += c.G) {
        const int r0 = un * 64, b = r0 / SEQ;
        const float* sh = mod + (size_t)b * (6 * D) + 3 * D; const float* sc = sh + D;
        for (int i = 0; i < 8; ++i) { const int row = r0 + c.wave * 8 + i;
            f32x4 v[8]; float s = 0.f;
#pragma unroll
            for (int j = 0; j < 8; ++j) { v[j] = *(const f32x4*)(T1 + (size_t)row * D + 4 * c.lane + 256 * j); s += (v[j][0] + v[j][1]) + (v[j][2] + v[j][3]); }
            float mean = wave_sum(s) * (1.f / D), s2 = 0.f;
#pragma unroll
            for (int j = 0; j < 8; ++j) { v[j] = v[j] - mean; s2 += (v[j][0] * v[j][0] + v[j][1] * v[j][1]) + (v[j][2] * v[j][2] + v[j][3] * v[j][3]); }
            float rstd = __builtin_amdgcn_rsqf(wave_sum(s2) * (1.f / D) + LN_EPS); s = 0.f;
#pragma unroll
            for (int j = 0; j < 8; ++j) { const int col = 4 * c.lane + 256 * j; v[j] = v[j] * rstd * *(const f32x4*)(p.in[I_LN1G] + col) + *(const f32x4*)(p.in[I_LN1B] + col);
                *(f32x4*)(XM + (size_t)row * D + col) = v[j]; s += (v[j][0] + v[j][1]) + (v[j][2] + v[j][3]); }
            mean = wave_sum(s) * (1.f / D); s2 = 0.f;
#pragma unroll
            for (int j = 0; j < 8; ++j) { v[j] = v[j] - mean; s2 += (v[j][0] * v[j][0] + v[j][1] * v[j][1]) + (v[j][2] * v[j][2] + v[j][3] * v[j][3]); }
            rstd = __builtin_amdgcn_rsqf(wave_sum(s2) * (1.f / D) + LN_EPS);
#pragma unroll
            for (int j = 0; j < 8; ++j) { const int col = 4 * c.lane + 256 * j; const f32x4 o = v[j] * rstd * (*(const f32x4*)(sc + col) + 1.0f) + *(const f32x4*)(sh + col);
                u32x2 hi; hi.x = cvt_pk_bf16(o[0], o[1]); hi.y = cvt_pk_bf16(o[2], o[3]);
                u32x2 lo; lo.x = cvt_pk_bf16(o[0] - bflo(hi.x), o[1] - bfhi(hi.x)); lo.y = cvt_pk_bf16(o[2] - bflo(hi.y), o[3] - bfhi(hi.y));
                *(u32x2*)(UH + (size_t)row * D + col) = hi; *(u32x2*)(UL + (size_t)row * D + col) = lo; }
        }
        asm volatile("s_waitcnt vmcnt(0)" ::: "memory");
        __syncthreads();
        if (c.wave < 4) {
            const int tr = r0 + 16 * c.wave + (c.lane & 15), kq = 8 * (c.lane >> 4);
            f32x4 acc0 = (f32x4){0.f, 0.f, 0.f, 0.f}, acc1 = acc0;
            const bf16* ah = UH + (size_t)tr * D + kq; const bf16* al = UL + (size_t)tr * D + kq;
            const bf16* bh0 = WRt + (size_t)(c.lane & 15) * D + kq; const bf16* bh1 = bh0 + 16 * D; const bf16* bl0 = bh0 + NE * D; const bf16* bl1 = bl0 + 16 * D;
#pragma unroll 4
            for (int s = 0; s < D / 32; ++s) {
                const bf16x8 xh = *(const bf16x8*)(ah + 32 * s), xl = *(const bf16x8*)(al + 32 * s);
                const bf16x8 wh0 = *(const bf16x8*)(bh0 + 32 * s), wh1 = *(const bf16x8*)(bh1 + 32 * s), wl0 = *(const bf16x8*)(bl0 + 32 * s), wl1 = *(const bf16x8*)(bl1 + 32 * s);
                acc0 = __builtin_amdgcn_mfma_f32_16x16x32_bf16(xh, wh0, acc0, 0, 0, 0); acc1 = __builtin_amdgcn_mfma_f32_16x16x32_bf16(xh, wh1, acc1, 0, 0, 0);
                acc0 = __builtin_amdgcn_mfma_f32_16x16x32_bf16(xl, wh0, acc0, 0, 0, 0); acc1 = __builtin_amdgcn_mfma_f32_16x16x32_bf16(xl, wh1, acc1, 0, 0, 0);
                acc0 = __builtin_amdgcn_mfma_f32_16x16x32_bf16(xh, wl0, acc0, 0, 0, 0); acc1 = __builtin_amdgcn_mfma_f32_16x16x32_bf16(xh, wl1, acc1, 0, 0, 0);
            }
            LAS float* lg = (LAS float*)(c.lds + c.wave * 2048);
            const float br0 = p.in[I_BROUTER][c.lane & 15], br1 = p.in[I_BROUTER][16 + (c.lane & 15)];
#pragma unroll
            for (int i = 0; i < 4; ++i) { const int tk = (c.lane >> 4) * 4 + i; lg[tk * 32 + (c.lane & 15)] = acc0[i] + br0; lg[tk * 32 + 16 + (c.lane & 15)] = acc1[i] + br1; }
            asm volatile("s_waitcnt lgkmcnt(0)" ::: "memory");
            if (c.lane < 16) {
                float l[32];
#pragma unroll
                for (int q = 0; q < 8; ++q) { const f32x4 t = *(const LAS f32x4*)(lg + c.lane * 32 + 4 * q); l[4 * q] = t[0]; l[4 * q + 1] = t[1]; l[4 * q + 2] = t[2]; l[4 * q + 3] = t[3]; }
                unsigned used = 0u; float tv[4]; int ti[4];
#pragma unroll
                for (int s = 0; s < 4; ++s) { float best = -3.0e38f; int bi = 0;
#pragma unroll
                    for (int e = 0; e < 32; ++e) { const bool ok = !((used >> e) & 1u) && (l[e] > best); best = ok ? l[e] : best; bi = ok ? e : bi; }
                    used |= 1u << bi; tv[s] = best; ti[s] = bi; }
                const float e1 = __expf(tv[1] - tv[0]), e2 = __expf(tv[2] - tv[0]), e3 = __expf(tv[3] - tv[0]); const float inv = 1.f / (1.f + e1 + e2 + e3);
                const float gw[4] = {inv, e1 * inv, e2 * inv, e3 * inv};
                const int row = r0 + 16 * c.wave + c.lane;
#pragma unroll
                for (int s = 0; s < 4; ++s) { const unsigned j = __hip_atomic_fetch_add(cntg + 16 * ti[s], 1u, RLX_AGENT);
                    rowtok[(size_t)ti[s] * ECAP + j] = row; roww[(size_t)ti[s] * ECAP + j] = gw[s]; sel[row * 4 + s] = ((unsigned)ti[s] << 16) | j; }
            }
        }
        __syncthreads();
    }
}
__device__ __forceinline__ void moe_plan(const Params& p, const Ctx& c) {
    LAS int* cnt = (LAS int*)(c.lds + LX_CNT); LAS int* tst = (LAS int*)(c.lds + LX_TST); LAS unsigned char* te = (LAS unsigned char*)(c.lds + LX_TE);
    const unsigned* cntg = (const unsigned*)(p.ws + WS_CTL) + CW_CNT;
    __syncthreads();
    if (c.tid < NE) cnt[c.tid] = (int)__hip_atomic_load(cntg + 16 * c.tid, RLX_AGENT);
    __syncthreads();
    if (c.tid == 0) { int a = 0; for (int e = 0; e < NE; ++e) { tst[e] = a; a += (cnt[e] + 255) >> 8; } tst[NE] = a; }
    __syncthreads();
    if (c.tid < NE) { for (int t = tst[c.tid]; t < tst[c.tid + 1]; ++t) te[t] = (unsigned char)c.tid; }
    __syncthreads();
}
__device__ __forceinline__ void p13_final(const Params& p, const Ctx& c) {
    const float* XM = (const float*)(p.ws + WS_XMID); const bf16* DN = (const bf16*)(p.ws + WS_DOWN); const unsigned* sel = (const unsigned*)(p.ws + WS_SEL);
    const float* mod = (const float*)(p.ws + WS_MOD); const LAS int* tst = (const LAS int*)(c.lds + LX_TST);
    for (int row = c.gw; row < TL; row += c.NGW) {
        const int b = row / SEQ; const float* gate = mod + (size_t)b * (6 * D) + 5 * D;
        f32x4 a[4][2];
#pragma unroll
        for (int j = 0; j < 4; ++j) { a[j][0] = (f32x4){0.f, 0.f, 0.f, 0.f}; a[j][1] = a[j][0]; }
#pragma unroll
        for (int s = 0; s < 4; ++s) { const unsigned sv = sel[row * 4 + s]; const int e = (int)(sv >> 16), jj = (int)(sv & 0xffffu); const size_t pos = (size_t)tst[e] * 256 + jj;
#pragma unroll
            for (int j = 0; j < 4; ++j) { f32x4 x0, x1; pg8::unpack8(*(const u32x4*)(DN + pos * D + 8 * c.lane + 512 * j), x0, x1); a[j][0] += x0; a[j][1] += x1; } }
        float s = 0.f;
#pragma unroll
        for (int j = 0; j < 4; ++j)
#pragma unroll
            for (int hh = 0; hh < 2; ++hh) { const int col = 8 * c.lane + 512 * j + 4 * hh; a[j][hh] = *(const f32x4*)(XM + (size_t)row * D + col) * DN_ALPHA + *(const f32x4*)(gate + col) * a[j][hh];
                s += (a[j][hh][0] + a[j][hh][1]) + (a[j][hh][2] + a[j][hh][3]); }
        const float mean = wave_sum(s) * (1.f / D); float s2 = 0.f;
#pragma unroll
        for (int j = 0; j < 4; ++j)
#pragma unroll
            for (int hh = 0; hh < 2; ++hh) { a[j][hh] = a[j][hh] - mean; s2 += (a[j][hh][0] * a[j][hh][0] + a[j][hh][1] * a[j][hh][1]) + (a[j][hh][2] * a[j][hh][2] + a[j][hh][3] * a[j][hh][3]); }
        const float rstd = __builtin_amdgcn_rsqf(wave_sum(s2) * (1.f / D) + LN_EPS);
#pragma unroll
        for (int j = 0; j < 4; ++j)
#pragma unroll
            for (int hh = 0; hh < 2; ++hh) { const int col = 8 * c.lane + 512 * j + 4 * hh;
                *(f32x4*)(p.out + (size_t)row * D + col) = a[j][hh] * rstd * *(const f32x4*)(p.in[I_LN2G] + col) + *(const f32x4*)(p.in[I_LN2B] + col); }
    }
}

constexpr int N_PHASES = 14;
__global__ void __launch_bounds__(512, 2) fwd(Params p) {
    extern __shared__ __attribute__((aligned(16))) unsigned char lds_raw[];
    Ctx c; c.lds = (LAS unsigned char*)lds_raw; c.tid = threadIdx.x; c.lane = c.tid & 63; c.wave = __builtin_amdgcn_readfirstlane(c.tid >> 6);
    c.G = gridDim.x; c.bid = blockIdx.x; c.gw = c.bid * 8 + c.wave; c.NGW = c.G * 8;
    unsigned char* ws = p.ws;
    const int lo = p.ph_lo, hi = p.ph_hi;
    volatile LAS unsigned* MISC = (volatile LAS unsigned*)(c.lds + LX_MISC);
    if (c.tid < 64) MISC[c.tid] = 0u;
    __syncthreads();
    XcdBarrier bar; bar.bar = (unsigned*)(ws + WS_CTL) + CW_BAR; bar.x = 0; bar.st = nullptr;
    if (hi - lo > 1) bar = xcd_barrier_post((unsigned*)(ws + WS_CTL) + CW_BAR, MISC + 8);
#ifndef ONLY_PHASE
#define ONLY_PHASE -1
#endif
#define IN(k) ((ONLY_PHASE < 0 || ONLY_PHASE == (k)) && lo <= (k) && (k) < hi)
#define SEAM(k) do { if (IN(k) && IN((k) + 1)) xcd_barrier(bar); } while (0)
    LAS unsigned char* ring = c.lds;

#ifndef DUP_MASK
#define DUP_MASK 0
#endif
#define PH(k, ...) do { if (IN(k)) { __VA_ARGS__ if constexpr (((DUP_MASK) >> (k)) & 1) { if (hi - lo > 1) xcd_barrier(bar); __VA_ARGS__ } } SEAM(k); } while (0)
    PH(0, { p0_adaln(p, c); p0_small(p, c); p0_convert(p, c); if (!CONV_IN_SCAN) moe_convert(p, c.gw, c.NGW, c.lane); });
    PH(1, { p1_modulate(p, c); });
    PH(2, { pg8::InProjSched S{(const bf16*)(ws + WS_U), (const bf16*)(ws + WS_WIN), c.G, c.bid};
        pg8::EpiInProj E{(bf16*)(ws + WS_ZL), (bf16*)(ws + WS_ZC), (const float*)(ws + WS_BIN)};
        pg8::gemm_phase<pg8::EpiInProj, pg8::InProjSched, false>(ring, D, S, E, nullptr); });
    PH(3, { p3_conv(p, c); p3_alora(p, c); });
    PH(4, {
        { pg8::PlainSched S{(const bf16*)(ws + WS_ALORA), (const bf16*)(ws + WS_WLORA), LORA_K, TT / 256, LORA_N / 256, c.G, c.bid};
          pg8::EpiBf16Plain E{(bf16*)(ws + WS_LORA), LORA_N, nullptr};
          pg8::gemm_phase<pg8::EpiBf16Plain, pg8::PlainSched, false>(ring, LORA_K, S, E, nullptr); }
        { pg8::PlainSched S{(const bf16*)(ws + WS_ACONV), (const bf16*)(ws + WS_WCO), DCV, TL / 256, D / 256, c.G, c.bid};
          pg8::EpiConvO E{(bf16*)(ws + WS_MIX), (const bf16*)(ws + WS_ZL), p.in[I_BCO]};
          pg8::gemm_phase<pg8::EpiConvO, pg8::PlainSched, false>(ring, DCV, S, E, nullptr); }
    });
    PH(5, { p5_prep(p, c); });
    PH(6, { p6_scan(p, c); });
    PH(7, { p7_rwkvout(p, c); });
    PH(8, { pg8::PlainSched S{(const bf16*)(ws + WS_ARWKV), (const bf16*)(ws + WS_WRO), DR, TL / 256, D / 256, c.G, c.bid};
        pg8::EpiRwkvO E{(bf16*)(ws + WS_MIX), (const bf16*)(ws + WS_ZL)};
        pg8::gemm_phase<pg8::EpiRwkvO, pg8::PlainSched, false>(ring, DR, S, E, nullptr); });
    PH(9, { pg8::PlainSched S{(const bf16*)(ws + WS_MIX), (const bf16*)(ws + WS_WOUT), D, TL / 256, D / 256, c.G, c.bid};
        pg8::EpiOut E{(float*)(ws + WS_T1), p.in[I_X], (const float*)(ws + WS_MOD), p.in[I_BOUT]};
        pg8::gemm_phase<pg8::EpiOut, pg8::PlainSched, false>(ring, D, S, E, nullptr); });
    PH(10, { p10_router(p, c); });
    PH(11, { moe_plan(p, c);
        pg8::MoeSched S{nullptr, (const bf16*)(ws + WS_WGU), (const int*)(ws + WS_ROWTOK), D, 4096, 16, c.G, c.bid, (const LAS int*)(c.lds + LX_CNT), (const LAS int*)(c.lds + LX_TST), (const LAS unsigned char*)(c.lds + LX_TE)};
        pg8::EpiGateUp E{(bf16*)(ws + WS_HID), (const float*)(ws + WS_BGU)};
        pg8::gemm_phase<pg8::EpiGateUp, pg8::MoeSched, true>(ring, D, S, E, (const char*)(ws + WS_U2HI)); });
    PH(12, { moe_plan(p, c);
        pg8::MoeSched S{(const bf16*)(ws + WS_HID), (const bf16*)(ws + WS_WDN), (const int*)(ws + WS_ROWTOK), D, D, 8, c.G, c.bid, (const LAS int*)(c.lds + LX_CNT), (const LAS int*)(c.lds + LX_TST), (const LAS unsigned char*)(c.lds + LX_TE)};
        pg8::EpiDown E{(bf16*)(ws + WS_DOWN), p.in[I_BDN], (const float*)(ws + WS_ROWW), (const LAS int*)(c.lds + LX_CNT)};
        pg8::gemm_phase<pg8::EpiDown, pg8::MoeSched, false>(ring, D, S, E, nullptr); });
    PH(13, { moe_plan(p, c); p13_final(p, c); });
#undef PH
#undef IN
#undef SEAM
}

extern "C" void kernel_launch(void* const* d_in, const int* in_sizes, int n_in, void* d_out, int out_size, void* d_ws, size_t ws_size, hipStream_t stream) {
    static int grid = 0;
    if (grid == 0) {
        if (n_in != 38 || out_size != TL * D || ws_size < WS_END) { fprintf(stderr, "kernel_launch: unexpected shapes: n_in %d out %d ws %zu (need %zu)\n", n_in, out_size, ws_size, (size_t)WS_END); grid = -1; return; }
        int dev = 0, cus = 0, per_cu = 0;
        if (hipGetDevice(&dev) != hipSuccess || hipDeviceGetAttribute(&cus, hipDeviceAttributeMultiprocessorCount, dev) != hipSuccess) { grid = -1; return; }
        if (hipFuncSetAttribute((const void*)fwd, hipFuncAttributeMaxDynamicSharedMemorySize, LDS_BYTES) != hipSuccess) { fprintf(stderr, "kernel_launch: hipFuncSetAttribute failed\n"); grid = -1; return; }
        if (hipOccupancyMaxActiveBlocksPerMultiprocessor(&per_cu, (const void*)fwd, 512, LDS_BYTES) != hipSuccess || per_cu < 1) { fprintf(stderr, "kernel_launch: occupancy query says %d\n", per_cu); }
        (void)hipGetLastError();
        grid = cus;
    }
    if (grid < 0) return;
    (void)in_sizes;
    (void)hipMemsetAsync((char*)d_ws + WS_CTL, 0, CTL_ZERO_BYTES, stream);
    Params p; memset(&p, 0, sizeof(p));
    for (int i = 0; i < 38; ++i) p.in[i] = (const float*)d_in[i];
    p.out = (float*)d_out; p.ws = (unsigned char*)d_ws;
#if MK_FUSED
    p.ph_lo = 0; p.ph_hi = N_PHASES;
    hipLaunchKernelGGL(fwd, dim3(grid), dim3(512), LDS_BYTES, stream, p);
#else
    for (int k = 0; k < N_PHASES; ++k) { p.ph_lo = k; p.ph_hi = k + 1; hipLaunchKernelGGL(fwd, dim3(grid), dim3(512), LDS_BYTES, stream, p); }
#endif
}
```

```cpp
#include <hip/hip_runtime.h>
#include <cstdio>
#include <cstdint>
#include <cstring>

#ifndef CONV_IN_SCAN
#define CONV_IN_SCAN 1
#endif
#ifndef MK_FUSED
#define MK_FUSED 1
#endif

#define GAS __attribute__((address_space(1)))
#define LAS __attribute__((address_space(3)))
typedef unsigned short bf16;
typedef short bf16x8 __attribute__((ext_vector_type(8)));
typedef float f32x4 __attribute__((ext_vector_type(4)));
typedef float f32x2 __attribute__((ext_vector_type(2)));
typedef unsigned u32x4 __attribute__((ext_vector_type(4)));
typedef unsigned u32x2 __attribute__((ext_vector_type(2)));
typedef int v8i __attribute__((ext_vector_type(8)));
typedef int v4i __attribute__((ext_vector_type(4)));

constexpr int D = 2048, NB = 8, SEQ = 2048, CTXL = 256, TL = NB * SEQ, TC = NB * CTXL, TT = TL + TC;
constexpr int DCV = 1024, DR = 1024, NH = 16, HS = 64, CWID = 31;
constexpr int DSHIFT = 3488, PIN = 9632;
constexpr int ZN = 9728, ZCN = 3584, ZR0 = 2048, ZG0 = 5632;
constexpr int NE = 32, ECAP = 16384, MAXMT = 288;
constexpr int LORA_K = 512, LORA_N = 5120;
constexpr int SCH = 16, NCHUNK = (CTXL + SEQ) / SCH, SBUF = SCH * 1280 + 256;
constexpr float LN_EPS = 1e-5f, GN_EPS = 64e-5f, DN_ALPHA = 1.189207115002721f;
constexpr float SW_LIMIT = 7.0f, SW_ALPHA = 1.702f;
constexpr float W8_SCALE = 64.0f;
constexpr int SC_W8 = 0x79797979, SC_ONE = 0x7F7F7F7F;

constexpr size_t MiB = 1u << 20;
constexpr size_t WS_CTL = 0, CTL_ZERO_BYTES = 1 * MiB;
constexpr size_t WS_MOD = 1 * MiB, WS_BIN = 2 * MiB, WS_BGU = 2 * MiB + 65536, WS_WR = 3 * MiB, WS_SEL = 4 * MiB, WS_RK = 5 * MiB;
constexpr size_t WS_ROWTOK = 6 * MiB, WS_ROWW = 8 * MiB, WS_WCO = 10 * MiB, WS_WRO = 14 * MiB, WS_WOUT = 18 * MiB, WS_WLORA = 26 * MiB;
constexpr size_t WS_WIN = 32 * MiB, WS_U = 70 * MiB, WS_ACONV = 142 * MiB, WS_ALORA = 174 * MiB, WS_ARWKV = 192 * MiB, WS_VS = 224 * MiB;
constexpr size_t WS_MIX = 256 * MiB, WS_U2HI = 320 * MiB, WS_U2LO = 384 * MiB, WS_T1 = 448 * MiB, WS_XMID = 576 * MiB, WS_Y = 704 * MiB;
constexpr size_t WS_ZC = 832 * MiB, WS_LORA = 848 * MiB, WS_ZL = 1028 * MiB, WS_SC = 1332 * MiB, WS_WGU = 1728 * MiB, WS_WDN = 2240 * MiB;
constexpr size_t WS_U2F8 = 1332 * MiB;
constexpr size_t WS_HID = 2496 * MiB, WS_DOWN = 2784 * MiB, WS_SC2 = 3072 * MiB, WS_END = 3804 * MiB;
constexpr int CW_BAR = 4096;
constexpr int CW_CNT = 1024;

constexpr int RING_BYTES = 131072;
constexpr int LDSX_OFF = RING_BYTES;
constexpr int LX_MISC = LDSX_OFF;
constexpr int LX_CNT = LDSX_OFF + 256;
constexpr int LX_TST = LDSX_OFF + 512;
constexpr int LX_TE = LDSX_OFF + 768;
constexpr int LDS_BYTES = 147456;

__device__ __forceinline__ unsigned f2bf(float f) { unsigned u = __builtin_bit_cast(unsigned, f); return (u + 0x7fffu + ((u >> 16) & 1u)) >> 16; }
__device__ __forceinline__ unsigned cvt_pk_bf16(float lo, float hi) { unsigned r; asm volatile("v_cvt_pk_bf16_f32 %0, %1, %2" : "=v"(r) : "v"(lo), "v"(hi)); return r; }
__device__ __forceinline__ float clamp448(float x) { return fminf(fmaxf(x, -448.f), 448.f); }
__device__ __forceinline__ unsigned pk_fp8x4(float a, float b, float c, float d) {
    unsigned w = 0u; w = (unsigned)__builtin_amdgcn_cvt_pk_fp8_f32(clamp448(a), clamp448(b), (int)w, false); w = (unsigned)__builtin_amdgcn_cvt_pk_fp8_f32(clamp448(c), clamp448(d), (int)w, true); return w; }
__device__ __forceinline__ float bflo(unsigned u) { return __builtin_bit_cast(float, u << 16); }
__device__ __forceinline__ float bfhi(unsigned u) { return __builtin_bit_cast(float, u & 0xffff0000u); }
__device__ __forceinline__ float bf1(bf16 h) { return __builtin_bit_cast(float, ((unsigned)h) << 16); }
__device__ __forceinline__ float sigm(float x) { return __builtin_amdgcn_rcpf(1.f + __expf(-x)); }
__device__ __forceinline__ float wave_sum(float v) {
#pragma unroll
    for (int o = 1; o < 64; o <<= 1) v += __shfl_xor(v, o);
    return v;
}
#define RLX_AGENT __ATOMIC_RELAXED, __HIP_MEMORY_SCOPE_AGENT

#define XB_TMO      128
#define XB_XCNT(j)  (256  + 64 * (j))
#define XB_XSUB(j)  (1280 + 64 * (j))
#define XB_XGEN(j)  (2304 + 64 * (j))
#define XB_TOP      3328
#define XB_TOPGEN   3392
#define XCD_BAR_WORDS 3456
#define XB_SPIN_CAP (1u << 22)
__device__ __forceinline__ unsigned xb_ld(unsigned* p)              { return __hip_atomic_load(p, __ATOMIC_RELAXED, __HIP_MEMORY_SCOPE_AGENT); }
__device__ __forceinline__ unsigned xb_add(unsigned* p, unsigned v) { return __hip_atomic_fetch_add(p, v, __ATOMIC_RELAXED, __HIP_MEMORY_SCOPE_AGENT); }
__device__ __forceinline__ unsigned xb_xcc_id() { return (unsigned)__builtin_amdgcn_s_getreg((3 << 11) | 20) & 0xFu; }
#define XB_SPIN(cond, bar) do { unsigned _sp = 0; while (cond) { __builtin_amdgcn_s_sleep(1); \
    if ((++_sp & 255u) == 0u) { if (xb_ld(&(bar)[XB_TMO])) break; if (_sp > XB_SPIN_CAP) { atomicAdd(&(bar)[XB_TMO], 1u); break; } } } } while (0)
struct XcdBarrier { unsigned* bar; unsigned x; volatile LAS unsigned* st; };
__device__ __forceinline__ XcdBarrier xcd_barrier_post(unsigned* bar, volatile LAS unsigned* st) {
    XcdBarrier b; b.bar = bar; b.x = xb_xcc_id(); b.st = st;
    if (threadIdx.x == 0) (void)xb_add(&bar[XB_XCNT(b.x)], 1u);
    return b;
}
__device__ __forceinline__ void xcd_barrier_complete(unsigned* bar, unsigned x, unsigned& nloc, unsigned& nx) {
    const unsigned G = gridDim.x * gridDim.y * gridDim.z;
    unsigned sum, cnt, mine, sp = 0u;
    for (;;) {
        sum = 0u; cnt = 0u; mine = 0u;
#pragma unroll
        for (unsigned j = 0; j < 16; ++j) { const unsigned c = xb_ld(&bar[XB_XCNT(j)]); sum += c; cnt += (c > 0u) ? 1u : 0u; mine = (j == x) ? c : mine; }
        if (sum == G) break;
        __builtin_amdgcn_s_sleep(1);
        if ((++sp & 255u) == 0u) { if (xb_ld(&bar[XB_TMO])) break; if (sp > XB_SPIN_CAP) { atomicAdd(&bar[XB_TMO], 1u); break; } }
    }
    nloc = mine > 0u ? mine : 1u; nx = cnt > 0u ? cnt : 1u;
}
__device__ __forceinline__ void xcd_barrier(const XcdBarrier& b) {
    asm volatile("s_waitcnt vmcnt(0)" ::: "memory");
    __syncthreads();
    if (threadIdx.x == 0) {
        unsigned* bar = b.bar;
        __builtin_amdgcn_s_waitcnt(0);
        unsigned nloc = b.st[0], nx = b.st[1];
        if (nloc == 0u) { xcd_barrier_complete(bar, b.x, nloc, nx); b.st[0] = nloc; b.st[1] = nx; }
        const unsigned old = xb_add(&bar[XB_XSUB(b.x)], 1u);
        const unsigned gen = old / nloc;
        if (old + 1u == (gen + 1u) * nloc) {
            __builtin_amdgcn_fence(__ATOMIC_RELEASE, "agent");
            asm volatile("s_waitcnt vmcnt(0)" ::: "memory");
            const unsigned og = xb_add(&bar[XB_TOP], 1u);
            const unsigned tg = og / nx;
            if (og + 1u == (tg + 1u) * nx) xb_add(&bar[XB_TOPGEN], 1u);
            else XB_SPIN(xb_ld(&bar[XB_TOPGEN]) == tg, bar);
            __builtin_amdgcn_fence(__ATOMIC_ACQUIRE, "agent");
            xb_add(&bar[XB_XGEN(b.x)], 1u);
            asm volatile("s_waitcnt vmcnt(0)" ::: "memory");
        } else {
            XB_SPIN(xb_ld(&bar[XB_XGEN(b.x)]) == gen, bar);
            __builtin_amdgcn_fence(__ATOMIC_ACQUIRE, "agent");
            asm volatile("s_waitcnt vmcnt(0)" ::: "memory");
        }
    }
    __syncthreads();
}

namespace pg8 {
constexpr int BM = 256, BK = 64, HALF = 128, HTB = HALF * BK * 2, STAGE_BYTES = 8 * HTB, NXCD = 8, WGM = 8;
__host__ __device__ __forceinline__ int lds_byte(int r, int c) { const int st = (r >> 4) * 2 + (c >> 5), rr = r & 15, cc = c & 31, ob = rr * 64 + cc * 2; return st * 1024 + (ob ^ (((ob >> 9) & 1) << 5)); }
__host__ __device__ __forceinline__ void stage_rc(int b, int& R, int& C) { const int st = b / 1024, sb = b % 1024, swz = sb ^ (((sb >> 9) & 1) << 5); R = (st >> 1) * 16 + swz / 64; C = (st & 1) * 32 + (swz % 64) / 2; }
__host__ __device__ __forceinline__ int perm32(int rho) { const int n = rho >> 4, i = rho & 15; return 8 * (i >> 2) + 4 * n + (i & 3); }

struct Unit { int pm, pn, e, lt; };
__device__ __forceinline__ void map_tile(int wgid, int nwg, int nM, int nN, int& pm, int& pn) {
    { const int q = nwg / NXCD, r = nwg % NXCD, xcd = wgid % NXCD, off = wgid / NXCD; wgid = (xcd < r ? xcd * (q + 1) : r * (q + 1) + (xcd - r) * q) + off; }
    const int nig = WGM * nN, gid = wgid / nig, fm = gid * WGM, gsz = (nM - fm) < WGM ? (nM - fm) : WGM;
    pm = fm + ((wgid % nig) % gsz); pn = (wgid % nig) / gsz;
}
struct PlainSched {
    const bf16* A; const bf16* Bt; int K, nM, nN, G, c;
    __device__ __forceinline__ bool next(int i, Unit& u) const { const long L = (long)i * G + c; if (L >= (long)nM * nN) return false; map_tile((int)L, nM * nN, nM, nN, u.pm, u.pn); u.e = 0; u.lt = 0; return true; }
    __device__ __forceinline__ const char* aptr(const Unit& u) const { return (const char*)A + (size_t)u.pm * BM * K * 2; }
    __device__ __forceinline__ const char* bptr(const Unit& u) const { return (const char*)Bt + (size_t)u.pn * BM * K * 2; }
    __device__ __forceinline__ void rows(const Unit&, const int (&)[2], const int (&)[2], unsigned (&)[2][2]) const {}
};
struct InProjSched {
    const bf16* A; const bf16* Bt; int G, c;
    __device__ __forceinline__ bool next(int i, Unit& u) const {
        const int L = i * G + c; constexpr int NL = 64 * 38, NCX = 8 * 14;
        if (L >= NL + NCX) return false;
        if (L < NL) map_tile(L, NL, 64, 38, u.pm, u.pn); else { map_tile(L - NL, NCX, 8, 14, u.pm, u.pn); u.pm += 64; u.pn += 8; }
        u.e = 0; u.lt = 0; return true; }
    __device__ __forceinline__ const char* aptr(const Unit& u) const { return (const char*)A + (size_t)u.pm * BM * D * 2; }
    __device__ __forceinline__ const char* bptr(const Unit& u) const { return (const char*)Bt + (size_t)u.pn * BM * D * 2; }
    __device__ __forceinline__ void rows(const Unit&, const int (&)[2], const int (&)[2], unsigned (&)[2][2]) const {}
};
struct MoeSched {
    const bf16* A; const bf16* Bt; const int* rowtok; int K, N, nN, G, c; const LAS int* cnt; const LAS int* tst; const LAS unsigned char* te;
    __device__ __forceinline__ bool next(int i, Unit& u) const { const int nM = tst[NE]; const int L = i * G + c; if (L >= nM * nN) return false;
        map_tile(L, nM * nN, nM, nN, u.pm, u.pn); u.e = te[u.pm]; u.lt = u.pm - tst[u.e]; return true; }
    __device__ __forceinline__ const char* aptr(const Unit& u) const { return (const char*)A + (size_t)u.pm * BM * K * 2; }
    __device__ __forceinline__ const char* bptr(const Unit& u) const { return (const char*)Bt + ((size_t)u.e * N + (size_t)u.pn * BM) * K * 2; }
    __device__ __forceinline__ void rows(const Unit& u, const int (&sR)[2], const int (&sC2)[2], unsigned (&g)[2][2]) const {
        const int n = cnt[u.e]; const int* rt = rowtok + (size_t)u.e * ECAP;
#pragma unroll
        for (int h = 0; h < 2; ++h)
#pragma unroll
            for (int i = 0; i < 2; ++i) { const int j = u.lt * BM + h * HALF + sR[i]; const int tok = (j < n) ? rt[j] : 0; g[h][i] = (unsigned)tok * (unsigned)(K * 2) + (unsigned)sC2[i]; }
        asm volatile("s_waitcnt vmcnt(0)" ::: "memory");
    }
};

template <class Epi, class Sched, bool GATHER, bool F8 = false>
__device__ __forceinline__ void gemm_phase(LAS unsigned char* lds, const int K, const Sched& S, const Epi& E, const char* gatherA) {
    const int tid = threadIdx.x, wid = __builtin_amdgcn_readfirstlane(tid >> 6), lane = tid & 63, wr = wid >> 2, wc = wid & 3, fr = lane & 15, fq = lane >> 4;
    const int nt = K / BK;
    unsigned voffA[2], voffB[2]; int sR[2], sC2[2];
#pragma unroll
    for (int i = 0; i < 2; ++i) { int R, C; stage_rc(tid * 16 + i * 8192, R, C); const int Rb = Epi::PERM ? ((R & ~31) + perm32(R & 31)) : R;
        voffA[i] = (unsigned)(R * K + C) * 2u; voffB[i] = (unsigned)(Rb * K + C) * 2u; sR[i] = R; sC2[i] = C * 2; }
    const size_t kstep = (size_t)(BK * 2);
    const size_t hstep = (size_t)HALF * K * 2;
    const unsigned ldsw = (unsigned)wid * 1024u;
    const int aoff = lds_byte(wr * 64 + fr, fq * 8), boff = lds_byte(wc * 32 + fr, fq * 8);
#define PG8_SA(b, h) (((b) * 2 + (h)) * HTB)
#define PG8_SB(b, h) ((4 + (b) * 2 + (h)) * HTB)
#define PG8_STAGE(bufoff, gbase, voff) do { _Pragma("unroll") for (int _i = 0; _i < 2; ++_i) \
        __builtin_amdgcn_global_load_lds((const unsigned*)((const char*)(gbase) + (voff)[_i]), (LAS unsigned*)(lds + (bufoff) + ldsw + _i * 8192), 16, 0, 0); } while (0)
#define PG8_STG_A(bufoff, gbase, h, OFF) do { if constexpr (GATHER) { PG8_STAGE(bufoff, gbase, OFF); } else { PG8_STAGE(bufoff, (gbase) + (h) * hstep, voffA); } } while (0)
#define PG8_CAT(p0, p1) __builtin_shufflevector(*(const LAS v4i*)(p0), *(const LAS v4i*)(p1), 0, 1, 2, 3, 4, 5, 6, 7)
#define PG8_LDA(dst, b, h) do { _Pragma("unroll") for (int m = 0; m < 4; ++m) { if constexpr (F8) dst##8[m] = PG8_CAT(lds + PG8_SA(b, h) + aoff + m * 2048, lds + PG8_SA(b, h) + aoff + m * 2048 + 1024); \
        else { _Pragma("unroll") for (int k = 0; k < 2; ++k) dst[m][k] = *(const LAS bf16x8*)(lds + PG8_SA(b, h) + aoff + m * 2048 + k * 1024); } } } while (0)
#define PG8_LDB(dst, b, h) do { _Pragma("unroll") for (int n = 0; n < 2; ++n) { if constexpr (F8) dst##8[n] = PG8_CAT(lds + PG8_SB(b, h) + boff + n * 2048, lds + PG8_SB(b, h) + boff + n * 2048 + 1024); \
        else { _Pragma("unroll") for (int k = 0; k < 2; ++k) dst[n][k] = *(const LAS bf16x8*)(lds + PG8_SB(b, h) + boff + n * 2048 + k * 1024); } } } while (0)
#define PG8_MMA(ai, bj, At, Bt) do { __builtin_amdgcn_s_setprio(1); _Pragma("unroll") for (int m = 0; m < 4; ++m) _Pragma("unroll") for (int n = 0; n < 2; ++n) { \
        if constexpr (F8) asm volatile("v_mfma_scale_f32_16x16x128_f8f6f4 %0, %1, %2, %0, %3, %4 op_sel_hi:[0,0,0]" : "+v"(acc[ai][bj][m][n]) : "v"(Bt##8[n]), "v"(At##8[m]), "v"(scw8), "v"(sca8)); \
        else { _Pragma("unroll") for (int k = 0; k < 2; ++k) acc[ai][bj][m][n] = __builtin_amdgcn_mfma_f32_16x16x32_bf16(Bt[n][k], At[m][k], acc[ai][bj][m][n], 0, 0, 0); } } __builtin_amdgcn_s_setprio(0); } while (0)
#define PG8_WAIT_V(n) asm volatile("s_waitcnt vmcnt(" #n ")" ::: "memory")
#define PG8_WAIT_L(n) asm volatile("s_waitcnt lgkmcnt(" #n ")" ::: "memory")
#define PG8_BAR __builtin_amdgcn_s_barrier()
#define PG8_SCHED __builtin_amdgcn_sched_barrier(0)
    Unit cur, nxt; int ui = 0;
    if (!S.next(0, cur)) return;
    f32x4 acc[2][2][4][2];
#pragma unroll
    for (int a = 0; a < 2; ++a)
#pragma unroll
        for (int b = 0; b < 2; ++b)
#pragma unroll
            for (int m = 0; m < 4; ++m)
#pragma unroll
                for (int n = 0; n < 2; ++n) acc[a][b][m][n] = (f32x4){0.f, 0.f, 0.f, 0.f};
    bf16x8 At[4][2], B0[2][2], B1[2][2]; v8i At8[4], B08[2], B18[2]; const int scw8 = SC_W8, sca8 = SC_ONE;
    const char* cA = GATHER ? gatherA : S.aptr(cur); const char* cB = S.bptr(cur);
    unsigned gA[2][2] = {{0u, 0u}, {0u, 0u}}, gA1[2] = {0u, 0u};
    if constexpr (GATHER) S.rows(cur, sR, sC2, gA);
    PG8_STAGE(PG8_SB(0, 0), cB, voffB); PG8_STAGE(PG8_SB(0, 1), cB + hstep, voffB); PG8_STG_A(PG8_SA(0, 0), cA, 0, gA[0]); PG8_STG_A(PG8_SA(0, 1), cA, 1, gA[1]);
    if (wr == 1) PG8_BAR;
    PG8_WAIT_V(2); PG8_BAR;
    PG8_STAGE(PG8_SB(1, 0), cB + kstep, voffB); PG8_STG_A(PG8_SA(1, 0), cA + kstep, 0, gA[0]); PG8_STAGE(PG8_SB(1, 1), cB + hstep + kstep, voffB);
    PG8_WAIT_V(6); PG8_BAR;
    for (;;) {
        const bool has_next = S.next(ui + 1, nxt);
        const char* nA = GATHER ? gatherA : (has_next ? S.aptr(nxt) : cA); const char* nB = has_next ? S.bptr(nxt) : cB;
        for (int t = 0; t < nt; t += 2) {
            const bool last = (t == nt - 2);
            const char* a1 = cA + (size_t)(t + 1) * kstep;
            const char* a2 = last ? nA : cA + (size_t)(t + 2) * kstep; const char* b2 = last ? nB : cB + (size_t)(t + 2) * kstep;
            const char* a3 = a2 + kstep; const char* b3 = b2 + kstep;
            if constexpr (GATHER) { gA1[0] = gA[1][0]; gA1[1] = gA[1][1]; if (last && has_next) S.rows(nxt, sR, sC2, gA); }
            PG8_LDB(B0, 0, 0); PG8_LDB(B1, 0, 1); PG8_SCHED; PG8_LDA(At, 0, 0); PG8_STG_A(PG8_SA(1, 1), a1, 1, gA1);
            PG8_WAIT_V(8); PG8_WAIT_L(0); PG8_BAR; PG8_MMA(0, 0, At, B0); PG8_MMA(0, 1, At, B1); PG8_BAR; PG8_SCHED;
            PG8_LDA(At, 0, 1); PG8_STAGE(PG8_SB(0, 0), b2, voffB); PG8_STAGE(PG8_SB(0, 1), b2 + hstep, voffB); PG8_STG_A(PG8_SA(0, 0), a2, 0, gA[0]);
            PG8_WAIT_V(8); PG8_WAIT_L(0); PG8_BAR; PG8_MMA(1, 0, At, B0); PG8_MMA(1, 1, At, B1); PG8_BAR; PG8_SCHED;
            PG8_LDB(B0, 1, 0); PG8_LDB(B1, 1, 1); PG8_SCHED; PG8_LDA(At, 1, 0); PG8_STG_A(PG8_SA(0, 1), a2, 1, gA[1]);
            PG8_WAIT_V(8); PG8_WAIT_L(0); PG8_BAR; PG8_MMA(0, 0, At, B0); PG8_MMA(0, 1, At, B1); PG8_BAR; PG8_SCHED;
            PG8_LDA(At, 1, 1); PG8_STAGE(PG8_SB(1, 0), b3, voffB); PG8_STAGE(PG8_SB(1, 1), b3 + hstep, voffB); PG8_STG_A(PG8_SA(1, 0), a3, 0, gA[0]);
            PG8_WAIT_V(8); PG8_WAIT_L(0); PG8_BAR; PG8_MMA(1, 0, At, B0); PG8_MMA(1, 1, At, B1); PG8_BAR; PG8_SCHED;
        }
        if (wr == 0) PG8_BAR;
        if constexpr (F8) asm volatile("s_nop 7\n\ts_nop 7\n\ts_nop 7" ::: "memory");
        E(acc, cur, wr, wc, fr, fq);
        if (!has_next) break;
#pragma unroll
        for (int a = 0; a < 2; ++a)
#pragma unroll
            for (int b = 0; b < 2; ++b)
#pragma unroll
                for (int m = 0; m < 4; ++m)
#pragma unroll
                    for (int n = 0; n < 2; ++n) acc[a][b][m][n] = (f32x4){0.f, 0.f, 0.f, 0.f};
        cur = nxt; cA = nA; cB = nB; ++ui;
        if (wr == 1) PG8_BAR;
    }
    PG8_WAIT_V(0);
    PG8_BAR;
#undef PG8_SA
#undef PG8_SB
#undef PG8_STAGE
#undef PG8_STG_A
#undef PG8_LDA
#undef PG8_CAT
#undef PG8_LDB
#undef PG8_MMA
#undef PG8_WAIT_V
#undef PG8_WAIT_L
#undef PG8_BAR
#undef PG8_SCHED
}

typedef const f32x4 (&AccT)[2][2][4][2];
__device__ __forceinline__ u32x4 pack8(f32x4 v0, f32x4 v1) { u32x4 w; w.x = cvt_pk_bf16(v0[0], v0[1]); w.y = cvt_pk_bf16(v0[2], v0[3]); w.z = cvt_pk_bf16(v1[0], v1[1]); w.w = cvt_pk_bf16(v1[2], v1[3]); return w; }
__device__ __forceinline__ void unpack8(u32x4 w, f32x4& v0, f32x4& v1) { v0 = (f32x4){bflo(w.x), bfhi(w.x), bflo(w.y), bfhi(w.y)}; v1 = (f32x4){bflo(w.z), bfhi(w.z), bflo(w.w), bfhi(w.w)}; }
__device__ __forceinline__ f32x4 sig4(f32x4 v) { return (f32x4){sigm(v[0]), sigm(v[1]), sigm(v[2]), sigm(v[3])}; }

struct EpiBf16Plain {
    static constexpr bool PERM = true;
    bf16* O; int ldc; const float* bias;
    __device__ __forceinline__ void operator()(AccT acc, const Unit& u, int wr, int wc, int fr, int fq) const {
        const int row0 = u.pm * BM + wr * 64 + fr, col0 = u.pn * BM + wc * 32 + 8 * fq;
        f32x4 bv[2][2];
#pragma unroll
        for (int bj = 0; bj < 2; ++bj)
#pragma unroll
            for (int n = 0; n < 2; ++n) bv[bj][n] = bias ? *(const f32x4*)(bias + col0 + bj * HALF + 4 * n) : (f32x4){0.f, 0.f, 0.f, 0.f};
#pragma unroll
        for (int ai = 0; ai < 2; ++ai)
#pragma unroll
            for (int m = 0; m < 4; ++m) { bf16* rowp = O + (size_t)(row0 + ai * HALF + m * 16) * ldc + col0;
#pragma unroll
                for (int bj = 0; bj < 2; ++bj) *(u32x4*)(rowp + bj * HALF) = pack8(acc[ai][bj][m][0] + bv[bj][0], acc[ai][bj][m][1] + bv[bj][1]); }
    }
};
struct EpiInProj {
    static constexpr bool PERM = true;
    bf16* ZL; bf16* ZC; const float* bias;
    __device__ __forceinline__ void operator()(AccT acc, const Unit& u, int wr, int wc, int fr, int fq) const {
        const int row0 = u.pm * BM + wr * 64 + fr, col0 = u.pn * BM + wc * 32 + 8 * fq;
        f32x4 bv[2][2];
#pragma unroll
        for (int bj = 0; bj < 2; ++bj)
#pragma unroll
            for (int n = 0; n < 2; ++n) bv[bj][n] = *(const f32x4*)(bias + col0 + bj * HALF + 4 * n);
        const bool lat = u.pm < 64;
#pragma unroll
        for (int ai = 0; ai < 2; ++ai)
#pragma unroll
            for (int m = 0; m < 4; ++m) { const int r = row0 + ai * HALF + m * 16;
                bf16* rowp = lat ? ZL + (size_t)r * ZN + col0 : ZC + (size_t)(r - TL) * ZCN + (col0 - ZR0);
#pragma unroll
                for (int bj = 0; bj < 2; ++bj) *(u32x4*)(rowp + bj * HALF) = pack8(acc[ai][bj][m][0] + bv[bj][0], acc[ai][bj][m][1] + bv[bj][1]); }
    }
};
struct EpiConvO {
    static constexpr bool PERM = true;
    bf16* MIX; const bf16* ZL; const float* bias;
    __device__ __forceinline__ void operator()(AccT acc, const Unit& u, int wr, int wc, int fr, int fq) const {
        const int row0 = u.pm * BM + wr * 64 + fr, col0 = u.pn * BM + wc * 32 + 8 * fq;
        f32x4 bv[2][2];
#pragma unroll
        for (int bj = 0; bj < 2; ++bj)
#pragma unroll
            for (int n = 0; n < 2; ++n) bv[bj][n] = *(const f32x4*)(bias + col0 + bj * HALF + 4 * n);
#pragma unroll
        for (int ai = 0; ai < 2; ++ai)
#pragma unroll
            for (int m = 0; m < 4; ++m) { const size_t r = (size_t)(row0 + ai * HALF + m * 16);
#pragma unroll
                for (int bj = 0; bj < 2; ++bj) { const int c = col0 + bj * HALF; f32x4 g0, g1; unpack8(*(const u32x4*)(ZL + r * ZN + ZG0 + c), g0, g1);
                    *(u32x4*)(MIX + r * D + c) = pack8(sig4(g0) * (acc[ai][bj][m][0] + bv[bj][0]), sig4(g1) * (acc[ai][bj][m][1] + bv[bj][1])); } }
    }
};
struct EpiRwkvO {
    static constexpr bool PERM = true;
    bf16* MIX; const bf16* ZL;
    __device__ __forceinline__ void operator()(AccT acc, const Unit& u, int wr, int wc, int fr, int fq) const {
        const int row0 = u.pm * BM + wr * 64 + fr, col0 = u.pn * BM + wc * 32 + 8 * fq;
#pragma unroll
        for (int ai = 0; ai < 2; ++ai)
#pragma unroll
            for (int m = 0; m < 4; ++m) { const size_t r = (size_t)(row0 + ai * HALF + m * 16);
#pragma unroll
                for (int bj = 0; bj < 2; ++bj) { const int c = col0 + bj * HALF; f32x4 g0, g1, m0, m1; unpack8(*(const u32x4*)(ZL + r * ZN + ZG0 + D + c), g0, g1); unpack8(*(const u32x4*)(MIX + r * D + c), m0, m1);
                    *(u32x4*)(MIX + r * D + c) = pack8(m0 + sig4(g0) * acc[ai][bj][m][0], m1 + sig4(g1) * acc[ai][bj][m][1]); } }
    }
};
struct EpiOut {
    static constexpr bool PERM = false;
    float* T1; const float* x; const float* mod; const float* bias;
    __device__ __forceinline__ void operator()(AccT acc, const Unit& u, int wr, int wc, int fr, int fq) const {
        const int row0 = u.pm * BM + wr * 64 + fr, col0 = u.pn * BM + wc * 32 + 4 * fq;
        const float* gate = mod + (size_t)(u.pm / 8) * (6 * D) + 2 * D;
        f32x4 bv[2][2], gv[2][2];
#pragma unroll
        for (int bj = 0; bj < 2; ++bj)
#pragma unroll
            for (int n = 0; n < 2; ++n) { bv[bj][n] = *(const f32x4*)(bias + col0 + bj * HALF + n * 16); gv[bj][n] = *(const f32x4*)(gate + col0 + bj * HALF + n * 16); }
#pragma unroll
        for (int ai = 0; ai < 2; ++ai)
#pragma unroll
            for (int m = 0; m < 4; ++m) { const size_t off = (size_t)(row0 + ai * HALF + m * 16) * D + col0;
#pragma unroll
                for (int bj = 0; bj < 2; ++bj)
#pragma unroll
                    for (int n = 0; n < 2; ++n) { const f32x4 xv = *(const f32x4*)(x + off + bj * HALF + n * 16);
                        *(f32x4*)(T1 + off + bj * HALF + n * 16) = xv * DN_ALPHA + gv[bj][n] * (acc[ai][bj][m][n] + bv[bj][n]); } }
    }
};
struct EpiGateUp {
    static constexpr bool PERM = true;
    unsigned char* HID; const float* bias;
    __device__ __forceinline__ void operator()(AccT acc, const Unit& u, int wr, int wc, int fr, int fq) const {
        const int row0 = u.pm * BM + wr * 64 + fr, cb = u.pn * BM + wc * 32 + 8 * fq, co = u.pn * HALF + wc * 32 + 8 * fq;
        const float* bp = bias + (size_t)u.e * 4096 + cb;
        f32x4 bv[2][2];
#pragma unroll
        for (int bj = 0; bj < 2; ++bj)
#pragma unroll
            for (int n = 0; n < 2; ++n) bv[bj][n] = *(const f32x4*)(bp + bj * HALF + 4 * n);
#pragma unroll
        for (int ai = 0; ai < 2; ++ai)
#pragma unroll
            for (int m = 0; m < 4; ++m) { f32x4 h[2];
#pragma unroll
                for (int n = 0; n < 2; ++n) { const f32x4 g = acc[ai][0][m][n] + bv[0][n], up = acc[ai][1][m][n] + bv[1][n];
#pragma unroll
                    for (int j = 0; j < 4; ++j) { const float gg = fminf(g[j], SW_LIMIT), uu = fminf(fmaxf(up[j], -SW_LIMIT), SW_LIMIT); h[n][j] = (uu + 1.0f) * (gg * sigm(SW_ALPHA * gg)); } }
                u32x2 o; o.x = pk_fp8x4(h[0][0], h[0][1], h[0][2], h[0][3]); o.y = pk_fp8x4(h[1][0], h[1][1], h[1][2], h[1][3]);
                *(u32x2*)(HID + (size_t)(row0 + ai * HALF + m * 16) * D + co) = o; }
    }
};
struct EpiDown {
    static constexpr bool PERM = true;
    bf16* DOWN; const float* bias; const float* roww; const LAS int* cnt;
    __device__ __forceinline__ void operator()(AccT acc, const Unit& u, int wr, int wc, int fr, int fq) const {
        const int rl0 = wr * 64 + fr, col0 = u.pn * BM + wc * 32 + 8 * fq; const int n_e = cnt[u.e];
        const float* bp = bias + (size_t)u.e * D + col0; const float* rw = roww + (size_t)u.e * ECAP + u.lt * BM;
        f32x4 bv[2][2];
#pragma unroll
        for (int bj = 0; bj < 2; ++bj)
#pragma unroll
            for (int n = 0; n < 2; ++n) bv[bj][n] = *(const f32x4*)(bp + bj * HALF + 4 * n);
#pragma unroll
        for (int ai = 0; ai < 2; ++ai)
#pragma unroll
            for (int m = 0; m < 4; ++m) { const int rl = rl0 + ai * HALF + m * 16; const float gw = (u.lt * BM + rl < n_e) ? rw[rl] : 0.f;
                bf16* rowp = DOWN + (size_t)(u.pm * BM + rl) * D + col0;
#pragma unroll
                for (int bj = 0; bj < 2; ++bj) *(u32x4*)(rowp + bj * HALF) = pack8((acc[ai][bj][m][0] + bv[bj][0]) * gw, (acc[ai][bj][m][1] + bv[bj][1]) * gw); }
    }
};
}
__device__ __forceinline__ void unpack8(u32x4 w, f32x4& a, f32x4& b) { pg8::unpack8(w, a, b); }

struct Params { const float* in[38]; float* out; unsigned char* ws; int ph_lo, ph_hi; };
enum { I_X = 0, I_C, I_CTX, I_CCTX, I_WADA, I_BADA, I_WIN, I_BIN, I_SMU, I_CONVW, I_CONVB, I_CLNG, I_CLNB, I_WCO, I_BCO, I_W0, I_W2, I_A0, I_A2, I_G2,
       I_KK, I_KA, I_RK, I_LNXG, I_LNXB, I_WRO, I_WOUT, I_BOUT, I_LN1G, I_LN1B, I_WROUTER, I_BROUTER, I_WGU, I_BGU, I_WDN, I_BDN, I_LN2G, I_LN2B };

struct Ctx { LAS unsigned char* lds; int tid, lane, wave, G, bid, gw, NGW; };

__device__ __forceinline__ void cvt_item(const float* W, int N, int K, int k0, int n0, bf16* WT, int drow0, int lane) {
    const int ko = lane & 7, ng = lane >> 3;
    const float* src = W + (size_t)(k0 + 8 * ko) * N + n0 + 4 * ng;
    f32x4 v[8];
#pragma unroll
    for (int j = 0; j < 8; ++j) v[j] = *(const f32x4*)(src + (size_t)j * N);
#pragma unroll
    for (int jn = 0; jn < 4; ++jn) { u32x4 o; o.x = cvt_pk_bf16(v[0][jn], v[1][jn]); o.y = cvt_pk_bf16(v[2][jn], v[3][jn]); o.z = cvt_pk_bf16(v[4][jn], v[5][jn]); o.w = cvt_pk_bf16(v[6][jn], v[7][jn]);
        *(u32x4*)(WT + (size_t)(drow0 + 4 * ng + jn) * K + k0 + 8 * ko) = o; }
}
__device__ __forceinline__ void p0_convert(const Params& p, const Ctx& c) {
    unsigned char* ws = p.ws;
    constexpr int I_IN = 32 * 301, I_CO = 16 * 64, I_RO = 16 * 64, I_OUT = 32 * 64;
    constexpr int NITEMS = I_IN + I_CO + I_RO + I_OUT;
    for (int it = c.gw; it < NITEMS; it += c.NGW) {
        int r = it;
        if (r < I_IN) { const int kb = r / 301, nb = r % 301, n0 = 32 * nb; cvt_item(p.in[I_WIN], PIN, D, 64 * kb, n0, (bf16*)(ws + WS_WIN), n0 < 5536 ? n0 : n0 + 96, c.lane); continue; } r -= I_IN;
        if (r < I_CO) { const int kb = r / 64, nb = r % 64; cvt_item(p.in[I_WCO], D, DCV, 64 * kb, 32 * nb, (bf16*)(ws + WS_WCO), 32 * nb, c.lane); continue; } r -= I_CO;
        if (r < I_RO) { const int kb = r / 64, nb = r % 64; cvt_item(p.in[I_WRO], D, DR, 64 * kb, 32 * nb, (bf16*)(ws + WS_WRO), 32 * nb, c.lane); continue; } r -= I_RO;
        { const int kb = r / 64, nb = r % 64; cvt_item(p.in[I_WOUT], D, D, 64 * kb, 32 * nb, (bf16*)(ws + WS_WOUT), 32 * nb, c.lane); }
    }
}
__device__ __forceinline__ void moe_cvt_item(const float* W, int N, int k0, int n0, unsigned char* WT, int drow0, int lane) {
    const int ko = lane & 7, ng = lane >> 3;
    const float* src = W + (size_t)(k0 + 16 * ko) * N + n0 + 4 * ng;
    f32x4 v[16];
#pragma unroll
    for (int j = 0; j < 16; ++j) v[j] = __builtin_nontemporal_load((const f32x4*)(src + (size_t)j * N)) * W8_SCALE;
#pragma unroll
    for (int jn = 0; jn < 4; ++jn) { u32x4 o; o.x = pk_fp8x4(v[0][jn], v[1][jn], v[2][jn], v[3][jn]); o.y = pk_fp8x4(v[4][jn], v[5][jn], v[6][jn], v[7][jn]);
        o.z = pk_fp8x4(v[8][jn], v[9][jn], v[10][jn], v[11][jn]); o.w = pk_fp8x4(v[12][jn], v[13][jn], v[14][jn], v[15][jn]);
        *(u32x4*)(WT + (size_t)(drow0 + 4 * ng + jn) * D + k0 + 16 * ko) = o; }
}
__device__ __forceinline__ void moe_convert(const Params& p, int wi, int nw, int lane) {
    unsigned char* ws = p.ws;
    constexpr int I_GU1 = 16 * 128, I_GU = NE * I_GU1, I_DN1 = 16 * 64, I_DN = NE * I_DN1;
    for (int it = wi; it < I_GU + I_DN; it += nw) {
        if (it < I_GU) { const int e = it / I_GU1, q = it % I_GU1, kb = q / 128, nb = q % 128, n0 = 32 * nb; const int nn = n0 & 2047;
            const int drow = (nn >> 7) * 256 + (n0 >= 2048 ? 128 : 0) + (nn & 127);
            moe_cvt_item(p.in[I_WGU] + (size_t)e * D * 4096, 4096, 128 * kb, n0, ws + WS_WGU + (size_t)e * 4096 * D, drow, lane); }
        else { const int r = it - I_GU; const int e = r / I_DN1, q = r % I_DN1, kb = q / 64, nb = q % 64;
            moe_cvt_item(p.in[I_WDN] + (size_t)e * D * D, D, 128 * kb, 32 * nb, ws + WS_WDN + (size_t)e * D * D, 32 * nb, lane); }
    }
}
__device__ __forceinline__ void p0_small(const Params& p, const Ctx& c) {
    unsigned char* ws = p.ws;
    const int gt = c.bid * 512 + c.tid, NT = c.G * 512;
    bf16* WL = (bf16*)(ws + WS_WLORA);
    for (int t = gt; t < LORA_N * (LORA_K / 8); t += NT) {
        const int n = t / (LORA_K / 8), k0 = (t % (LORA_K / 8)) * 8, g = n >> 10, ch = n & 1023; float v[8];
#pragma unroll
        for (int j = 0; j < 8; ++j) { const int k = k0 + j; float x = 0.f;
            if (g < 4) { if (k >= 64 * g && k < 64 * g + 64) { const float* src = (g < 2) ? p.in[I_W2] : p.in[I_A2]; x = src[((size_t)(g & 1) * 64 + (k - 64 * g)) * DR + ch]; } }
            else { if (k >= 256 && k < 416) x = p.in[I_G2][(size_t)(k - 256) * DR + ch]; }
            v[j] = x; }
        u32x4 o; o.x = cvt_pk_bf16(v[0], v[1]); o.y = cvt_pk_bf16(v[2], v[3]); o.z = cvt_pk_bf16(v[4], v[5]); o.w = cvt_pk_bf16(v[6], v[7]);
        *(u32x4*)(WL + (size_t)n * LORA_K + k0) = o;
    }
    bf16* WRt = (bf16*)(ws + WS_WR);
    for (int t = gt; t < NE * D; t += NT) { const int e = t / D, k = t % D; const float w = p.in[I_WROUTER][(size_t)k * NE + e]; const unsigned hi = f2bf(w); const float lo = w - bflo(hi);
        WRt[t] = (bf16)hi; WRt[NE * D + t] = (bf16)f2bf(lo); }
    float* bin = (float*)(ws + WS_BIN);
    for (int t = gt; t < ZN; t += NT) bin[t] = t < 5536 ? p.in[I_BIN][t] : (t < ZG0 ? 0.f : p.in[I_BIN][t - 96]);
    float* bgu = (float*)(ws + WS_BGU);
    for (int t = gt; t < NE * 4096; t += NT) { const int e = t >> 12, q = t & 4095, pn = q >> 8, rr = q & 255; bgu[t] = p.in[I_BGU][(size_t)e * 4096 + (rr < 128 ? 128 * pn + rr : 2048 + 128 * pn + rr - 128)]; }
    bf16* WI = (bf16*)(ws + WS_WIN);
    for (int t = gt; t < 96 * D / 8; t += NT) *(u32x4*)(WI + (size_t)5536 * D + (size_t)t * 8) = (u32x4){0u, 0u, 0u, 0u};
}
__device__ __forceinline__ void p0_adaln(const Params& p, const Ctx& c) {
    LAS float* act = (LAS float*)c.lds; LAS float* red = (LAS float*)(c.lds + 73728);
    for (int i = c.tid; i < 9 * D; i += 512) { const int r = i / D, k = i % D; const float v = r < 8 ? p.in[I_C][r * D + k] : p.in[I_CCTX][k]; act[i] = v * sigm(v); }
    __syncthreads();
    const int cg = c.tid & 15, ks = c.tid >> 4;
    float* mod = (float*)(p.ws + WS_MOD);
    for (int u = c.bid; u < 192; u += c.G) {
        f32x4 acc[9];
#pragma unroll
        for (int r = 0; r < 9; ++r) acc[r] = (f32x4){0.f, 0.f, 0.f, 0.f};
        const float* wp = p.in[I_WADA] + 64 * u + 4 * cg;
#pragma unroll 4
        for (int k = ks; k < D; k += 32) { const f32x4 w = *(const f32x4*)(wp + (size_t)k * (6 * D));
#pragma unroll
            for (int r = 0; r < 9; ++r) acc[r] += w * act[r * D + k]; }
#pragma unroll
        for (int r = 0; r < 9; ++r)
#pragma unroll
            for (int j = 0; j < 4; ++j) { float v = acc[r][j]; v += __shfl_xor(v, 16); v += __shfl_xor(v, 32); acc[r][j] = v; }
        if (c.lane < 16) {
#pragma unroll
            for (int r = 0; r < 9; ++r) *(LAS f32x4*)(red + (c.wave * 9 + r) * 64 + 4 * cg) = acc[r]; }
        __syncthreads();
        for (int i = c.tid; i < 9 * 64; i += 512) { const int r = i / 64, col = i % 64; float s = 0.f;
#pragma unroll
            for (int w = 0; w < 8; ++w) s += red[(w * 9 + r) * 64 + col];
            mod[r * (6 * D) + 64 * u + col] = s + p.in[I_BADA][64 * u + col]; }
        __syncthreads();
    }
}

__device__ __forceinline__ void p1_modulate(const Params& p, const Ctx& c) {
    const float* mod = (const float*)(p.ws + WS_MOD); bf16* U = (bf16*)(p.ws + WS_U);
    for (int row = c.gw; row < TT; row += c.NGW) {
        const float* src = row < TL ? p.in[I_X] + (size_t)row * D : p.in[I_CTX] + (size_t)(row - TL) * D;
        const int b = row < TL ? row / SEQ : 8;
        const float* sh = mod + (size_t)b * (6 * D); const float* sc = sh + D;
        f32x4 v[8]; float s = 0.f;
#pragma unroll
        for (int j = 0; j < 8; ++j) { v[j] = *(const f32x4*)(src + 4 * c.lane + 256 * j); s += (v[j][0] + v[j][1]) + (v[j][2] + v[j][3]); }
        const float mean = wave_sum(s) * (1.f / D); float s2 = 0.f;
#pragma unroll
        for (int j = 0; j < 8; ++j) { v[j] = v[j] - mean; s2 += (v[j][0] * v[j][0] + v[j][1] * v[j][1]) + (v[j][2] * v[j][2] + v[j][3] * v[j][3]); }
        const float rstd = __builtin_amdgcn_rsqf(wave_sum(s2) * (1.f / D) + LN_EPS);
#pragma unroll
        for (int j = 0; j < 8; ++j) { const int col = 4 * c.lane + 256 * j; const f32x4 a = *(const f32x4*)(sc + col), bb = *(const f32x4*)(sh + col);
            const f32x4 o = v[j] * rstd * (a + 1.0f) + bb; u32x2 w; w.x = cvt_pk_bf16(o[0], o[1]); w.y = cvt_pk_bf16(o[2], o[3]);
            *(u32x2*)(U + (size_t)row * D + col) = w; }
    }
}

__device__ __forceinline__ void p3_conv(const Params& p, const Ctx& c) {
    const bf16* ZL = (const bf16*)(p.ws + WS_ZL); bf16* AC = (bf16*)(p.ws + WS_ACONV);
    LAS unsigned* tile = (LAS unsigned*)c.lds;
    for (int gr = c.bid; gr < TL / 64; gr += c.G) {
        const int row0 = gr * 64, c0 = 2 * c.tid;
#pragma unroll 4
        for (int i = 0; i < 16; ++i) { const int ch = c.tid + 512 * i, t = ch >> 7, cg = ch & 127;
            f32x4 a0, a1, g0, g1; unpack8(*(const u32x4*)(ZL + (size_t)(row0 + t) * ZN + 8 * cg), a0, a1); unpack8(*(const u32x4*)(ZL + (size_t)(row0 + t) * ZN + DCV + 8 * cg), g0, g1);
            *(LAS u32x4*)(tile + t * 512 + 4 * cg) = pg8::pack8(a0 * pg8::sig4(g0), a1 * pg8::sig4(g1)); }
        __syncthreads();
#pragma unroll 1
        for (int cc = 0; cc < 2; ++cc) {
            float w[CWID];
#pragma unroll
            for (int j = 0; j < CWID; ++j) w[j] = p.in[I_CONVW][j * DCV + c0 + cc];
            const float cb = p.in[I_CONVB][c0 + cc];
            float h[64];
#pragma unroll
            for (int t = 0; t < 64; ++t) { const unsigned a = tile[t * 512 + c.tid]; h[t] = cc ? bfhi(a) : bflo(a); }
#pragma clang loop unroll(full)
            for (int t = 0; t < 64; ++t) { float a = cb;
#pragma clang loop unroll(full)
                for (int j = 0; j < CWID; ++j) { const int tt = t + j - CWID / 2; if (tt >= 0 && tt < 64) a += w[j] * h[tt]; }
                ((LAS bf16*)tile)[t * DCV + c0 + cc] = (bf16)f2bf(a); }
        }
        __syncthreads();
        f32x4 g[4], bb[4];
#pragma unroll
        for (int q = 0; q < 4; ++q) { g[q] = *(const f32x4*)(p.in[I_CLNG] + 16 * c.lane + 4 * q); bb[q] = *(const f32x4*)(p.in[I_CLNB] + 16 * c.lane + 4 * q); }
#pragma unroll 2
        for (int i = 0; i < 8; ++i) { const int t = c.wave * 8 + i;
            const u32x4 r0 = *(const LAS u32x4*)(tile + t * 512 + 8 * c.lane), r1 = *(const LAS u32x4*)(tile + t * 512 + 8 * c.lane + 4);
            f32x4 v[4]; unpack8(r0, v[0], v[1]); unpack8(r1, v[2], v[3]);
            float s = 0.f;
#pragma unroll
            for (int q = 0; q < 4; ++q) s += (v[q][0] + v[q][1]) + (v[q][2] + v[q][3]);
            const float mean = wave_sum(s) * (1.f / DCV); float s2 = 0.f;
#pragma unroll
            for (int q = 0; q < 4; ++q) { v[q] = v[q] - mean; s2 += (v[q][0] * v[q][0] + v[q][1] * v[q][1]) + (v[q][2] * v[q][2] + v[q][3] * v[q][3]); }
            const float rstd = __builtin_amdgcn_rsqf(wave_sum(s2) * (1.f / DCV) + LN_EPS);
#pragma unroll
            for (int q = 0; q < 4; ++q) { v[q] = v[q] * rstd * g[q] + bb[q];
#pragma unroll
                for (int j = 0; j < 4; ++j) v[q][j] = v[q][j] * sigm(v[q][j]); }
            bf16* o = AC + (size_t)(row0 + t) * DCV + 16 * c.lane;
            *(u32x4*)o = pg8::pack8(v[0], v[1]); *(u32x4*)(o + 8) = pg8::pack8(v[2], v[3]); }
        __syncthreads();
    }
}
__device__ __forceinline__ void p3_alora(const Params& p, const Ctx& c) {
    const bf16* ZL = (const bf16*)(p.ws + WS_ZL); const bf16* ZC = (const bf16*)(p.ws + WS_ZC); bf16* AL = (bf16*)(p.ws + WS_ALORA);
    const float* mu = p.in[I_SMU];
    for (int row = c.gw; row < TT; row += c.NGW) {
        const bool lat = row < TL; const int pitch = lat ? ZN : ZCN; const int len = lat ? SEQ : CTXL; const int t = lat ? row % SEQ : (row - TL) % CTXL;
        const bf16* zp = lat ? ZL + (size_t)row * ZN + ZR0 : ZC + (size_t)(row - TL) * ZCN;
        const bool hp = t > 0, hn = t < len - 1; const int po = hp ? pitch : 0, no = hn ? pitch : 0; const float mp = hp ? 1.f : 0.f, mn = hn ? 1.f : 0.f;
#pragma unroll
        for (int i = 0; i < 8; ++i) { const int j = c.lane + 64 * i; float o = 0.f;
            if (j < 416) { const int col = 3072 + j; const float z = bf1(zp[col]); const float pv = mp * bf1(zp[col - po]), nv = mn * bf1(zp[col + no]);
                const float zs = z + mu[col] * (pv - z) + mu[DSHIFT + col] * (nv - z);
                o = j < 128 ? (1.f - 2.f * __builtin_amdgcn_rcpf(__expf(2.f * zs) + 1.f)) : (j < 256 ? zs : sigm(zs)); }
            AL[(size_t)row * LORA_K + j] = (bf16)f2bf(o); }
    }
}

__device__ __forceinline__ void p5_prep(const Params& p, const Ctx& c) {
    const bf16* ZL = (const bf16*)(p.ws + WS_ZL); const bf16* ZC = (const bf16*)(p.ws + WS_ZC); const bf16* LO = (const bf16*)(p.ws + WS_LORA);
    unsigned char* SC = p.ws + WS_SC2; bf16* VS = (bf16*)(p.ws + WS_VS); float* RK = (float*)(p.ws + WS_RK);
    const float* mu = p.in[I_SMU];
    for (int it = c.gw; it < NB * NH * NCHUNK; it += c.NGW) {
        const int m = it % NCHUNK, bh = it / NCHUNK, h = bh % NH, b = bh / NH, hc = h * HS + c.lane;
        const bool lat = m >= 16; const int pitch = lat ? ZN : ZCN, len = lat ? SEQ : CTXL, t0 = lat ? (m - 16) * 16 : m * 16;
        const size_t rowbase = lat ? (size_t)b * SEQ + t0 : (size_t)b * CTXL + t0;
        const bf16* zp = lat ? ZL + rowbase * ZN + ZR0 : ZC + rowbase * ZCN;
        const size_t lrow = lat ? rowbase : (size_t)TL + rowbase;
        const float mpr = mu[hc], mnr = mu[DSHIFT + hc], mpk = mu[DR + hc], mnk = mu[DSHIFT + DR + hc], mpv = mu[2 * DR + hc], mnv = mu[DSHIFT + 2 * DR + hc];
        const float kk_ = p.in[I_KK][hc], ka_ = p.in[I_KA][hc], rk_ = p.in[I_RK][hc];
        const float w00 = p.in[I_W0][hc], w01 = p.in[I_W0][DR + hc], a00 = p.in[I_A0][hc], a01 = p.in[I_A0][DR + hc];
        float* rec0 = (float*)(SC + ((size_t)(bh * 2 + 0) * NCHUNK + m) * SBUF) + c.lane;
        float* rec1 = (float*)(SC + ((size_t)(bh * 2 + 1) * NCHUNK + (lat ? 159 - m : 15 - m)) * SBUF) + c.lane;
        float zr[18], zk[18], zv[18];
#pragma unroll
        for (int i = 0; i < 18; ++i) { const int t = t0 - 1 + i; const bool ok = t >= 0 && t < len; const int tc = t < 0 ? 0 : (t >= len ? len - 1 : t); const float msk = ok ? 1.f : 0.f;
            const bf16* q = zp + (ptrdiff_t)(tc - t0) * pitch;
            zr[i] = msk * bf1(q[hc]); zk[i] = msk * bf1(q[DR + hc]); zv[i] = msk * bf1(q[2 * DR + hc]); }
        float s_r[16], s_v[16], s_na[16], s_w[16], s_b[16], s_kd[16];
        bf16 lw0[16], lw1[16], la0[16], la1[16];
#pragma unroll
        for (int i = 0; i < 16; ++i) { const bf16* lp = LO + (lrow + i) * LORA_N + hc; lw0[i] = lp[0]; lw1[i] = lp[DR]; la0[i] = lp[2 * DR]; la1[i] = lp[3 * DR]; }
        float gam = 1.f;
#pragma unroll
        for (int i = 0; i < 16; ++i) {
            const float r = zr[i + 1] + mpr * (zr[i] - zr[i + 1]) + mnr * (zr[i + 2] - zr[i + 1]);
            const float k = zk[i + 1] + mpk * (zk[i] - zk[i + 1]) + mnk * (zk[i + 2] - zk[i + 1]);
            const float v = zv[i + 1] + mpv * (zv[i] - zv[i + 1]) + mnv * (zv[i + 2] - zv[i + 1]);
            const float kr = k * kk_; const float nrm = sqrtf(wave_sum(kr * kr)); const float kk = kr / fmaxf(nrm, 1e-12f);
            const float wl0 = bf1(lw0[i]), wl1 = bf1(lw1[i]), al0 = bf1(la0[i]), al1 = bf1(la1[i]);
            const float aa0 = sigm(a00 + al0), aa1 = sigm(a01 + al1);
            const float w0 = __expf(-0.6065306597f * sigm(w00 + wl0)), w1 = __expf(-0.6065306597f * sigm(w01 + wl1));
            const float kd0 = k * (1.f + (aa0 - 1.f) * ka_), kd1 = k * (1.f + (aa1 - 1.f) * ka_);
            s_r[i] = r; s_v[i] = v; s_na[i] = -kk; s_w[i] = w1; s_b[i] = kk * aa1; s_kd[i] = kd1;
            { const float gprev = gam; gam *= w0; const float inv = __builtin_amdgcn_rcpf(gam); float* o = rec0 + i * 320;
              o[0] = gprev * -kk; o[64] = kk * aa0 * inv; o[128] = kd0 * inv; o[192] = gam * r; o[256] = v; }
            if (lat) { const float s = wave_sum(r * (kd0 + kd1) * rk_); if (c.lane == 0) RK[(rowbase + i) * NH + h] = s;
                VS[(rowbase + i) * DR + hc] = (bf16)f2bf(v); }
        }
        rec0[SCH * 320] = gam;
        gam = 1.f;
#pragma unroll
        for (int s = 0; s < 16; ++s) { const int i = 15 - s;
            const float gprev = gam; gam *= s_w[i]; const float inv = __builtin_amdgcn_rcpf(gam); float* o = rec1 + s * 320;
            o[0] = gprev * s_na[i]; o[64] = s_b[i] * inv; o[128] = s_kd[i] * inv; o[192] = gam * s_r[i]; o[256] = s_v[i]; }
        rec1[SCH * 320] = gam;
    }
}

constexpr int SNB = 4, SLOT = SBUF + 768, S_FULL = SNB * SLOT, S_DONE = S_FULL + 64;
__device__ __forceinline__ float dpp_xor1(float x) { return __builtin_bit_cast(float, __builtin_amdgcn_update_dpp(0, __builtin_bit_cast(int, x), 0xB1, 0xf, 0xf, true)); }
__device__ __forceinline__ float dpp_xor2(float x) { return __builtin_bit_cast(float, __builtin_amdgcn_update_dpp(0, __builtin_bit_cast(int, x), 0x4E, 0xf, 0xf, true)); }
__device__ __forceinline__ float dpp_hmir(float x) { return __builtin_bit_cast(float, __builtin_amdgcn_update_dpp(0, __builtin_bit_cast(int, x), 0x141, 0xf, 0xf, true)); }
__device__ __forceinline__ float red8(float x) { x += dpp_xor1(x); x += dpp_xor2(x); x += dpp_hmir(x); return x; }
struct ScanCoef { f32x4 a0, a1, b0, b1, k0, k1, r0, r1; f32x2 vv; };
__device__ __forceinline__ ScanCoef scan_ld(const LAS unsigned char* sb, const LAS unsigned char* vb) {
    ScanCoef o; o.a0 = *(const LAS f32x4*)(sb); o.a1 = *(const LAS f32x4*)(sb + 16); o.b0 = *(const LAS f32x4*)(sb + 256); o.b1 = *(const LAS f32x4*)(sb + 272);
    o.k0 = *(const LAS f32x4*)(sb + 512); o.k1 = *(const LAS f32x4*)(sb + 528); o.r0 = *(const LAS f32x4*)(sb + 768); o.r1 = *(const LAS f32x4*)(sb + 784);
    o.vv = *(const LAS f32x2*)(vb); return o;
}
__device__ __forceinline__ void p6_scan(const Params& p, const Ctx& c) {
    LAS unsigned char* L = c.lds; volatile LAS unsigned* full = (volatile LAS unsigned*)(L + S_FULL); volatile LAS unsigned* done = (volatile LAS unsigned*)(L + S_DONE);
    float* Y = (float*)(p.ws + WS_Y);
    for (int sid = c.bid; sid < NB * NH * 2; sid += c.G) {
        if (c.tid < 8) { full[c.tid] = 0u; done[c.tid] = 0u; }
        __syncthreads();
        const int d = sid & 1, bh = sid >> 1, h = bh % NH, b = bh / NH;
        if (c.wave == 4) {
            const unsigned char* src = p.ws + WS_SC2 + (size_t)sid * NCHUNK * SBUF + 16 * c.lane;
            for (int ch = 0; ch < NCHUNK; ++ch) {
                const int buf = ch & (SNB - 1);
                if (ch >= SNB) { const unsigned want = 4u * (unsigned)(ch / SNB); unsigned sp = 0; while (done[buf] < want) { __builtin_amdgcn_s_sleep(1); if (++sp > (1u << 24)) break; } }
                const unsigned char* g = src + (size_t)ch * SBUF; LAS unsigned char* dl = L + buf * SLOT;
#pragma unroll
                for (int i = 0; i < 20; ++i) __builtin_amdgcn_global_load_lds((const unsigned*)(g + i * 1024), (LAS unsigned*)(dl + i * 1024), 16, 0, 0);
                if (c.lane < 16) __builtin_amdgcn_global_load_lds((const unsigned*)(g + 20480), (LAS unsigned*)(dl + 20480), 16, 0, 0);
                if (ch >= 1) { asm volatile("s_waitcnt vmcnt(21)" ::: "memory"); if (c.lane == 0) full[(ch - 1) & (SNB - 1)] = (unsigned)ch; }
            }
            asm volatile("s_waitcnt vmcnt(0)" ::: "memory"); if (c.lane == 0) full[(NCHUNK - 1) & (SNB - 1)] = (unsigned)NCHUNK;
        } else if (c.wave < 4) {
            const int vp = c.lane >> 3, q = c.lane & 7, v0 = 16 * c.wave + 2 * vp;
            f32x2 S0[4], S1[4];
#pragma unroll
            for (int j = 0; j < 4; ++j) { S0[j] = (f32x2){0.f, 0.f}; S1[j] = (f32x2){0.f, 0.f}; }
            float* yp = Y + ((size_t)d * TL + (size_t)b * SEQ + (d ? SEQ - 1 : 0)) * DR + h * HS + v0; const ptrdiff_t ystep = d ? -(ptrdiff_t)DR : (ptrdiff_t)DR;
            for (int ch = 0; ch < NCHUNK; ++ch) {
                const int buf = ch & (SNB - 1); { unsigned sp = 0; while (full[buf] != (unsigned)(ch + 1)) { __builtin_amdgcn_s_sleep(1); if (++sp > (1u << 24)) break; } }
                const LAS unsigned char* base = L + buf * SLOT; const LAS unsigned char* sb = base + 32 * q; const LAS unsigned char* vb = base + 1024 + 4 * v0;
                const bool lat = ch >= CTXL / SCH;
                ScanCoef cur = scan_ld(sb, vb);
#pragma unroll 2
                for (int s = 0; s < SCH; ++s) {
                    const int sn = (s + 1 < SCH) ? s + 1 : s;
                    const ScanCoef nx = scan_ld(sb + sn * 1280, vb + sn * 1280);
                    const f32x2 A[4] = {cur.a0.xy, cur.a0.zw, cur.a1.xy, cur.a1.zw}, Bc[4] = {cur.b0.xy, cur.b0.zw, cur.b1.xy, cur.b1.zw};
                    const f32x2 Kc[4] = {cur.k0.xy, cur.k0.zw, cur.k1.xy, cur.k1.zw}, Rc[4] = {cur.r0.xy, cur.r0.zw, cur.r1.xy, cur.r1.zw};
                    f32x2 q0 = S0[0] * A[0], q1 = S1[0] * A[0];
#pragma unroll
                    for (int j = 1; j < 4; ++j) { q0 = __builtin_elementwise_fma(S0[j], A[j], q0); q1 = __builtin_elementwise_fma(S1[j], A[j], q1); }
                    const float p0 = red8(q0.x + q0.y), p1 = red8(q1.x + q1.y);
                    const f32x2 pp0 = (f32x2){p0, p0}, pp1 = (f32x2){p1, p1}, vv0 = (f32x2){cur.vv.x, cur.vv.x}, vv1 = (f32x2){cur.vv.y, cur.vv.y};
#pragma unroll
                    for (int j = 0; j < 4; ++j) { S0[j] = __builtin_elementwise_fma(pp0, Bc[j], __builtin_elementwise_fma(vv0, Kc[j], S0[j])); S1[j] = __builtin_elementwise_fma(pp1, Bc[j], __builtin_elementwise_fma(vv1, Kc[j], S1[j])); }
                    if (lat) { f32x2 y0 = S0[0] * Rc[0], y1 = S1[0] * Rc[0];
#pragma unroll
                        for (int j = 1; j < 4; ++j) { y0 = __builtin_elementwise_fma(S0[j], Rc[j], y0); y1 = __builtin_elementwise_fma(S1[j], Rc[j], y1); }
                        const float z0 = red8(y0.x + y0.y), z1 = red8(y1.x + y1.y);
                        if (q == 0) *(f32x2*)yp = (f32x2){z0, z1};
                        yp += ystep; }
                    cur = nx;
                }
                const f32x4 g0 = *(const LAS f32x4*)(base + SCH * 1280 + 32 * q), g1 = *(const LAS f32x4*)(base + SCH * 1280 + 32 * q + 16);
                const f32x2 Gm[4] = {g0.xy, g0.zw, g1.xy, g1.zw};
#pragma unroll
                for (int j = 0; j < 4; ++j) { S0[j] *= Gm[j]; S1[j] *= Gm[j]; }
                asm volatile("s_waitcnt lgkmcnt(0)" ::: "memory");
                if (c.lane == 0) __hip_atomic_fetch_add((LAS unsigned*)(L + S_DONE) + buf, 1u, __ATOMIC_RELAXED, __HIP_MEMORY_SCOPE_WORKGROUP);
            }
        } else if (CONV_IN_SCAN && sid == c.bid) {
            moe_convert(p, c.bid * 3 + (c.wave - 5), c.G * 3, c.lane);
        }
        __syncthreads();
    }
}

__device__ __forceinline__ void p7_rwkvout(const Params& p, const Ctx& c) {
    const float* Y = (const float*)(p.ws + WS_Y); const float* RK = (const float*)(p.ws + WS_RK); const bf16* VS = (const bf16*)(p.ws + WS_VS);
    const bf16* LO = (const bf16*)(p.ws + WS_LORA); bf16* AR = (bf16*)(p.ws + WS_ARWKV);
    const int c0 = 16 * c.lane, hd = c.lane >> 2;
    f32x4 g[4], bb[4];
#pragma unroll
    for (int q = 0; q < 4; ++q) { g[q] = *(const f32x4*)(p.in[I_LNXG] + c0 + 4 * q); bb[q] = *(const f32x4*)(p.in[I_LNXB] + c0 + 4 * q); }
    for (int row = c.gw; row < TL; row += c.NGW) {
        f32x4 y[4]; float s = 0.f;
#pragma unroll
        for (int q = 0; q < 4; ++q) { y[q] = *(const f32x4*)(Y + (size_t)row * DR + c0 + 4 * q) + *(const f32x4*)(Y + ((size_t)TL + row) * DR + c0 + 4 * q); s += (y[q][0] + y[q][1]) + (y[q][2] + y[q][3]); }
        s += __shfl_xor(s, 1); s += __shfl_xor(s, 2); const float mean = s * (1.f / HS); float s2 = 0.f;
#pragma unroll
        for (int q = 0; q < 4; ++q) { y[q] = y[q] - mean; s2 += (y[q][0] * y[q][0] + y[q][1] * y[q][1]) + (y[q][2] * y[q][2] + y[q][3] * y[q][3]); }
        s2 += __shfl_xor(s2, 1); s2 += __shfl_xor(s2, 2); const float rstd = __builtin_amdgcn_rsqf(s2 * (1.f / HS) + GN_EPS);
        const float rk = RK[(size_t)row * NH + hd];
        f32x4 v[4], gt[4];
        unpack8(*(const u32x4*)(VS + (size_t)row * DR + c0), v[0], v[1]); unpack8(*(const u32x4*)(VS + (size_t)row * DR + c0 + 8), v[2], v[3]);
        unpack8(*(const u32x4*)(LO + (size_t)row * LORA_N + 4 * DR + c0), gt[0], gt[1]); unpack8(*(const u32x4*)(LO + (size_t)row * LORA_N + 4 * DR + c0 + 8), gt[2], gt[3]);
#pragma unroll
        for (int q = 0; q < 4; ++q) y[q] = (y[q] * rstd * g[q] + bb[q] + v[q] * rk) * gt[q];
        bf16* o = AR + (size_t)row * DR + c0; *(u32x4*)o = pg8::pack8(y[0], y[1]); *(u32x4*)(o + 8) = pg8::pack8(y[2], y[3]);
    }
}

__device__ __forceinline__ void p10_router(const Params& p, const Ctx& c) {
    const float* T1 = (const float*)(p.ws + WS_T1); float* XM = (float*)(p.ws + WS_XMID); bf16* UH = (bf16*)(p.ws + WS_U2HI); bf16* UL = (bf16*)(p.ws + WS_U2LO);
    const float* mod = (const float*)(p.ws + WS_MOD); const bf16* WRt = (const bf16*)(p.ws + WS_WR); unsigned char* U8 = p.ws + WS_U2F8;
    unsigned* cntg = (unsigned*)(p.ws + WS_CTL) + CW_CNT; int* rowtok = (int*)(p.ws + WS_ROWTOK); float* roww = (float*)(p.ws + WS_ROWW); unsigned* sel = (unsigned*)(p.ws + WS_SEL);
    for (int un = c.bid; un < TL / 64; un += c.G) {
        const int r0 = un * 64, b = r0 / SEQ;
        const float* sh = mod + (size_t)b * (6 * D) + 3 * D; const float* sc = sh + D;
        for (int i = 0; i < 8; ++i) { const int row = r0 + c.wave * 8 + i;
            f32x4 v[8]; float s = 0.f;
#pragma unroll
            for (int j = 0; j < 8; ++j) { v[j] = *(const f32x4*)(T1 + (size_t)row * D + 4 * c.lane + 256 * j); s += (v[j][0] + v[j][1]) + (v[j][2] + v[j][3]); }
            float mean = wave_sum(s) * (1.f / D), s2 = 0.f;
#pragma unroll
            for (int j = 0; j < 8; ++j) { v[j] = v[j] - mean; s2 += (v[j][0] * v[j][0] + v[j][1] * v[j][1]) + (v[j][2] * v[j][2] + v[j][3] * v[j][3]); }
            float rstd = __builtin_amdgcn_rsqf(wave_sum(s2) * (1.f / D) + LN_EPS); s = 0.f;
#pragma unroll
            for (int j = 0; j < 8; ++j) { const int col = 4 * c.lane + 256 * j; v[j] = v[j] * rstd * *(const f32x4*)(p.in[I_LN1G] + col) + *(const f32x4*)(p.in[I_LN1B] + col);
                *(f32x4*)(XM + (size_t)row * D + col) = v[j]; s += (v[j][0] + v[j][1]) + (v[j][2] + v[j][3]); }
            mean = wave_sum(s) * (1.f / D); s2 = 0.f;
#pragma unroll
            for (int j = 0; j < 8; ++j) { v[j] = v[j] - mean; s2 += (v[j][0] * v[j][0] + v[j][1] * v[j][1]) + (v[j][2] * v[j][2] + v[j][3] * v[j][3]); }
            rstd = __builtin_amdgcn_rsqf(wave_sum(s2) * (1.f / D) + LN_EPS);
#pragma unroll
            for (int j = 0; j < 8; ++j) { const int col = 4 * c.lane + 256 * j; const f32x4 o = v[j] * rstd * (*(const f32x4*)(sc + col) + 1.0f) + *(const f32x4*)(sh + col);
                u32x2 hi; hi.x = cvt_pk_bf16(o[0], o[1]); hi.y = cvt_pk_bf16(o[2], o[3]);
                u32x2 lo; lo.x = cvt_pk_bf16(o[0] - bflo(hi.x), o[1] - bfhi(hi.x)); lo.y = cvt_pk_bf16(o[2] - bflo(hi.y), o[3] - bfhi(hi.y));
                *(u32x2*)(UH + (size_t)row * D + col) = hi; *(u32x2*)(UL + (size_t)row * D + col) = lo;
                *(unsigned*)(U8 + (size_t)row * D + col) = pk_fp8x4(o[0], o[1], o[2], o[3]); }
        }
        asm volatile("s_waitcnt vmcnt(0)" ::: "memory");
        __syncthreads();
        if (c.wave < 4) {
            const int tr = r0 + 16 * c.wave + (c.lane & 15), kq = 8 * (c.lane >> 4);
            f32x4 acc0 = (f32x4){0.f, 0.f, 0.f, 0.f}, acc1 = acc0;
            const bf16* ah = UH + (size_t)tr * D + kq; const bf16* al = UL + (size_t)tr * D + kq;
            const bf16* bh0 = WRt + (size_t)(c.lane & 15) * D + kq; const bf16* bh1 = bh0 + 16 * D; const bf16* bl0 = bh0 + NE * D; const bf16* bl1 = bl0 + 16 * D;
#pragma unroll 4
            for (int s = 0; s < D / 32; ++s) {
                const bf16x8 xh = *(const bf16x8*)(ah + 32 * s), xl = *(const bf16x8*)(al + 32 * s);
                const bf16x8 wh0 = *(const bf16x8*)(bh0 + 32 * s), wh1 = *(const bf16x8*)(bh1 + 32 * s), wl0 = *(const bf16x8*)(bl0 + 32 * s), wl1 = *(const bf16x8*)(bl1 + 32 * s);
                acc0 = __builtin_amdgcn_mfma_f32_16x16x32_bf16(xh, wh0, acc0, 0, 0, 0); acc1 = __builtin_amdgcn_mfma_f32_16x16x32_bf16(xh, wh1, acc1, 0, 0, 0);
                acc0 = __builtin_amdgcn_mfma_f32_16x16x32_bf16(xl, wh0, acc0, 0, 0, 0); acc1 = __builtin_amdgcn_mfma_f32_16x16x32_bf16(xl, wh1, acc1, 0, 0, 0);
                acc0 = __builtin_amdgcn_mfma_f32_16x16x32_bf16(xh, wl0, acc0, 0, 0, 0); acc1 = __builtin_amdgcn_mfma_f32_16x16x32_bf16(xh, wl1, acc1, 0, 0, 0);
            }
            LAS float* lg = (LAS float*)(c.lds + c.wave * 2048);
            const float br0 = p.in[I_BROUTER][c.lane & 15], br1 = p.in[I_BROUTER][16 + (c.lane & 15)];
#pragma unroll
            for (int i = 0; i < 4; ++i) { const int tk = (c.lane >> 4) * 4 + i; lg[tk * 32 + (c.lane & 15)] = acc0[i] + br0; lg[tk * 32 + 16 + (c.lane & 15)] = acc1[i] + br1; }
            asm volatile("s_waitcnt lgkmcnt(0)" ::: "memory");
            if (c.lane < 16) {
                float l[32];
#pragma unroll
                for (int q = 0; q < 8; ++q) { const f32x4 t = *(const LAS f32x4*)(lg + c.lane * 32 + 4 * q); l[4 * q] = t[0]; l[4 * q + 1] = t[1]; l[4 * q + 2] = t[2]; l[4 * q + 3] = t[3]; }
                unsigned used = 0u; float tv[4]; int ti[4];
#pragma unroll
                for (int s = 0; s < 4; ++s) { float best = -3.0e38f; int bi = 0;
#pragma unroll
                    for (int e = 0; e < 32; ++e) { const bool ok = !((used >> e) & 1u) && (l[e] > best); best = ok ? l[e] : best; bi = ok ? e : bi; }
                    used |= 1u << bi; tv[s] = best; ti[s] = bi; }
                const float e1 = __expf(tv[1] - tv[0]), e2 = __expf(tv[2] - tv[0]), e3 = __expf(tv[3] - tv[0]); const float inv = 1.f / (1.f + e1 + e2 + e3);
                const float gw[4] = {inv, e1 * inv, e2 * inv, e3 * inv};
                const int row = r0 + 16 * c.wave + c.lane;
#pragma unroll
                for (int s = 0; s < 4; ++s) { const unsigned j = __hip_atomic_fetch_add(cntg + 16 * ti[s], 1u, RLX_AGENT);
                    rowtok[(size_t)ti[s] * ECAP + j] = row; roww[(size_t)ti[s] * ECAP + j] = gw[s]; sel[row * 4 + s] = ((unsigned)ti[s] << 16) | j; }
            }
        }
        __syncthreads();
    }
}
__device__ __forceinline__ void moe_plan(const Params& p, const Ctx& c) {
    LAS int* cnt = (LAS int*)(c.lds + LX_CNT); LAS int* tst = (LAS int*)(c.lds + LX_TST); LAS unsigned char* te = (LAS unsigned char*)(c.lds + LX_TE);
    const unsigned* cntg = (const unsigned*)(p.ws + WS_CTL) + CW_CNT;
    __syncthreads();
    if (c.tid < NE) cnt[c.tid] = (int)__hip_atomic_load(cntg + 16 * c.tid, RLX_AGENT);
    __syncthreads();
    if (c.tid == 0) { int a = 0; for (int e = 0; e < NE; ++e) { tst[e] = a; a += (cnt[e] + 255) >> 8; } tst[NE] = a; }
    __syncthreads();
    if (c.tid < NE) { for (int t = tst[c.tid]; t < tst[c.tid + 1]; ++t) te[t] = (unsigned char)c.tid; }
    __syncthreads();
}
__device__ __forceinline__ void p13_final(const Params& p, const Ctx& c) {
    const float* XM = (const float*)(p.ws + WS_XMID); const bf16* DN = (const bf16*)(p.ws + WS_DOWN); const unsigned* sel = (const unsigned*)(p.ws + WS_SEL);
    const float* mod = (const float*)(p.ws + WS_MOD); const LAS int* tst = (const LAS int*)(c.lds + LX_TST);
    for (int row = c.gw; row < TL; row += c.NGW) {
        const int b = row / SEQ; const float* gate = mod + (size_t)b * (6 * D) + 5 * D;
        f32x4 a[4][2];
#pragma unroll
        for (int j = 0; j < 4; ++j) { a[j][0] = (f32x4){0.f, 0.f, 0.f, 0.f}; a[j][1] = a[j][0]; }
#pragma unroll
        for (int s = 0; s < 4; ++s) { const unsigned sv = sel[row * 4 + s]; const int e = (int)(sv >> 16), jj = (int)(sv & 0xffffu); const size_t pos = (size_t)tst[e] * 256 + jj;
#pragma unroll
            for (int j = 0; j < 4; ++j) { f32x4 x0, x1; pg8::unpack8(*(const u32x4*)(DN + pos * D + 8 * c.lane + 512 * j), x0, x1); a[j][0] += x0; a[j][1] += x1; } }
        float s = 0.f;
#pragma unroll
        for (int j = 0; j < 4; ++j)
#pragma unroll
            for (int hh = 0; hh < 2; ++hh) { const int col = 8 * c.lane + 512 * j + 4 * hh; a[j][hh] = *(const f32x4*)(XM + (size_t)row * D + col) * DN_ALPHA + *(const f32x4*)(gate + col) * a[j][hh];
                s += (a[j][hh][0] + a[j][hh][1]) + (a[j][hh][2] + a[j][hh][3]); }
        const float mean = wave_sum(s) * (1.f / D); float s2 = 0.f;
#pragma unroll
        for (int j = 0; j < 4; ++j)
#pragma unroll
            for (int hh = 0; hh < 2; ++hh) { a[j][hh] = a[j][hh] - mean; s2 += (a[j][hh][0] * a[j][hh][0] + a[j][hh][1] * a[j][hh][1]) + (a[j][hh][2] * a[j][hh][2] + a[j][hh][3] * a[j][hh][3]); }
        const float rstd = __builtin_amdgcn_rsqf(wave_sum(s2) * (1.f / D) + LN_EPS);
#pragma unroll
        for (int j = 0; j < 4; ++j)
#pragma unroll
            for (int hh = 0; hh < 2; ++hh) { const int col = 8 * c.lane + 512 * j + 4 * hh;
                *(f32x4*)(p.out + (size_t)row * D + col) = a[j][hh] * rstd * *(const f32x4*)(p.in[I_LN2G] + col) + *(const f32x4*)(p.in[I_LN2B] + col); }
    }
}

constexpr int N_PHASES = 14;
__global__ void __launch_bounds__(512, 2) fwd(Params p) {
    extern __shared__ __attribute__((aligned(16))) unsigned char lds_raw[];
    Ctx c; c.lds = (LAS unsigned char*)lds_raw; c.tid = threadIdx.x; c.lane = c.tid & 63; c.wave = __builtin_amdgcn_readfirstlane(c.tid >> 6);
    c.G = gridDim.x; c.bid = blockIdx.x; c.gw = c.bid * 8 + c.wave; c.NGW = c.G * 8;
    unsigned char* ws = p.ws;
    const int lo = p.ph_lo, hi = p.ph_hi;
    volatile LAS unsigned* MISC = (volatile LAS unsigned*)(c.lds + LX_MISC);
    if (c.tid < 64) MISC[c.tid] = 0u;
    __syncthreads();
    XcdBarrier bar; bar.bar = (unsigned*)(ws + WS_CTL) + CW_BAR; bar.x = 0; bar.st = nullptr;
    if (hi - lo > 1) bar = xcd_barrier_post((unsigned*)(ws + WS_CTL) + CW_BAR, MISC + 8);
#ifndef ONLY_PHASE
#define ONLY_PHASE -1
#endif
#define IN(k) ((ONLY_PHASE < 0 || ONLY_PHASE == (k)) && lo <= (k) && (k) < hi)
#define SEAM(k) do { if (IN(k) && IN((k) + 1)) xcd_barrier(bar); } while (0)
    LAS unsigned char* ring = c.lds;

#ifndef DUP_MASK
#define DUP_MASK 0
#endif
#define PH(k, ...) do { if (IN(k)) { __VA_ARGS__ if constexpr (((DUP_MASK) >> (k)) & 1) { if (hi - lo > 1) xcd_barrier(bar); __VA_ARGS__ } } SEAM(k); } while (0)
    PH(0, { p0_adaln(p, c); p0_small(p, c); p0_convert(p, c); if (!CONV_IN_SCAN) moe_convert(p, c.gw, c.NGW, c.lane); });
    PH(1, { p1_modulate(p, c); });
    PH(2, { pg8::InProjSched S{(const bf16*)(ws + WS_U), (const bf16*)(ws + WS_WIN), c.G, c.bid};
        pg8::EpiInProj E{(bf16*)(ws + WS_ZL), (bf16*)(ws + WS_ZC), (const float*)(ws + WS_BIN)};
        pg8::gemm_phase<pg8::EpiInProj, pg8::InProjSched, false>(ring, D, S, E, nullptr); });
    PH(3, { p3_conv(p, c); p3_alora(p, c); });
    PH(4, {
        { pg8::PlainSched S{(const bf16*)(ws + WS_ALORA), (const bf16*)(ws + WS_WLORA), LORA_K, TT / 256, LORA_N / 256, c.G, c.bid};
          pg8::EpiBf16Plain E{(bf16*)(ws + WS_LORA), LORA_N, nullptr};
          pg8::gemm_phase<pg8::EpiBf16Plain, pg8::PlainSched, false>(ring, LORA_K, S, E, nullptr); }
        { pg8::PlainSched S{(const bf16*)(ws + WS_ACONV), (const bf16*)(ws + WS_WCO), DCV, TL / 256, D / 256, c.G, c.bid};
          pg8::EpiConvO E{(bf16*)(ws + WS_MIX), (const bf16*)(ws + WS_ZL), p.in[I_BCO]};
          pg8::gemm_phase<pg8::EpiConvO, pg8::PlainSched, false>(ring, DCV, S, E, nullptr); }
    });
    PH(5, { p5_prep(p, c); });
    PH(6, { p6_scan(p, c); });
    PH(7, { p7_rwkvout(p, c); });
    PH(8, { pg8::PlainSched S{(const bf16*)(ws + WS_ARWKV), (const bf16*)(ws + WS_WRO), DR, TL / 256, D / 256, c.G, c.bid};
        pg8::EpiRwkvO E{(bf16*)(ws + WS_MIX), (const bf16*)(ws + WS_ZL)};
        pg8::gemm_phase<pg8::EpiRwkvO, pg8::PlainSched, false>(ring, DR, S, E, nullptr); });
    PH(9, { pg8::PlainSched S{(const bf16*)(ws + WS_MIX), (const bf16*)(ws + WS_WOUT), D, TL / 256, D / 256, c.G, c.bid};
        pg8::EpiOut E{(float*)(ws + WS_T1), p.in[I_X], (const float*)(ws + WS_MOD), p.in[I_BOUT]};
        pg8::gemm_phase<pg8::EpiOut, pg8::PlainSched, false>(ring, D, S, E, nullptr); });
    PH(10, { p10_router(p, c); });
    PH(11, { moe_plan(p, c);
        pg8::MoeSched S{nullptr, (const bf16*)(ws + WS_WGU), (const int*)(ws + WS_ROWTOK), D / 2, 4096, 16, c.G, c.bid, (const LAS int*)(c.lds + LX_CNT), (const LAS int*)(c.lds + LX_TST), (const LAS unsigned char*)(c.lds + LX_TE)};
        pg8::EpiGateUp E{ws + WS_HID, (const float*)(ws + WS_BGU)};
        pg8::gemm_phase<pg8::EpiGateUp, pg8::MoeSched, true, true>(ring, D / 2, S, E, (const char*)(ws + WS_U2F8)); });
    PH(12, { moe_plan(p, c);
        pg8::MoeSched S{(const bf16*)(ws + WS_HID), (const bf16*)(ws + WS_WDN), (const int*)(ws + WS_ROWTOK), D / 2, D, 8, c.G, c.bid, (const LAS int*)(c.lds + LX_CNT), (const LAS int*)(c.lds + LX_TST), (const LAS unsigned char*)(c.lds + LX_TE)};
        pg8::EpiDown E{(bf16*)(ws + WS_DOWN), p.in[I_BDN], (const float*)(ws + WS_ROWW), (const LAS int*)(c.lds + LX_CNT)};
        pg8::gemm_phase<pg8::EpiDown, pg8::MoeSched, false, true>(ring, D / 2, S, E, nullptr); });
    PH(13, { moe_plan(p, c); p13_final(p, c); });
#undef PH
#undef IN
#undef SEAM
}

extern "C" void kernel_launch(void* const* d_in, const int* in_sizes, int n_in, void* d_out, int out_size, void* d_ws, size_t ws_size, hipStream_t stream) {
    static int grid = 0;
    if (grid == 0) {
        if (n_in != 38 || out_size != TL * D || ws_size < WS_END) { fprintf(stderr, "kernel_launch: unexpected shapes: n_in %d out %d ws %zu (need %zu)\n", n_in, out_size, ws_size, (size_t)WS_END); grid = -1; return; }
        int dev = 0, cus = 0, per_cu = 0;
        if (hipGetDevice(&dev) != hipSuccess || hipDeviceGetAttribute(&cus, hipDeviceAttributeMultiprocessorCount, dev) != hipSuccess) { grid = -1; return; }
        if (hipFuncSetAttribute((const void*)fwd, hipFuncAttributeMaxDynamicSharedMemorySize, LDS_BYTES) != hipSuccess) { fprintf(stderr, "kernel_launch: hipFuncSetAttribute failed\n"); grid = -1; return; }
        if (hipOccupancyMaxActiveBlocksPerMultiprocessor(&per_cu, (const void*)fwd, 512, LDS_BYTES) != hipSuccess || per_cu < 1) { fprintf(stderr, "kernel_launch: occupancy query says %d\n", per_cu); }
        (void)hipGetLastError();
        grid = cus;
    }
    if (grid < 0) return;
    (void)in_sizes;
    (void)hipMemsetAsync((char*)d_ws + WS_CTL, 0, CTL_ZERO_BYTES, stream);
    Params p; memset(&p, 0, sizeof(p));
    for (int i = 0; i < 38; ++i) p.in[i] = (const float*)d_in[i];
    p.out = (float*)d_out; p.ws = (unsigned char*)d_ws;
#if MK_FUSED
    p.ph_lo = 0; p.ph_hi = N_PHASES;
    hipLaunchKernelGGL(fwd, dim3(grid), dim3(512), LDS_BYTES, stream, p);
#else
    for (int k = 0; k < N_PHASES; ++k) { p.ph_lo = k; p.ph_hi = k + 1; hipLaunchKernelGGL(fwd, dim3(grid), dim3(512), LDS_BYTES, stream, p); }
#endif
}
```

```cpp
#include <hip/hip_runtime.h>
#include <cstdio>
#include <cstdint>
#include <cstring>

#ifndef CONV_IN_SCAN
#define CONV_IN_SCAN 1
#endif
#ifndef MK_FUSED
#define MK_FUSED 1
#endif

#define GAS __attribute__((address_space(1)))
#define LAS __attribute__((address_space(3)))
typedef unsigned short bf16;
typedef short bf16x8 __attribute__((ext_vector_type(8)));
typedef float f32x4 __attribute__((ext_vector_type(4)));
typedef float f32x2 __attribute__((ext_vector_type(2)));
typedef unsigned u32x4 __attribute__((ext_vector_type(4)));
typedef unsigned u32x2 __attribute__((ext_vector_type(2)));
typedef int v8i __attribute__((ext_vector_type(8)));
typedef int v4i __attribute__((ext_vector_type(4)));

constexpr int D = 2048, NB = 8, SEQ = 2048, CTXL = 256, TL = NB * SEQ, TC = NB * CTXL, TT = TL + TC;
constexpr int DCV = 1024, DR = 1024, NH = 16, HS = 64, CWID = 31;
constexpr int DSHIFT = 3488, PIN = 9632;
constexpr int ZN = 9728, ZCN = 3584, ZR0 = 2048, ZG0 = 5632;
constexpr int NE = 32, ECAP = 16384, MAXMT = 288;
constexpr int LORA_K = 512, LORA_N = 5120;
constexpr int SCH = 16, NCHUNK = (CTXL + SEQ) / SCH, SBUF = SCH * 1280 + 256;
constexpr float LN_EPS = 1e-5f, GN_EPS = 64e-5f, DN_ALPHA = 1.189207115002721f;
constexpr float SW_LIMIT = 7.0f, SW_ALPHA = 1.702f;
constexpr float W8_SCALE = 64.0f;
constexpr int SC_W8 = 0x79797979, SC_ONE = 0x7F7F7F7F;

constexpr size_t MiB = 1u << 20;
constexpr size_t WS_CTL = 0, CTL_ZERO_BYTES = 1 * MiB;
constexpr size_t WS_MOD = 1 * MiB, WS_BIN = 2 * MiB, WS_BGU = 2 * MiB + 65536, WS_WR = 3 * MiB, WS_SEL = 4 * MiB, WS_RK = 5 * MiB;
constexpr size_t WS_ROWTOK = 6 * MiB, WS_ROWW = 8 * MiB, WS_WCO = 10 * MiB, WS_WRO = 14 * MiB, WS_WOUT = 18 * MiB, WS_WLORA = 26 * MiB;
constexpr size_t WS_WIN = 32 * MiB, WS_U = 70 * MiB, WS_ACONV = 142 * MiB, WS_ALORA = 174 * MiB, WS_ARWKV = 192 * MiB, WS_VS = 224 * MiB;
constexpr size_t WS_MIX = 256 * MiB, WS_U2HI = 320 * MiB, WS_U2LO = 384 * MiB, WS_T1 = 448 * MiB, WS_XMID = 576 * MiB, WS_Y = 704 * MiB;
constexpr size_t WS_ZC = 832 * MiB, WS_LORA = 848 * MiB, WS_ZL = 1028 * MiB, WS_SC = 1332 * MiB, WS_WGU = 1728 * MiB, WS_WDN = 2240 * MiB;
constexpr size_t WS_U2F8 = 1332 * MiB;
constexpr size_t WS_HID = 2496 * MiB, WS_DOWN = 2784 * MiB, WS_SC2 = 3072 * MiB, WS_END = 3804 * MiB;
constexpr int CW_BAR = 4096;
constexpr int CW_CNT = 1024;

constexpr int RING_BYTES = 131072;
constexpr int LDSX_OFF = RING_BYTES;
constexpr int LX_MISC = LDSX_OFF;
constexpr int LX_CNT = LDSX_OFF + 256;
constexpr int LX_TST = LDSX_OFF + 512;
constexpr int LX_TE = LDSX_OFF + 768;
constexpr int LDS_BYTES = 147456;

__device__ __forceinline__ unsigned f2bf(float f) { unsigned u = __builtin_bit_cast(unsigned, f); return (u + 0x7fffu + ((u >> 16) & 1u)) >> 16; }
__device__ __forceinline__ unsigned cvt_pk_bf16(float lo, float hi) { unsigned r; asm volatile("v_cvt_pk_bf16_f32 %0, %1, %2" : "=v"(r) : "v"(lo), "v"(hi)); return r; }
__device__ __forceinline__ float clamp448(float x) { return fminf(fmaxf(x, -448.f), 448.f); }
__device__ __forceinline__ unsigned pk_fp8x4(float a, float b, float c, float d) {
    unsigned w = 0u; w = (unsigned)__builtin_amdgcn_cvt_pk_fp8_f32(clamp448(a), clamp448(b), (int)w, false); w = (unsigned)__builtin_amdgcn_cvt_pk_fp8_f32(clamp448(c), clamp448(d), (int)w, true); return w; }
__device__ __forceinline__ float bflo(unsigned u) { return __builtin_bit_cast(float, u << 16); }
__device__ __forceinline__ float bfhi(unsigned u) { return __builtin_bit_cast(float, u & 0xffff0000u); }
__device__ __forceinline__ float bf1(bf16 h) { return __builtin_bit_cast(float, ((unsigned)h) << 16); }
__device__ __forceinline__ float sigm(float x) { return __builtin_amdgcn_rcpf(1.f + __expf(-x)); }
__device__ __forceinline__ float wave_sum(float v) {
#pragma unroll
    for (int o = 1; o < 64; o <<= 1) v += __shfl_xor(v, o);
    return v;
}
#define RLX_AGENT __ATOMIC_RELAXED, __HIP_MEMORY_SCOPE_AGENT

#define XB_TMO      128
#define XB_XCNT(j)  (256  + 64 * (j))
#define XB_XSUB(j)  (1280 + 64 * (j))
#define XB_XGEN(j)  (2304 + 64 * (j))
#define XB_TOP      3328
#define XB_TOPGEN   3392
#define XCD_BAR_WORDS 3456
#define XB_SPIN_CAP (1u << 22)
__device__ __forceinline__ unsigned xb_ld(unsigned* p)              { return __hip_atomic_load(p, __ATOMIC_RELAXED, __HIP_MEMORY_SCOPE_AGENT); }
__device__ __forceinline__ unsigned xb_add(unsigned* p, unsigned v) { return __hip_atomic_fetch_add(p, v, __ATOMIC_RELAXED, __HIP_MEMORY_SCOPE_AGENT); }
__device__ __forceinline__ unsigned xb_xcc_id() { return (unsigned)__builtin_amdgcn_s_getreg((3 << 11) | 20) & 0xFu; }
#define XB_SPIN(cond, bar) do { unsigned _sp = 0; while (cond) { __builtin_amdgcn_s_sleep(1); \
    if ((++_sp & 255u) == 0u) { if (xb_ld(&(bar)[XB_TMO])) break; if (_sp > XB_SPIN_CAP) { atomicAdd(&(bar)[XB_TMO], 1u); break; } } } } while (0)
struct XcdBarrier { unsigned* bar; unsigned x; volatile LAS unsigned* st; };
__device__ __forceinline__ XcdBarrier xcd_barrier_post(unsigned* bar, volatile LAS unsigned* st) {
    XcdBarrier b; b.bar = bar; b.x = xb_xcc_id(); b.st = st;
    if (threadIdx.x == 0) (void)xb_add(&bar[XB_XCNT(b.x)], 1u);
    return b;
}
__device__ __forceinline__ void xcd_barrier_complete(unsigned* bar, unsigned x, unsigned& nloc, unsigned& nx) {
    const unsigned G = gridDim.x * gridDim.y * gridDim.z;
    unsigned sum, cnt, mine, sp = 0u;
    for (;;) {
        sum = 0u; cnt = 0u; mine = 0u;
#pragma unroll
        for (unsigned j = 0; j < 16; ++j) { const unsigned c = xb_ld(&bar[XB_XCNT(j)]); sum += c; cnt += (c > 0u) ? 1u : 0u; mine = (j == x) ? c : mine; }
        if (sum == G) break;
        __builtin_amdgcn_s_sleep(1);
        if ((++sp & 255u) == 0u) { if (xb_ld(&bar[XB_TMO])) break; if (sp > XB_SPIN_CAP) { atomicAdd(&bar[XB_TMO], 1u); break; } }
    }
    nloc = mine > 0u ? mine : 1u; nx = cnt > 0u ? cnt : 1u;
}
__device__ __forceinline__ void xcd_barrier(const XcdBarrier& b) {
    asm volatile("s_waitcnt vmcnt(0)" ::: "memory");
    __syncthreads();
    if (threadIdx.x == 0) {
        unsigned* bar = b.bar;
        __builtin_amdgcn_s_waitcnt(0);
        unsigned nloc = b.st[0], nx = b.st[1];
        if (nloc == 0u) { xcd_barrier_complete(bar, b.x, nloc, nx); b.st[0] = nloc; b.st[1] = nx; }
        const unsigned old = xb_add(&bar[XB_XSUB(b.x)], 1u);
        const unsigned gen = old / nloc;
        if (old + 1u == (gen + 1u) * nloc) {
            __builtin_amdgcn_fence(__ATOMIC_RELEASE, "agent");
            asm volatile("s_waitcnt vmcnt(0)" ::: "memory");
            const unsigned og = xb_add(&bar[XB_TOP], 1u);
            const unsigned tg = og / nx;
            if (og + 1u == (tg + 1u) * nx) xb_add(&bar[XB_TOPGEN], 1u);
            else XB_SPIN(xb_ld(&bar[XB_TOPGEN]) == tg, bar);
            __builtin_amdgcn_fence(__ATOMIC_ACQUIRE, "agent");
            xb_add(&bar[XB_XGEN(b.x)], 1u);
            asm volatile("s_waitcnt vmcnt(0)" ::: "memory");
        } else {
            XB_SPIN(xb_ld(&bar[XB_XGEN(b.x)]) == gen, bar);
            __builtin_amdgcn_fence(__ATOMIC_ACQUIRE, "agent");
            asm volatile("s_waitcnt vmcnt(0)" ::: "memory");
        }
    }
    __syncthreads();
}

namespace pg8 {
constexpr int BM = 256, BK = 64, HALF = 128, HTB = HALF * BK * 2, STAGE_BYTES = 8 * HTB, NXCD = 8, WGM = 8;
__host__ __device__ __forceinline__ int lds_byte(int r, int c) { const int st = (r >> 4) * 2 + (c >> 5), rr = r & 15, cc = c & 31, ob = rr * 64 + cc * 2; return st * 1024 + (ob ^ (((ob >> 9) & 1) << 5)); }
__host__ __device__ __forceinline__ void stage_rc(int b, int& R, int& C) { const int st = b / 1024, sb = b % 1024, swz = sb ^ (((sb >> 9) & 1) << 5); R = (st >> 1) * 16 + swz / 64; C = (st & 1) * 32 + (swz % 64) / 2; }
__host__ __device__ __forceinline__ int perm32(int rho) { const int n = rho >> 4, i = rho & 15; return 8 * (i >> 2) + 4 * n + (i & 3); }

struct Unit { int pm, pn, e, lt; };
__device__ __forceinline__ void map_tile(int wgid, int nwg, int nM, int nN, int& pm, int& pn) {
    { const int q = nwg / NXCD, r = nwg % NXCD, xcd = wgid % NXCD, off = wgid / NXCD; wgid = (xcd < r ? xcd * (q + 1) : r * (q + 1) + (xcd - r) * q) + off; }
    const int nig = WGM * nN, gid = wgid / nig, fm = gid * WGM, gsz = (nM - fm) < WGM ? (nM - fm) : WGM;
    pm = fm + ((wgid % nig) % gsz); pn = (wgid % nig) / gsz;
}
struct PlainSched {
    const bf16* A; const bf16* Bt; int K, nM, nN, G, c;
    __device__ __forceinline__ bool next(int i, Unit& u) const { const long L = (long)i * G + c; if (L >= (long)nM * nN) return false; map_tile((int)L, nM * nN, nM, nN, u.pm, u.pn); u.e = 0; u.lt = 0; return true; }
    __device__ __forceinline__ const char* aptr(const Unit& u) const { return (const char*)A + (size_t)u.pm * BM * K * 2; }
    __device__ __forceinline__ const char* bptr(const Unit& u) const { return (const char*)Bt + (size_t)u.pn * BM * K * 2; }
    __device__ __forceinline__ void rows(const Unit&, const int (&)[2], const int (&)[2], unsigned (&)[2][2]) const {}
};
struct InProjSched {
    const bf16* A; const bf16* Bt; int G, c;
    __device__ __forceinline__ bool next(int i, Unit& u) const {
        const int L = i * G + c; constexpr int NL = 64 * 38, NCX = 8 * 14;
        if (L >= NL + NCX) return false;
        if (L < NL) map_tile(L, NL, 64, 38, u.pm, u.pn); else { map_tile(L - NL, NCX, 8, 14, u.pm, u.pn); u.pm += 64; u.pn += 8; }
        u.e = 0; u.lt = 0; return true; }
    __device__ __forceinline__ const char* aptr(const Unit& u) const { return (const char*)A + (size_t)u.pm * BM * D; }
    __device__ __forceinline__ const char* bptr(const Unit& u) const { return (const char*)Bt + (size_t)u.pn * BM * D; }
    __device__ __forceinline__ void rows(const Unit&, const int (&)[2], const int (&)[2], unsigned (&)[2][2]) const {}
};
struct MoeSched {
    const bf16* A; const bf16* Bt; const int* rowtok; int K, N, nN, G, c; const LAS int* cnt; const LAS int* tst; const LAS unsigned char* te;
    __device__ __forceinline__ bool next(int i, Unit& u) const { const int nM = tst[NE]; const int L = i * G + c; if (L >= nM * nN) return false;
        map_tile(L, nM * nN, nM, nN, u.pm, u.pn); u.e = te[u.pm]; u.lt = u.pm - tst[u.e]; return true; }
    __device__ __forceinline__ const char* aptr(const Unit& u) const { return (const char*)A + (size_t)u.pm * BM * K * 2; }
    __device__ __forceinline__ const char* bptr(const Unit& u) const { return (const char*)Bt + ((size_t)u.e * N + (size_t)u.pn * BM) * K * 2; }
    __device__ __forceinline__ void rows(const Unit& u, const int (&sR)[2], const int (&sC2)[2], unsigned (&g)[2][2]) const {
        const int n = cnt[u.e]; const int* rt = rowtok + (size_t)u.e * ECAP;
#pragma unroll
        for (int h = 0; h < 2; ++h)
#pragma unroll
            for (int i = 0; i < 2; ++i) { const int j = u.lt * BM + h * HALF + sR[i]; const int tok = (j < n) ? rt[j] : 0; g[h][i] = (unsigned)tok * (unsigned)(K * 2) + (unsigned)sC2[i]; }
        asm volatile("s_waitcnt vmcnt(0)" ::: "memory");
    }
};

template <class Epi, class Sched, bool GATHER, bool F8 = false>
__device__ __forceinline__ void gemm_phase(LAS unsigned char* lds, const int K, const Sched& S, const Epi& E, const char* gatherA) {
    const int tid = threadIdx.x, wid = __builtin_amdgcn_readfirstlane(tid >> 6), lane = tid & 63, wr = wid >> 2, wc = wid & 3, fr = lane & 15, fq = lane >> 4;
    const int nt = K / BK;
    unsigned voffA[2], voffB[2]; int sR[2], sC2[2];
#pragma unroll
    for (int i = 0; i < 2; ++i) { int R, C; stage_rc(tid * 16 + i * 8192, R, C); const int Rb = Epi::PERM ? ((R & ~31) + perm32(R & 31)) : R;
        voffA[i] = (unsigned)(R * K + C) * 2u; voffB[i] = (unsigned)(Rb * K + C) * 2u; sR[i] = R; sC2[i] = C * 2; }
    const size_t kstep = (size_t)(BK * 2);
    const size_t hstep = (size_t)HALF * K * 2;
    const unsigned ldsw = (unsigned)wid * 1024u;
    const int aoff = lds_byte(wr * 64 + fr, fq * 8), boff = lds_byte(wc * 32 + fr, fq * 8);
#define PG8_SA(b, h) (((b) * 2 + (h)) * HTB)
#define PG8_SB(b, h) ((4 + (b) * 2 + (h)) * HTB)
#define PG8_STAGE(bufoff, gbase, voff) do { _Pragma("unroll") for (int _i = 0; _i < 2; ++_i) \
        __builtin_amdgcn_global_load_lds((const unsigned*)((const char*)(gbase) + (voff)[_i]), (LAS unsigned*)(lds + (bufoff) + ldsw + _i * 8192), 16, 0, 0); } while (0)
#define PG8_STG_A(bufoff, gbase, h, OFF) do { if constexpr (GATHER) { PG8_STAGE(bufoff, gbase, OFF); } else { PG8_STAGE(bufoff, (gbase) + (h) * hstep, voffA); } } while (0)
#define PG8_CAT(p0, p1) __builtin_shufflevector(*(const LAS v4i*)(p0), *(const LAS v4i*)(p1), 0, 1, 2, 3, 4, 5, 6, 7)
#define PG8_LDA(dst, b, h) do { _Pragma("unroll") for (int m = 0; m < 4; ++m) { if constexpr (F8) dst##8[m] = PG8_CAT(lds + PG8_SA(b, h) + aoff + m * 2048, lds + PG8_SA(b, h) + aoff + m * 2048 + 1024); \
        else { _Pragma("unroll") for (int k = 0; k < 2; ++k) dst[m][k] = *(const LAS bf16x8*)(lds + PG8_SA(b, h) + aoff + m * 2048 + k * 1024); } } } while (0)
#define PG8_LDB(dst, b, h) do { _Pragma("unroll") for (int n = 0; n < 2; ++n) { if constexpr (F8) dst##8[n] = PG8_CAT(lds + PG8_SB(b, h) + boff + n * 2048, lds + PG8_SB(b, h) + boff + n * 2048 + 1024); \
        else { _Pragma("unroll") for (int k = 0; k < 2; ++k) dst[n][k] = *(const LAS bf16x8*)(lds + PG8_SB(b, h) + boff + n * 2048 + k * 1024); } } } while (0)
#define PG8_MMA(ai, bj, At, Bt) do { __builtin_amdgcn_s_setprio(1); _Pragma("unroll") for (int m = 0; m < 4; ++m) _Pragma("unroll") for (int n = 0; n < 2; ++n) { \
        if constexpr (F8) asm volatile("v_mfma_scale_f32_16x16x128_f8f6f4 %0, %1, %2, %0, %3, %4 op_sel_hi:[0,0,0]" : "+v"(acc[ai][bj][m][n]) : "v"(Bt##8[n]), "v"(At##8[m]), "v"(scw8), "v"(sca8)); \
        else { _Pragma("unroll") for (int k = 0; k < 2; ++k) acc[ai][bj][m][n] = __builtin_amdgcn_mfma_f32_16x16x32_bf16(Bt[n][k], At[m][k], acc[ai][bj][m][n], 0, 0, 0); } } __builtin_amdgcn_s_setprio(0); } while (0)
#define PG8_WAIT_V(n) asm volatile("s_waitcnt vmcnt(" #n ")" ::: "memory")
#define PG8_WAIT_L(n) asm volatile("s_waitcnt lgkmcnt(" #n ")" ::: "memory")
#define PG8_BAR __builtin_amdgcn_s_barrier()
#define PG8_SCHED __builtin_amdgcn_sched_barrier(0)
    Unit cur, nxt; int ui = 0;
    if (!S.next(0, cur)) return;
    f32x4 acc[2][2][4][2];
#pragma unroll
    for (int a = 0; a < 2; ++a)
#pragma unroll
        for (int b = 0; b < 2; ++b)
#pragma unroll
            for (int m = 0; m < 4; ++m)
#pragma unroll
                for (int n = 0; n < 2; ++n) acc[a][b][m][n] = (f32x4){0.f, 0.f, 0.f, 0.f};
    bf16x8 At[4][2], B0[2][2], B1[2][2]; v8i At8[4], B08[2], B18[2]; const int scw8 = SC_W8, sca8 = SC_ONE;
    const char* cA = GATHER ? gatherA : S.aptr(cur); const char* cB = S.bptr(cur);
    unsigned gA[2][2] = {{0u, 0u}, {0u, 0u}}, gA1[2] = {0u, 0u};
    if constexpr (GATHER) S.rows(cur, sR, sC2, gA);
    PG8_STAGE(PG8_SB(0, 0), cB, voffB); PG8_STAGE(PG8_SB(0, 1), cB + hstep, voffB); PG8_STG_A(PG8_SA(0, 0), cA, 0, gA[0]); PG8_STG_A(PG8_SA(0, 1), cA, 1, gA[1]);
    if (wr == 1) PG8_BAR;
    PG8_WAIT_V(2); PG8_BAR;
    PG8_STAGE(PG8_SB(1, 0), cB + kstep, voffB); PG8_STG_A(PG8_SA(1, 0), cA + kstep, 0, gA[0]); PG8_STAGE(PG8_SB(1, 1), cB + hstep + kstep, voffB);
    PG8_WAIT_V(6); PG8_BAR;
    for (;;) {
        const bool has_next = S.next(ui + 1, nxt);
        const char* nA = GATHER ? gatherA : (has_next ? S.aptr(nxt) : cA); const char* nB = has_next ? S.bptr(nxt) : cB;
        for (int t = 0; t < nt; t += 2) {
            const bool last = (t == nt - 2);
            const char* a1 = cA + (size_t)(t + 1) * kstep;
            const char* a2 = last ? nA : cA + (size_t)(t + 2) * kstep; const char* b2 = last ? nB : cB + (size_t)(t + 2) * kstep;
            const char* a3 = a2 + kstep; const char* b3 = b2 + kstep;
            if constexpr (GATHER) { gA1[0] = gA[1][0]; gA1[1] = gA[1][1]; if (last && has_next) S.rows(nxt, sR, sC2, gA); }
            PG8_LDB(B0, 0, 0); PG8_LDB(B1, 0, 1); PG8_SCHED; PG8_LDA(At, 0, 0); PG8_STG_A(PG8_SA(1, 1), a1, 1, gA1);
            PG8_WAIT_V(8); PG8_WAIT_L(0); PG8_BAR; PG8_MMA(0, 0, At, B0); PG8_MMA(0, 1, At, B1); PG8_BAR; PG8_SCHED;
            PG8_LDA(At, 0, 1); PG8_STAGE(PG8_SB(0, 0), b2, voffB); PG8_STAGE(PG8_SB(0, 1), b2 + hstep, voffB); PG8_STG_A(PG8_SA(0, 0), a2, 0, gA[0]);
            PG8_WAIT_V(8); PG8_WAIT_L(0); PG8_BAR; PG8_MMA(1, 0, At, B0); PG8_MMA(1, 1, At, B1); PG8_BAR; PG8_SCHED;
            PG8_LDB(B0, 1, 0); PG8_LDB(B1, 1, 1); PG8_SCHED; PG8_LDA(At, 1, 0); PG8_STG_A(PG8_SA(0, 1), a2, 1, gA[1]);
            PG8_WAIT_V(8); PG8_WAIT_L(0); PG8_BAR; PG8_MMA(0, 0, At, B0); PG8_MMA(0, 1, At, B1); PG8_BAR; PG8_SCHED;
            PG8_LDA(At, 1, 1); PG8_STAGE(PG8_SB(1, 0), b3, voffB); PG8_STAGE(PG8_SB(1, 1), b3 + hstep, voffB); PG8_STG_A(PG8_SA(1, 0), a3, 0, gA[0]);
            PG8_WAIT_V(8); PG8_WAIT_L(0); PG8_BAR; PG8_MMA(1, 0, At, B0); PG8_MMA(1, 1, At, B1); PG8_BAR; PG8_SCHED;
        }
        if (wr == 0) PG8_BAR;
        if constexpr (F8) asm volatile("s_nop 7\n\ts_nop 7\n\ts_nop 7" ::: "memory");
        E(acc, cur, wr, wc, fr, fq);
        if (!has_next) break;
#pragma unroll
        for (int a = 0; a < 2; ++a)
#pragma unroll
            for (int b = 0; b < 2; ++b)
#pragma unroll
                for (int m = 0; m < 4; ++m)
#pragma unroll
                    for (int n = 0; n < 2; ++n) acc[a][b][m][n] = (f32x4){0.f, 0.f, 0.f, 0.f};
        cur = nxt; cA = nA; cB = nB; ++ui;
        if (wr == 1) PG8_BAR;
    }
    PG8_WAIT_V(0);
    PG8_BAR;
#undef PG8_SA
#undef PG8_SB
#undef PG8_STAGE
#undef PG8_STG_A
#undef PG8_LDA
#undef PG8_CAT
#undef PG8_LDB
#undef PG8_MMA
#undef PG8_WAIT_V
#undef PG8_WAIT_L
#undef PG8_BAR
#undef PG8_SCHED
}

typedef const f32x4 (&AccT)[2][2][4][2];
__device__ __forceinline__ u32x4 pack8(f32x4 v0, f32x4 v1) { u32x4 w; w.x = cvt_pk_bf16(v0[0], v0[1]); w.y = cvt_pk_bf16(v0[2], v0[3]); w.z = cvt_pk_bf16(v1[0], v1[1]); w.w = cvt_pk_bf16(v1[2], v1[3]); return w; }
__device__ __forceinline__ void unpack8(u32x4 w, f32x4& v0, f32x4& v1) { v0 = (f32x4){bflo(w.x), bfhi(w.x), bflo(w.y), bfhi(w.y)}; v1 = (f32x4){bflo(w.z), bfhi(w.z), bflo(w.w), bfhi(w.w)}; }
__device__ __forceinline__ f32x4 sig4(f32x4 v) { return (f32x4){sigm(v[0]), sigm(v[1]), sigm(v[2]), sigm(v[3])}; }

struct EpiBf16Plain {
    static constexpr bool PERM = true;
    bf16* O; int ldc; const float* bias;
    __device__ __forceinline__ void operator()(AccT acc, const Unit& u, int wr, int wc, int fr, int fq) const {
        const int row0 = u.pm * BM + wr * 64 + fr, col0 = u.pn * BM + wc * 32 + 8 * fq;
        f32x4 bv[2][2];
#pragma unroll
        for (int bj = 0; bj < 2; ++bj)
#pragma unroll
            for (int n = 0; n < 2; ++n) bv[bj][n] = bias ? *(const f32x4*)(bias + col0 + bj * HALF + 4 * n) : (f32x4){0.f, 0.f, 0.f, 0.f};
#pragma unroll
        for (int ai = 0; ai < 2; ++ai)
#pragma unroll
            for (int m = 0; m < 4; ++m) { bf16* rowp = O + (size_t)(row0 + ai * HALF + m * 16) * ldc + col0;
#pragma unroll
                for (int bj = 0; bj < 2; ++bj) *(u32x4*)(rowp + bj * HALF) = pack8(acc[ai][bj][m][0] + bv[bj][0], acc[ai][bj][m][1] + bv[bj][1]); }
    }
};
struct EpiInProj {
    static constexpr bool PERM = true;
    bf16* ZL; bf16* ZC; const float* bias;
    __device__ __forceinline__ void operator()(AccT acc, const Unit& u, int wr, int wc, int fr, int fq) const {
        const int row0 = u.pm * BM + wr * 64 + fr, col0 = u.pn * BM + wc * 32 + 8 * fq;
        f32x4 bv[2][2];
#pragma unroll
        for (int bj = 0; bj < 2; ++bj)
#pragma unroll
            for (int n = 0; n < 2; ++n) bv[bj][n] = *(const f32x4*)(bias + col0 + bj * HALF + 4 * n);
        const bool lat = u.pm < 64;
#pragma unroll
        for (int ai = 0; ai < 2; ++ai)
#pragma unroll
            for (int m = 0; m < 4; ++m) { const int r = row0 + ai * HALF + m * 16;
                bf16* rowp = lat ? ZL + (size_t)r * ZN + col0 : ZC + (size_t)(r - TL) * ZCN + (col0 - ZR0);
#pragma unroll
                for (int bj = 0; bj < 2; ++bj) *(u32x4*)(rowp + bj * HALF) = pack8(acc[ai][bj][m][0] + bv[bj][0], acc[ai][bj][m][1] + bv[bj][1]); }
    }
};
struct EpiConvO {
    static constexpr bool PERM = true;
    bf16* MIX; const bf16* ZL; const float* bias;
    __device__ __forceinline__ void operator()(AccT acc, const Unit& u, int wr, int wc, int fr, int fq) const {
        const int row0 = u.pm * BM + wr * 64 + fr, col0 = u.pn * BM + wc * 32 + 8 * fq;
        f32x4 bv[2][2];
#pragma unroll
        for (int bj = 0; bj < 2; ++bj)
#pragma unroll
            for (int n = 0; n < 2; ++n) bv[bj][n] = *(const f32x4*)(bias + col0 + bj * HALF + 4 * n);
#pragma unroll
        for (int ai = 0; ai < 2; ++ai)
#pragma unroll
            for (int m = 0; m < 4; ++m) { const size_t r = (size_t)(row0 + ai * HALF + m * 16);
#pragma unroll
                for (int bj = 0; bj < 2; ++bj) { const int c = col0 + bj * HALF; f32x4 g0, g1; unpack8(*(const u32x4*)(ZL + r * ZN + ZG0 + c), g0, g1);
                    *(u32x4*)(MIX + r * D + c) = pack8(sig4(g0) * (acc[ai][bj][m][0] + bv[bj][0]), sig4(g1) * (acc[ai][bj][m][1] + bv[bj][1])); } }
    }
};
struct EpiRwkvO {
    static constexpr bool PERM = true;
    bf16* MIX; const bf16* ZL;
    __device__ __forceinline__ void operator()(AccT acc, const Unit& u, int wr, int wc, int fr, int fq) const {
        const int row0 = u.pm * BM + wr * 64 + fr, col0 = u.pn * BM + wc * 32 + 8 * fq;
#pragma unroll
        for (int ai = 0; ai < 2; ++ai)
#pragma unroll
            for (int m = 0; m < 4; ++m) { const size_t r = (size_t)(row0 + ai * HALF + m * 16);
#pragma unroll
                for (int bj = 0; bj < 2; ++bj) { const int c = col0 + bj * HALF; f32x4 g0, g1, m0, m1; unpack8(*(const u32x4*)(ZL + r * ZN + ZG0 + D + c), g0, g1); unpack8(*(const u32x4*)(MIX + r * D + c), m0, m1);
                    *(u32x4*)(MIX + r * D + c) = pack8(m0 + sig4(g0) * acc[ai][bj][m][0], m1 + sig4(g1) * acc[ai][bj][m][1]); } }
    }
};
struct EpiOut {
    static constexpr bool PERM = false;
    float* T1; const float* x; const float* mod; const float* bias;
    __device__ __forceinline__ void operator()(AccT acc, const Unit& u, int wr, int wc, int fr, int fq) const {
        const int row0 = u.pm * BM + wr * 64 + fr, col0 = u.pn * BM + wc * 32 + 4 * fq;
        const float* gate = mod + (size_t)(u.pm / 8) * (6 * D) + 2 * D;
        f32x4 bv[2][2], gv[2][2];
#pragma unroll
        for (int bj = 0; bj < 2; ++bj)
#pragma unroll
            for (int n = 0; n < 2; ++n) { bv[bj][n] = *(const f32x4*)(bias + col0 + bj * HALF + n * 16); gv[bj][n] = *(const f32x4*)(gate + col0 + bj * HALF + n * 16); }
#pragma unroll
        for (int ai = 0; ai < 2; ++ai)
#pragma unroll
            for (int m = 0; m < 4; ++m) { const size_t off = (size_t)(row0 + ai * HALF + m * 16) * D + col0;
#pragma unroll
                for (int bj = 0; bj < 2; ++bj)
#pragma unroll
                    for (int n = 0; n < 2; ++n) { const f32x4 xv = *(const f32x4*)(x + off + bj * HALF + n * 16);
                        *(f32x4*)(T1 + off + bj * HALF + n * 16) = xv * DN_ALPHA + gv[bj][n] * (acc[ai][bj][m][n] + bv[bj][n]); } }
    }
};
struct EpiGateUp {
    static constexpr bool PERM = true;
    unsigned char* HID; const float* bias;
    __device__ __forceinline__ void operator()(AccT acc, const Unit& u, int wr, int wc, int fr, int fq) const {
        const int row0 = u.pm * BM + wr * 64 + fr, cb = u.pn * BM + wc * 32 + 8 * fq, co = u.pn * HALF + wc * 32 + 8 * fq;
        const float* bp = bias + (size_t)u.e * 4096 + cb;
        f32x4 bv[2][2];
#pragma unroll
        for (int bj = 0; bj < 2; ++bj)
#pragma unroll
            for (int n = 0; n < 2; ++n) bv[bj][n] = *(const f32x4*)(bp + bj * HALF + 4 * n);
#pragma unroll
        for (int ai = 0; ai < 2; ++ai)
#pragma unroll
            for (int m = 0; m < 4; ++m) { f32x4 h[2];
#pragma unroll
                for (int n = 0; n < 2; ++n) { const f32x4 g = acc[ai][0][m][n] + bv[0][n], up = acc[ai][1][m][n] + bv[1][n];
#pragma unroll
                    for (int j = 0; j < 4; ++j) { const float gg = fminf(g[j], SW_LIMIT), uu = fminf(fmaxf(up[j], -SW_LIMIT), SW_LIMIT); h[n][j] = (uu + 1.0f) * (gg * sigm(SW_ALPHA * gg)); } }
                u32x2 o; o.x = pk_fp8x4(h[0][0], h[0][1], h[0][2], h[0][3]); o.y = pk_fp8x4(h[1][0], h[1][1], h[1][2], h[1][3]);
                *(u32x2*)(HID + (size_t)(row0 + ai * HALF + m * 16) * D + co) = o; }
    }
};
struct EpiDown {
    static constexpr bool PERM = true;
    bf16* DOWN; const float* bias; const float* roww; const LAS int* cnt;
    __device__ __forceinline__ void operator()(AccT acc, const Unit& u, int wr, int wc, int fr, int fq) const {
        const int rl0 = wr * 64 + fr, col0 = u.pn * BM + wc * 32 + 8 * fq; const int n_e = cnt[u.e];
        const float* bp = bias + (size_t)u.e * D + col0; const float* rw = roww + (size_t)u.e * ECAP + u.lt * BM;
        f32x4 bv[2][2];
#pragma unroll
        for (int bj = 0; bj < 2; ++bj)
#pragma unroll
            for (int n = 0; n < 2; ++n) bv[bj][n] = *(const f32x4*)(bp + bj * HALF + 4 * n);
#pragma unroll
        for (int ai = 0; ai < 2; ++ai)
#pragma unroll
            for (int m = 0; m < 4; ++m) { const int rl = rl0 + ai * HALF + m * 16; const float gw = (u.lt * BM + rl < n_e) ? rw[rl] : 0.f;
                bf16* rowp = DOWN + (size_t)(u.pm * BM + rl) * D + col0;
#pragma unroll
                for (int bj = 0; bj < 2; ++bj) *(u32x4*)(rowp + bj * HALF) = pack8((acc[ai][bj][m][0] + bv[bj][0]) * gw, (acc[ai][bj][m][1] + bv[bj][1]) * gw); }
    }
};
}
__device__ __forceinline__ void unpack8(u32x4 w, f32x4& a, f32x4& b) { pg8::unpack8(w, a, b); }

struct Params { const float* in[38]; float* out; unsigned char* ws; int ph_lo, ph_hi; };
enum { I_X = 0, I_C, I_CTX, I_CCTX, I_WADA, I_BADA, I_WIN, I_BIN, I_SMU, I_CONVW, I_CONVB, I_CLNG, I_CLNB, I_WCO, I_BCO, I_W0, I_W2, I_A0, I_A2, I_G2,
       I_KK, I_KA, I_RK, I_LNXG, I_LNXB, I_WRO, I_WOUT, I_BOUT, I_LN1G, I_LN1B, I_WROUTER, I_BROUTER, I_WGU, I_BGU, I_WDN, I_BDN, I_LN2G, I_LN2B };

struct Ctx { LAS unsigned char* lds; int tid, lane, wave, G, bid, gw, NGW; };

__device__ __forceinline__ void cvt_item(const float* W, int N, int K, int k0, int n0, bf16* WT, int drow0, int lane) {
    const int ko = lane & 7, ng = lane >> 3;
    const float* src = W + (size_t)(k0 + 8 * ko) * N + n0 + 4 * ng;
    f32x4 v[8];
#pragma unroll
    for (int j = 0; j < 8; ++j) v[j] = *(const f32x4*)(src + (size_t)j * N);
#pragma unroll
    for (int jn = 0; jn < 4; ++jn) { u32x4 o; o.x = cvt_pk_bf16(v[0][jn], v[1][jn]); o.y = cvt_pk_bf16(v[2][jn], v[3][jn]); o.z = cvt_pk_bf16(v[4][jn], v[5][jn]); o.w = cvt_pk_bf16(v[6][jn], v[7][jn]);
        *(u32x4*)(WT + (size_t)(drow0 + 4 * ng + jn) * K + k0 + 8 * ko) = o; }
}
__device__ __forceinline__ void cvt8_item(const float* W, int N, int k0, int n0, unsigned char* WT, int pitch, int drow0, int lane) {
    const int ko = lane & 7, ng = lane >> 3;
    const float* src = W + (size_t)(k0 + 16 * ko) * N + n0 + 4 * ng;
    f32x4 v[16];
#pragma unroll
    for (int j = 0; j < 16; ++j) v[j] = *(const f32x4*)(src + (size_t)j * N) * W8_SCALE;
#pragma unroll
    for (int jn = 0; jn < 4; ++jn) { u32x4 o; o.x = pk_fp8x4(v[0][jn], v[1][jn], v[2][jn], v[3][jn]); o.y = pk_fp8x4(v[4][jn], v[5][jn], v[6][jn], v[7][jn]);
        o.z = pk_fp8x4(v[8][jn], v[9][jn], v[10][jn], v[11][jn]); o.w = pk_fp8x4(v[12][jn], v[13][jn], v[14][jn], v[15][jn]);
        *(u32x4*)(WT + (size_t)(drow0 + 4 * ng + jn) * pitch + k0 + 16 * ko) = o; }
}
__device__ __forceinline__ void p0_convert(const Params& p, const Ctx& c) {
    unsigned char* ws = p.ws;
    constexpr int I_IN = 16 * 301, I_CO = 16 * 64, I_RO = 16 * 64, I_OUT = 32 * 64;
    constexpr int NITEMS = I_IN + I_CO + I_RO + I_OUT;
    for (int it = c.gw; it < NITEMS; it += c.NGW) {
        int r = it;
        if (r < I_IN) { const int kb = r / 301, nb = r % 301, n0 = 32 * nb; cvt8_item(p.in[I_WIN], PIN, 128 * kb, n0, ws + WS_WIN, D, n0 < 5536 ? n0 : n0 + 96, c.lane); continue; } r -= I_IN;
        if (r < I_CO) { const int kb = r / 64, nb = r % 64; cvt_item(p.in[I_WCO], D, DCV, 64 * kb, 32 * nb, (bf16*)(ws + WS_WCO), 32 * nb, c.lane); continue; } r -= I_CO;
        if (r < I_RO) { const int kb = r / 64, nb = r % 64; cvt_item(p.in[I_WRO], D, DR, 64 * kb, 32 * nb, (bf16*)(ws + WS_WRO), 32 * nb, c.lane); continue; } r -= I_RO;
        { const int kb = r / 64, nb = r % 64; cvt_item(p.in[I_WOUT], D, D, 64 * kb, 32 * nb, (bf16*)(ws + WS_WOUT), 32 * nb, c.lane); }
    }
}
struct CvtAddr { const float* src; unsigned char* dst; int N; };
__device__ __forceinline__ CvtAddr moe_cvt_addr(const Params& p, int it, int lane) {
    constexpr int I_GU1 = 16 * 128, I_GU = NE * I_GU1, I_DN1 = 16 * 64;
    const int ko = lane & 7, ng = lane >> 3; CvtAddr a;
    if (it < I_GU) { const int e = it / I_GU1, q = it % I_GU1, kb = q / 128, nb = q % 128, n0 = 32 * nb; const int nn = n0 & 2047;
        const int drow = (nn >> 7) * 256 + (n0 >= 2048 ? 128 : 0) + (nn & 127);
        a.N = 4096; a.src = p.in[I_WGU] + (size_t)e * D * 4096 + (size_t)(128 * kb + 16 * ko) * 4096 + n0 + 4 * ng;
        a.dst = p.ws + WS_WGU + (size_t)e * 4096 * D + (size_t)(drow + 4 * ng) * D + 128 * kb + 16 * ko; }
    else { const int r = it - I_GU; const int e = r / I_DN1, q = r % I_DN1, kb = q / 64, nb = q % 64;
        a.N = D; a.src = p.in[I_WDN] + (size_t)e * D * D + (size_t)(128 * kb + 16 * ko) * D + 32 * nb + 4 * ng;
        a.dst = p.ws + WS_WDN + (size_t)e * D * D + (size_t)(32 * nb + 4 * ng) * D + 128 * kb + 16 * ko; }
    return a;
}
__device__ __forceinline__ void moe_cvt_load(const CvtAddr& a, f32x4 (&v)[16]) {
#pragma unroll
    for (int j = 0; j < 16; ++j) v[j] = __builtin_nontemporal_load((const f32x4*)(a.src + (size_t)j * a.N));
}
__device__ __forceinline__ void moe_cvt_store(const CvtAddr& a, const f32x4 (&v)[16]) {
#pragma unroll
    for (int jn = 0; jn < 4; ++jn) { u32x4 o;
        o.x = pk_fp8x4(v[0][jn] * W8_SCALE, v[1][jn] * W8_SCALE, v[2][jn] * W8_SCALE, v[3][jn] * W8_SCALE); o.y = pk_fp8x4(v[4][jn] * W8_SCALE, v[5][jn] * W8_SCALE, v[6][jn] * W8_SCALE, v[7][jn] * W8_SCALE);
        o.z = pk_fp8x4(v[8][jn] * W8_SCALE, v[9][jn] * W8_SCALE, v[10][jn] * W8_SCALE, v[11][jn] * W8_SCALE); o.w = pk_fp8x4(v[12][jn] * W8_SCALE, v[13][jn] * W8_SCALE, v[14][jn] * W8_SCALE, v[15][jn] * W8_SCALE);
        *(u32x4*)(a.dst + (size_t)jn * D) = o; }
}
__device__ __forceinline__ void moe_convert(const Params& p, int wi, int nw, int lane) {
    constexpr int NIT = NE * (16 * 128 + 16 * 64);
    f32x4 va[16], vb[16];
    int it = wi; if (it >= NIT) return;
    CvtAddr aa = moe_cvt_addr(p, it, lane), ab = aa; moe_cvt_load(aa, va);
    for (;;) {
        const int i1 = it + nw; ab = moe_cvt_addr(p, i1 < NIT ? i1 : NIT - 1, lane); moe_cvt_load(ab, vb);
        moe_cvt_store(aa, va); if (i1 >= NIT) break;
        const int i2 = i1 + nw; aa = moe_cvt_addr(p, i2 < NIT ? i2 : NIT - 1, lane); moe_cvt_load(aa, va);
        moe_cvt_store(ab, vb); if (i2 >= NIT) break;
        it = i2;
    }
}
__device__ __forceinline__ void p0_small(const Params& p, const Ctx& c) {
    unsigned char* ws = p.ws;
    const int gt = c.bid * 512 + c.tid, NT = c.G * 512;
    bf16* WL = (bf16*)(ws + WS_WLORA);
    for (int t = gt; t < LORA_N * (LORA_K / 8); t += NT) {
        const int n = t / (LORA_K / 8), k0 = (t % (LORA_K / 8)) * 8, g = n >> 10, ch = n & 1023; float v[8];
#pragma unroll
        for (int j = 0; j < 8; ++j) { const int k = k0 + j; float x = 0.f;
            if (g < 4) { if (k >= 64 * g && k < 64 * g + 64) { const float* src = (g < 2) ? p.in[I_W2] : p.in[I_A2]; x = src[((size_t)(g & 1) * 64 + (k - 64 * g)) * DR + ch]; } }
            else { if (k >= 256 && k < 416) x = p.in[I_G2][(size_t)(k - 256) * DR + ch]; }
            v[j] = x; }
        u32x4 o; o.x = cvt_pk_bf16(v[0], v[1]); o.y = cvt_pk_bf16(v[2], v[3]); o.z = cvt_pk_bf16(v[4], v[5]); o.w = cvt_pk_bf16(v[6], v[7]);
        *(u32x4*)(WL + (size_t)n * LORA_K + k0) = o;
    }
    bf16* WRt = (bf16*)(ws + WS_WR);
    for (int t = gt; t < NE * D; t += NT) { const int e = t / D, k = t % D; const float w = p.in[I_WROUTER][(size_t)k * NE + e]; const unsigned hi = f2bf(w); const float lo = w - bflo(hi);
        WRt[t] = (bf16)hi; WRt[NE * D + t] = (bf16)f2bf(lo); }
    float* bin = (float*)(ws + WS_BIN);
    for (int t = gt; t < ZN; t += NT) bin[t] = t < 5536 ? p.in[I_BIN][t] : (t < ZG0 ? 0.f : p.in[I_BIN][t - 96]);
    float* bgu = (float*)(ws + WS_BGU);
    for (int t = gt; t < NE * 4096; t += NT) { const int e = t >> 12, q = t & 4095, pn = q >> 8, rr = q & 255; bgu[t] = p.in[I_BGU][(size_t)e * 4096 + (rr < 128 ? 128 * pn + rr : 2048 + 128 * pn + rr - 128)]; }
    unsigned char* WI = ws + WS_WIN;
    for (int t = gt; t < 96 * D / 16; t += NT) *(u32x4*)(WI + (size_t)5536 * D + (size_t)t * 16) = (u32x4){0u, 0u, 0u, 0u};
}
__device__ __forceinline__ void p0_adaln(const Params& p, const Ctx& c) {
    LAS float* act = (LAS float*)c.lds; LAS float* red = (LAS float*)(c.lds + 73728);
    for (int i = c.tid; i < 9 * D; i += 512) { const int r = i / D, k = i % D; const float v = r < 8 ? p.in[I_C][r * D + k] : p.in[I_CCTX][k]; act[i] = v * sigm(v); }
    __syncthreads();
    const int cg = c.tid & 15, ks = c.tid >> 4;
    float* mod = (float*)(p.ws + WS_MOD);
    for (int u = c.bid; u < 192; u += c.G) {
        f32x4 acc[9];
#pragma unroll
        for (int r = 0; r < 9; ++r) acc[r] = (f32x4){0.f, 0.f, 0.f, 0.f};
        const float* wp = p.in[I_WADA] + 64 * u + 4 * cg;
#pragma unroll 4
        for (int k = ks; k < D; k += 32) { const f32x4 w = *(const f32x4*)(wp + (size_t)k * (6 * D));
#pragma unroll
            for (int r = 0; r < 9; ++r) acc[r] += w * act[r * D + k]; }
#pragma unroll
        for (int r = 0; r < 9; ++r)
#pragma unroll
            for (int j = 0; j < 4; ++j) { float v = acc[r][j]; v += __shfl_xor(v, 16); v += __shfl_xor(v, 32); acc[r][j] = v; }
        if (c.lane < 16) {
#pragma unroll
            for (int r = 0; r < 9; ++r) *(LAS f32x4*)(red + (c.wave * 9 + r) * 64 + 4 * cg) = acc[r]; }
        __syncthreads();
        for (int i = c.tid; i < 9 * 64; i += 512) { const int r = i / 64, col = i % 64; float s = 0.f;
#pragma unroll
            for (int w = 0; w < 8; ++w) s += red[(w * 9 + r) * 64 + col];
            mod[r * (6 * D) + 64 * u + col] = s + p.in[I_BADA][64 * u + col]; }
        __syncthreads();
    }
}

__device__ __forceinline__ void p1_modulate(const Params& p, const Ctx& c) {
    const float* mod = (const float*)(p.ws + WS_MOD); unsigned char* U = p.ws + WS_U;
    for (int row = c.gw; row < TT; row += c.NGW) {
        const float* src = row < TL ? p.in[I_X] + (size_t)row * D : p.in[I_CTX] + (size_t)(row - TL) * D;
        const int b = row < TL ? row / SEQ : 8;
        const float* sh = mod + (size_t)b * (6 * D); const float* sc = sh + D;
        f32x4 v[8]; float s = 0.f;
#pragma unroll
        for (int j = 0; j < 8; ++j) { v[j] = *(const f32x4*)(src + 4 * c.lane + 256 * j); s += (v[j][0] + v[j][1]) + (v[j][2] + v[j][3]); }
        const float mean = wave_sum(s) * (1.f / D); float s2 = 0.f;
#pragma unroll
        for (int j = 0; j < 8; ++j) { v[j] = v[j] - mean; s2 += (v[j][0] * v[j][0] + v[j][1] * v[j][1]) + (v[j][2] * v[j][2] + v[j][3] * v[j][3]); }
        const float rstd = __builtin_amdgcn_rsqf(wave_sum(s2) * (1.f / D) + LN_EPS);
#pragma unroll
        for (int j = 0; j < 8; ++j) { const int col = 4 * c.lane + 256 * j; const f32x4 a = *(const f32x4*)(sc + col), bb = *(const f32x4*)(sh + col);
            const f32x4 o = v[j] * rstd * (a + 1.0f) + bb;
            *(unsigned*)(U + (size_t)row * D + col) = pk_fp8x4(o[0], o[1], o[2], o[3]); }
    }
}

__device__ __forceinline__ void p3_conv(const Params& p, const Ctx& c) {
    const bf16* ZL = (const bf16*)(p.ws + WS_ZL); bf16* AC = (bf16*)(p.ws + WS_ACONV);
    LAS unsigned* tile = (LAS unsigned*)c.lds;
    for (int gr = c.bid; gr < TL / 64; gr += c.G) {
        const int row0 = gr * 64, c0 = 2 * c.tid;
#pragma unroll 4
        for (int i = 0; i < 16; ++i) { const int ch = c.tid + 512 * i, t = ch >> 7, cg = ch & 127;
            f32x4 a0, a1, g0, g1; unpack8(*(const u32x4*)(ZL + (size_t)(row0 + t) * ZN + 8 * cg), a0, a1); unpack8(*(const u32x4*)(ZL + (size_t)(row0 + t) * ZN + DCV + 8 * cg), g0, g1);
            *(LAS u32x4*)(tile + t * 512 + 4 * cg) = pg8::pack8(a0 * pg8::sig4(g0), a1 * pg8::sig4(g1)); }
        __syncthreads();
#pragma unroll 1
        for (int cc = 0; cc < 2; ++cc) {
            float w[CWID];
#pragma unroll
            for (int j = 0; j < CWID; ++j) w[j] = p.in[I_CONVW][j * DCV + c0 + cc];
            const float cb = p.in[I_CONVB][c0 + cc];
            float h[64];
#pragma unroll
            for (int t = 0; t < 64; ++t) { const unsigned a = tile[t * 512 + c.tid]; h[t] = cc ? bfhi(a) : bflo(a); }
#pragma clang loop unroll(full)
            for (int t = 0; t < 64; ++t) { float a = cb;
#pragma clang loop unroll(full)
                for (int j = 0; j < CWID; ++j) { const int tt = t + j - CWID / 2; if (tt >= 0 && tt < 64) a += w[j] * h[tt]; }
                ((LAS bf16*)tile)[t * DCV + c0 + cc] = (bf16)f2bf(a); }
        }
        __syncthreads();
        f32x4 g[4], bb[4];
#pragma unroll
        for (int q = 0; q < 4; ++q) { g[q] = *(const f32x4*)(p.in[I_CLNG] + 16 * c.lane + 4 * q); bb[q] = *(const f32x4*)(p.in[I_CLNB] + 16 * c.lane + 4 * q); }
#pragma unroll 2
        for (int i = 0; i < 8; ++i) { const int t = c.wave * 8 + i;
            const u32x4 r0 = *(const LAS u32x4*)(tile + t * 512 + 8 * c.lane), r1 = *(const LAS u32x4*)(tile + t * 512 + 8 * c.lane + 4);
            f32x4 v[4]; unpack8(r0, v[0], v[1]); unpack8(r1, v[2], v[3]);
            float s = 0.f;
#pragma unroll
            for (int q = 0; q < 4; ++q) s += (v[q][0] + v[q][1]) + (v[q][2] + v[q][3]);
            const float mean = wave_sum(s) * (1.f / DCV); float s2 = 0.f;
#pragma unroll
            for (int q = 0; q < 4; ++q) { v[q] = v[q] - mean; s2 += (v[q][0] * v[q][0] + v[q][1] * v[q][1]) + (v[q][2] * v[q][2] + v[q][3] * v[q][3]); }
            const float rstd = __builtin_amdgcn_rsqf(wave_sum(s2) * (1.f / DCV) + LN_EPS);
#pragma unroll
            for (int q = 0; q < 4; ++q) { v[q] = v[q] * rstd * g[q] + bb[q];
#pragma unroll
                for (int j = 0; j < 4; ++j) v[q][j] = v[q][j] * sigm(v[q][j]); }
            bf16* o = AC + (size_t)(row0 + t) * DCV + 16 * c.lane;
            *(u32x4*)o = pg8::pack8(v[0], v[1]); *(u32x4*)(o + 8) = pg8::pack8(v[2], v[3]); }
        __syncthreads();
    }
}
__device__ __forceinline__ void p3_alora(const Params& p, const Ctx& c) {
    const bf16* ZL = (const bf16*)(p.ws + WS_ZL); const bf16* ZC = (const bf16*)(p.ws + WS_ZC); bf16* AL = (bf16*)(p.ws + WS_ALORA);
    const float* mu = p.in[I_SMU];
    for (int row = c.gw; row < TT; row += c.NGW) {
        const bool lat = row < TL; const int pitch = lat ? ZN : ZCN; const int len = lat ? SEQ : CTXL; const int t = lat ? row % SEQ : (row - TL) % CTXL;
        const bf16* zp = lat ? ZL + (size_t)row * ZN + ZR0 : ZC + (size_t)(row - TL) * ZCN;
        const bool hp = t > 0, hn = t < len - 1; const int po = hp ? pitch : 0, no = hn ? pitch : 0; const float mp = hp ? 1.f : 0.f, mn = hn ? 1.f : 0.f;
#pragma unroll
        for (int i = 0; i < 8; ++i) { const int j = c.lane + 64 * i; float o = 0.f;
            if (j < 416) { const int col = 3072 + j; const float z = bf1(zp[col]); const float pv = mp * bf1(zp[col - po]), nv = mn * bf1(zp[col + no]);
                const float zs = z + mu[col] * (pv - z) + mu[DSHIFT + col] * (nv - z);
                o = j < 128 ? (1.f - 2.f * __builtin_amdgcn_rcpf(__expf(2.f * zs) + 1.f)) : (j < 256 ? zs : sigm(zs)); }
            AL[(size_t)row * LORA_K + j] = (bf16)f2bf(o); }
    }
}

__device__ __forceinline__ void p5_prep(const Params& p, const Ctx& c) {
    const bf16* ZL = (const bf16*)(p.ws + WS_ZL); const bf16* ZC = (const bf16*)(p.ws + WS_ZC); const bf16* LO = (const bf16*)(p.ws + WS_LORA);
    unsigned char* SC = p.ws + WS_SC2; bf16* VS = (bf16*)(p.ws + WS_VS); float* RK = (float*)(p.ws + WS_RK);
    const float* mu = p.in[I_SMU];
    for (int it = c.gw; it < NB * NH * NCHUNK; it += c.NGW) {
        const int m = it % NCHUNK, bh = it / NCHUNK, h = bh % NH, b = bh / NH, hc = h * HS + c.lane;
        const bool lat = m >= 16; const int pitch = lat ? ZN : ZCN, len = lat ? SEQ : CTXL, t0 = lat ? (m - 16) * 16 : m * 16;
        const size_t rowbase = lat ? (size_t)b * SEQ + t0 : (size_t)b * CTXL + t0;
        const bf16* zp = lat ? ZL + rowbase * ZN + ZR0 : ZC + rowbase * ZCN;
        const size_t lrow = lat ? rowbase : (size_t)TL + rowbase;
        const float mpr = mu[hc], mnr = mu[DSHIFT + hc], mpk = mu[DR + hc], mnk = mu[DSHIFT + DR + hc], mpv = mu[2 * DR + hc], mnv = mu[DSHIFT + 2 * DR + hc];
        const float kk_ = p.in[I_KK][hc], ka_ = p.in[I_KA][hc], rk_ = p.in[I_RK][hc];
        const float w00 = p.in[I_W0][hc], w01 = p.in[I_W0][DR + hc], a00 = p.in[I_A0][hc], a01 = p.in[I_A0][DR + hc];
        float* rec0 = (float*)(SC + ((size_t)(bh * 2 + 0) * NCHUNK + m) * SBUF) + c.lane;
        float* rec1 = (float*)(SC + ((size_t)(bh * 2 + 1) * NCHUNK + (lat ? 159 - m : 15 - m)) * SBUF) + c.lane;
        float zr[18], zk[18], zv[18];
#pragma unroll
        for (int i = 0; i < 18; ++i) { const int t = t0 - 1 + i; const bool ok = t >= 0 && t < len; const int tc = t < 0 ? 0 : (t >= len ? len - 1 : t); const float msk = ok ? 1.f : 0.f;
            const bf16* q = zp + (ptrdiff_t)(tc - t0) * pitch;
            zr[i] = msk * bf1(q[hc]); zk[i] = msk * bf1(q[DR + hc]); zv[i] = msk * bf1(q[2 * DR + hc]); }
        float s_r[16], s_v[16], s_na[16], s_w[16], s_b[16], s_kd[16];
        bf16 lw0[16], lw1[16], la0[16], la1[16];
#pragma unroll
        for (int i = 0; i < 16; ++i) { const bf16* lp = LO + (lrow + i) * LORA_N + hc; lw0[i] = lp[0]; lw1[i] = lp[DR]; la0[i] = lp[2 * DR]; la1[i] = lp[3 * DR]; }
        float gam = 1.f;
#pragma unroll
        for (int i = 0; i < 16; ++i) {
            const float r = zr[i + 1] + mpr * (zr[i] - zr[i + 1]) + mnr * (zr[i + 2] - zr[i + 1]);
            const float k = zk[i + 1] + mpk * (zk[i] - zk[i + 1]) + mnk * (zk[i + 2] - zk[i + 1]);
            const float v = zv[i + 1] + mpv * (zv[i] - zv[i + 1]) + mnv * (zv[i + 2] - zv[i + 1]);
            const float kr = k * kk_; const float nrm = sqrtf(wave_sum(kr * kr)); const float kk = kr / fmaxf(nrm, 1e-12f);
            const float wl0 = bf1(lw0[i]), wl1 = bf1(lw1[i]), al0 = bf1(la0[i]), al1 = bf1(la1[i]);
            const float aa0 = sigm(a00 + al0), aa1 = sigm(a01 + al1);
            const float w0 = __expf(-0.6065306597f * sigm(w00 + wl0)), w1 = __expf(-0.6065306597f * sigm(w01 + wl1));
            const float kd0 = k * (1.f + (aa0 - 1.f) * ka_), kd1 = k * (1.f + (aa1 - 1.f) * ka_);
            s_r[i] = r; s_v[i] = v; s_na[i] = -kk; s_w[i] = w1; s_b[i] = kk * aa1; s_kd[i] = kd1;
            { const float gprev = gam; gam *= w0; const float inv = __builtin_amdgcn_rcpf(gam); float* o = rec0 + i * 320;
              o[0] = gprev * -kk; o[64] = kk * aa0 * inv; o[128] = kd0 * inv; o[192] = gam * r; o[256] = v; }
            if (lat) { const float s = wave_sum(r * (kd0 + kd1) * rk_); if (c.lane == 0) RK[(rowbase + i) * NH + h] = s;
                VS[(rowbase + i) * DR + hc] = (bf16)f2bf(v); }
        }
        rec0[SCH * 320] = gam;
        gam = 1.f;
#pragma unroll
        for (int s = 0; s < 16; ++s) { const int i = 15 - s;
            const float gprev = gam; gam *= s_w[i]; const float inv = __builtin_amdgcn_rcpf(gam); float* o = rec1 + s * 320;
            o[0] = gprev * s_na[i]; o[64] = s_b[i] * inv; o[128] = s_kd[i] * inv; o[192] = gam * s_r[i]; o[256] = s_v[i]; }
        rec1[SCH * 320] = gam;
    }
}

constexpr int SNB = 6, SLOT = SBUF + 768, S_FULL = LX_MISC + 64, S_DONE = LX_MISC + 128;
static_assert(SNB * SLOT <= RING_BYTES, "scan ring");
__device__ __forceinline__ float dpp_xor1(float x) { return __builtin_bit_cast(float, __builtin_amdgcn_update_dpp(0, __builtin_bit_cast(int, x), 0xB1, 0xf, 0xf, true)); }
__device__ __forceinline__ float dpp_xor2(float x) { return __builtin_bit_cast(float, __builtin_amdgcn_update_dpp(0, __builtin_bit_cast(int, x), 0x4E, 0xf, 0xf, true)); }
__device__ __forceinline__ float dpp_hmir(float x) { return __builtin_bit_cast(float, __builtin_amdgcn_update_dpp(0, __builtin_bit_cast(int, x), 0x141, 0xf, 0xf, true)); }
__device__ __forceinline__ float red8(float x) { x += dpp_xor1(x); x += dpp_xor2(x); x += dpp_hmir(x); return x; }
struct ScanCoef { f32x4 a0, a1, b0, b1, k0, k1, r0, r1; f32x2 vv; };
__device__ __forceinline__ ScanCoef scan_ld(const LAS unsigned char* sb, const LAS unsigned char* vb) {
    ScanCoef o; o.a0 = *(const LAS f32x4*)(sb); o.a1 = *(const LAS f32x4*)(sb + 16); o.b0 = *(const LAS f32x4*)(sb + 256); o.b1 = *(const LAS f32x4*)(sb + 272);
    o.k0 = *(const LAS f32x4*)(sb + 512); o.k1 = *(const LAS f32x4*)(sb + 528); o.r0 = *(const LAS f32x4*)(sb + 768); o.r1 = *(const LAS f32x4*)(sb + 784);
    o.vv = *(const LAS f32x2*)(vb); return o;
}
__device__ __forceinline__ void p6_scan(const Params& p, const Ctx& c) {
    LAS unsigned char* L = c.lds; volatile LAS unsigned* full = (volatile LAS unsigned*)(L + S_FULL); volatile LAS unsigned* done = (volatile LAS unsigned*)(L + S_DONE);
    float* Y = (float*)(p.ws + WS_Y);
    for (int sid = c.bid; sid < NB * NH * 2; sid += c.G) {
        if (c.tid < 8) { full[c.tid] = 0u; done[c.tid] = 0u; }
        __syncthreads();
        const int d = sid & 1, bh = sid >> 1, h = bh % NH, b = bh / NH;
        if (c.wave == 4) {
            const unsigned char* src = p.ws + WS_SC2 + (size_t)sid * NCHUNK * SBUF + 16 * c.lane;
            __builtin_amdgcn_s_setprio(2);
            for (int ch = 0; ch < NCHUNK; ++ch) {
                const int buf = ch % SNB;
                if (ch >= SNB) { const unsigned want = 4u * (unsigned)(ch / SNB); unsigned sp = 0; while (done[buf] < want) { __builtin_amdgcn_s_sleep(1); if (++sp > (1u << 24)) break; } }
                const unsigned char* g = src + (size_t)ch * SBUF; LAS unsigned char* dl = L + buf * SLOT;
#pragma unroll
                for (int i = 0; i < 20; ++i) __builtin_amdgcn_global_load_lds((const unsigned*)(g + i * 1024), (LAS unsigned*)(dl + i * 1024), 16, 0, 0);
                if (c.lane < 16) __builtin_amdgcn_global_load_lds((const unsigned*)(g + 20480), (LAS unsigned*)(dl + 20480), 16, 0, 0);
                if (ch >= 3) { asm volatile("s_waitcnt vmcnt(63)" ::: "memory"); if (c.lane == 0) full[(ch - 3) % SNB] = (unsigned)(ch - 2); }
            }
            asm volatile("s_waitcnt vmcnt(42)" ::: "memory"); if (c.lane == 0) full[(NCHUNK - 3) % SNB] = (unsigned)(NCHUNK - 2);
            asm volatile("s_waitcnt vmcnt(21)" ::: "memory"); if (c.lane == 0) full[(NCHUNK - 2) % SNB] = (unsigned)(NCHUNK - 1);
            asm volatile("s_waitcnt vmcnt(0)" ::: "memory"); if (c.lane == 0) full[(NCHUNK - 1) % SNB] = (unsigned)NCHUNK;
            __builtin_amdgcn_s_setprio(0);
        } else if (c.wave < 4) {
            const int vp = c.lane >> 3, q = c.lane & 7, v0 = 16 * c.wave + 2 * vp;
            __builtin_amdgcn_s_setprio(2);
            f32x2 S0[4], S1[4];
#pragma unroll
            for (int j = 0; j < 4; ++j) { S0[j] = (f32x2){0.f, 0.f}; S1[j] = (f32x2){0.f, 0.f}; }
            float* yp = Y + ((size_t)d * TL + (size_t)b * SEQ + (d ? SEQ - 1 : 0)) * DR + h * HS + v0; const ptrdiff_t ystep = d ? -(ptrdiff_t)DR : (ptrdiff_t)DR;
            for (int ch = 0; ch < NCHUNK; ++ch) {
                const int buf = ch % SNB; { unsigned sp = 0; while (full[buf] != (unsigned)(ch + 1)) { __builtin_amdgcn_s_sleep(1); if (++sp > (1u << 24)) break; } }
                const LAS unsigned char* base = L + buf * SLOT; const LAS unsigned char* sb = base + 32 * q; const LAS unsigned char* vb = base + 1024 + 4 * v0;
                const bool lat = ch >= CTXL / SCH;
                ScanCoef cur = scan_ld(sb, vb);
#pragma unroll 2
                for (int s = 0; s < SCH; ++s) {
                    const int sn = (s + 1 < SCH) ? s + 1 : s;
                    const ScanCoef nx = scan_ld(sb + sn * 1280, vb + sn * 1280);
                    const f32x2 A[4] = {cur.a0.xy, cur.a0.zw, cur.a1.xy, cur.a1.zw}, Bc[4] = {cur.b0.xy, cur.b0.zw, cur.b1.xy, cur.b1.zw};
                    const f32x2 Kc[4] = {cur.k0.xy, cur.k0.zw, cur.k1.xy, cur.k1.zw}, Rc[4] = {cur.r0.xy, cur.r0.zw, cur.r1.xy, cur.r1.zw};
                    f32x2 q0 = S0[0] * A[0], q1 = S1[0] * A[0];
#pragma unroll
                    for (int j = 1; j < 4; ++j) { q0 = __builtin_elementwise_fma(S0[j], A[j], q0); q1 = __builtin_elementwise_fma(S1[j], A[j], q1); }
                    const float p0 = red8(q0.x + q0.y), p1 = red8(q1.x + q1.y);
                    const f32x2 pp0 = (f32x2){p0, p0}, pp1 = (f32x2){p1, p1}, vv0 = (f32x2){cur.vv.x, cur.vv.x}, vv1 = (f32x2){cur.vv.y, cur.vv.y};
#pragma unroll
                    for (int j = 0; j < 4; ++j) { S0[j] = __builtin_elementwise_fma(pp0, Bc[j], __builtin_elementwise_fma(vv0, Kc[j], S0[j])); S1[j] = __builtin_elementwise_fma(pp1, Bc[j], __builtin_elementwise_fma(vv1, Kc[j], S1[j])); }
                    if (lat) { f32x2 y0 = S0[0] * Rc[0], y1 = S1[0] * Rc[0];
#pragma unroll
                        for (int j = 1; j < 4; ++j) { y0 = __builtin_elementwise_fma(S0[j], Rc[j], y0); y1 = __builtin_elementwise_fma(S1[j], Rc[j], y1); }
                        const float z0 = red8(y0.x + y0.y), z1 = red8(y1.x + y1.y);
                        if (q == 0) *(f32x2*)yp = (f32x2){z0, z1};
                        yp += ystep; }
                    cur = nx;
                }
                const f32x4 g0 = *(const LAS f32x4*)(base + SCH * 1280 + 32 * q), g1 = *(const LAS f32x4*)(base + SCH * 1280 + 32 * q + 16);
                const f32x2 Gm[4] = {g0.xy, g0.zw, g1.xy, g1.zw};
#pragma unroll
                for (int j = 0; j < 4; ++j) { S0[j] *= Gm[j]; S1[j] *= Gm[j]; }
                asm volatile("s_waitcnt lgkmcnt(0)" ::: "memory");
                if (c.lane == 0) __hip_atomic_fetch_add((LAS unsigned*)(L + S_DONE) + buf, 1u, __ATOMIC_RELAXED, __HIP_MEMORY_SCOPE_WORKGROUP);
            }
            __builtin_amdgcn_s_setprio(0);
        } else if (CONV_IN_SCAN && sid == c.bid) {
            moe_convert(p, c.bid * 3 + (c.wave - 5), c.G * 3, c.lane);
        }
        __syncthreads();
    }
}

__device__ __forceinline__ void p7_rwkvout(const Params& p, const Ctx& c) {
    const float* Y = (const float*)(p.ws + WS_Y); const float* RK = (const float*)(p.ws + WS_RK); const bf16* VS = (const bf16*)(p.ws + WS_VS);
    const bf16* LO = (const bf16*)(p.ws + WS_LORA); bf16* AR = (bf16*)(p.ws + WS_ARWKV);
    const int c0 = 16 * c.lane, hd = c.lane >> 2;
    f32x4 g[4], bb[4];
#pragma unroll
    for (int q = 0; q < 4; ++q) { g[q] = *(const f32x4*)(p.in[I_LNXG] + c0 + 4 * q); bb[q] = *(const f32x4*)(p.in[I_LNXB] + c0 + 4 * q); }
    for (int row = c.gw; row < TL; row += c.NGW) {
        f32x4 y[4]; float s = 0.f;
#pragma unroll
        for (int q = 0; q < 4; ++q) { y[q] = *(const f32x4*)(Y + (size_t)row * DR + c0 + 4 * q) + *(const f32x4*)(Y + ((size_t)TL + row) * DR + c0 + 4 * q); s += (y[q][0] + y[q][1]) + (y[q][2] + y[q][3]); }
        s += __shfl_xor(s, 1); s += __shfl_xor(s, 2); const float mean = s * (1.f / HS); float s2 = 0.f;
#pragma unroll
        for (int q = 0; q < 4; ++q) { y[q] = y[q] - mean; s2 += (y[q][0] * y[q][0] + y[q][1] * y[q][1]) + (y[q][2] * y[q][2] + y[q][3] * y[q][3]); }
        s2 += __shfl_xor(s2, 1); s2 += __shfl_xor(s2, 2); const float rstd = __builtin_amdgcn_rsqf(s2 * (1.f / HS) + GN_EPS);
        const float rk = RK[(size_t)row * NH + hd];
        f32x4 v[4], gt[4];
        unpack8(*(const u32x4*)(VS + (size_t)row * DR + c0), v[0], v[1]); unpack8(*(const u32x4*)(VS + (size_t)row * DR + c0 + 8), v[2], v[3]);
        unpack8(*(const u32x4*)(LO + (size_t)row * LORA_N + 4 * DR + c0), gt[0], gt[1]); unpack8(*(const u32x4*)(LO + (size_t)row * LORA_N + 4 * DR + c0 + 8), gt[2], gt[3]);
#pragma unroll
        for (int q = 0; q < 4; ++q) y[q] = (y[q] * rstd * g[q] + bb[q] + v[q] * rk) * gt[q];
        bf16* o = AR + (size_t)row * DR + c0; *(u32x4*)o = pg8::pack8(y[0], y[1]); *(u32x4*)(o + 8) = pg8::pack8(y[2], y[3]);
    }
}

__device__ __forceinline__ void p10_router(const Params& p, const Ctx& c) {
    const float* T1 = (const float*)(p.ws + WS_T1); float* XM = (float*)(p.ws + WS_XMID); bf16* UH = (bf16*)(p.ws + WS_U2HI); bf16* UL = (bf16*)(p.ws + WS_U2LO);
    const float* mod = (const float*)(p.ws + WS_MOD); const bf16* WRt = (const bf16*)(p.ws + WS_WR); unsigned char* U8 = p.ws + WS_U2F8;
    unsigned* cntg = (unsigned*)(p.ws + WS_CTL) + CW_CNT; int* rowtok = (int*)(p.ws + WS_ROWTOK); float* roww = (float*)(p.ws + WS_ROWW); unsigned* sel = (unsigned*)(p.ws + WS_SEL);
    for (int un = c.bid; un < TL / 64; un += c.G) {
        const int r0 = un * 64, b = r0 / SEQ;
        const float* sh = mod + (size_t)b * (6 * D) + 3 * D; const float* sc = sh + D;
        for (int i = 0; i < 8; ++i) { const int row = r0 + c.wave * 8 + i;
            f32x4 v[8]; float s = 0.f;
#pragma unroll
            for (int j = 0; j < 8; ++j) { v[j] = *(const f32x4*)(T1 + (size_t)row * D + 4 * c.lane + 256 * j); s += (v[j][0] + v[j][1]) + (v[j][2] + v[j][3]); }
            float mean = wave_sum(s) * (1.f / D), s2 = 0.f;
#pragma unroll
            for (int j = 0; j < 8; ++j) { v[j] = v[j] - mean; s2 += (v[j][0] * v[j][0] + v[j][1] * v[j][1]) + (v[j][2] * v[j][2] + v[j][3] * v[j][3]); }
            float rstd = __builtin_amdgcn_rsqf(wave_sum(s2) * (1.f / D) + LN_EPS); s = 0.f;
#pragma unroll
            for (int j = 0; j < 8; ++j) { const int col = 4 * c.lane + 256 * j; v[j] = v[j] * rstd * *(const f32x4*)(p.in[I_LN1G] + col) + *(const f32x4*)(p.in[I_LN1B] + col);
                *(f32x4*)(XM + (size_t)row * D + col) = v[j]; s += (v[j][0] + v[j][1]) + (v[j][2] + v[j][3]); }
            mean = wave_sum(s) * (1.f / D); s2 = 0.f;
#pragma unroll
            for (int j = 0; j < 8; ++j) { v[j] = v[j] - mean; s2 += (v[j][0] * v[j][0] + v[j][1] * v[j][1]) + (v[j][2] * v[j][2] + v[j][3] * v[j][3]); }
            rstd = __builtin_amdgcn_rsqf(wave_sum(s2) * (1.f / D) + LN_EPS);
#pragma unroll
            for (int j = 0; j < 8; ++j) { const int col = 4 * c.lane + 256 * j; const f32x4 o = v[j] * rstd * (*(const f32x4*)(sc + col) + 1.0f) + *(const f32x4*)(sh + col);
                u32x2 hi; hi.x = cvt_pk_bf16(o[0], o[1]); hi.y = cvt_pk_bf16(o[2], o[3]);
                u32x2 lo; lo.x = cvt_pk_bf16(o[0] - bflo(hi.x), o[1] - bfhi(hi.x)); lo.y = cvt_pk_bf16(o[2] - bflo(hi.y), o[3] - bfhi(hi.y));
                *(u32x2*)(UH + (size_t)row * D + col) = hi; *(u32x2*)(UL + (size_t)row * D + col) = lo;
                *(unsigned*)(U8 + (size_t)row * D + col) = pk_fp8x4(o[0], o[1], o[2], o[3]); }
        }
        asm volatile("s_waitcnt vmcnt(0)" ::: "memory");
        __syncthreads();
        if (c.wave < 4) {
            const int tr = r0 + 16 * c.wave + (c.lane & 15), kq = 8 * (c.lane >> 4);
            f32x4 acc0 = (f32x4){0.f, 0.f, 0.f, 0.f}, acc1 = acc0;
            const bf16* ah = UH + (size_t)tr * D + kq; const bf16* al = UL + (size_t)tr * D + kq;
            const bf16* bh0 = WRt + (size_t)(c.lane & 15) * D + kq; const bf16* bh1 = bh0 + 16 * D; const bf16* bl0 = bh0 + NE * D; const bf16* bl1 = bl0 + 16 * D;
#pragma unroll 4
            for (int s = 0; s < D / 32; ++s) {
                const bf16x8 xh = *(const bf16x8*)(ah + 32 * s), xl = *(const bf16x8*)(al + 32 * s);
                const bf16x8 wh0 = *(const bf16x8*)(bh0 + 32 * s), wh1 = *(const bf16x8*)(bh1 + 32 * s), wl0 = *(const bf16x8*)(bl0 + 32 * s), wl1 = *(const bf16x8*)(bl1 + 32 * s);
                acc0 = __builtin_amdgcn_mfma_f32_16x16x32_bf16(xh, wh0, acc0, 0, 0, 0); acc1 = __builtin_amdgcn_mfma_f32_16x16x32_bf16(xh, wh1, acc1, 0, 0, 0);
                acc0 = __builtin_amdgcn_mfma_f32_16x16x32_bf16(xl, wh0, acc0, 0, 0, 0); acc1 = __builtin_amdgcn_mfma_f32_16x16x32_bf16(xl, wh1, acc1, 0, 0, 0);
                acc0 = __builtin_amdgcn_mfma_f32_16x16x32_bf16(xh, wl0, acc0, 0, 0, 0); acc1 = __builtin_amdgcn_mfma_f32_16x16x32_bf16(xh, wl1, acc1, 0, 0, 0);
            }
            LAS float* lg = (LAS float*)(c.lds + c.wave * 2048);
            const float br0 = p.in[I_BROUTER][c.lane & 15], br1 = p.in[I_BROUTER][16 + (c.lane & 15)];
#pragma unroll
            for (int i = 0; i < 4; ++i) { const int tk = (c.lane >> 4) * 4 + i; lg[tk * 32 + (c.lane & 15)] = acc0[i] + br0; lg[tk * 32 + 16 + (c.lane & 15)] = acc1[i] + br1; }
            asm volatile("s_waitcnt lgkmcnt(0)" ::: "memory");
            if (c.lane < 16) {
                float l[32];
#pragma unroll
                for (int q = 0; q < 8; ++q) { const f32x4 t = *(const LAS f32x4*)(lg + c.lane * 32 + 4 * q); l[4 * q] = t[0]; l[4 * q + 1] = t[1]; l[4 * q + 2] = t[2]; l[4 * q + 3] = t[3]; }
                unsigned used = 0u; float tv[4]; int ti[4];
#pragma unroll
                for (int s = 0; s < 4; ++s) { float best = -3.0e38f; int bi = 0;
#pragma unroll
                    for (int e = 0; e < 32; ++e) { const bool ok = !((used >> e) & 1u) && (l[e] > best); best = ok ? l[e] : best; bi = ok ? e : bi; }
                    used |= 1u << bi; tv[s] = best; ti[s] = bi; }
                const float e1 = __expf(tv[1] - tv[0]), e2 = __expf(tv[2] - tv[0]), e3 = __expf(tv[3] - tv[0]); const float inv = 1.f / (1.f + e1 + e2 + e3);
                const float gw[4] = {inv, e1 * inv, e2 * inv, e3 * inv};
                const int row = r0 + 16 * c.wave + c.lane;
#pragma unroll
                for (int s = 0; s < 4; ++s) { const unsigned j = __hip_atomic_fetch_add(cntg + 16 * ti[s], 1u, RLX_AGENT);
                    rowtok[(size_t)ti[s] * ECAP + j] = row; roww[(size_t)ti[s] * ECAP + j] = gw[s]; sel[row * 4 + s] = ((unsigned)ti[s] << 16) | j; }
            }
        }
        __syncthreads();
    }
}
__device__ __forceinline__ void moe_plan(const Params& p, const Ctx& c) {
    LAS int* cnt = (LAS int*)(c.lds + LX_CNT); LAS int* tst = (LAS int*)(c.lds + LX_TST); LAS unsigned char* te = (LAS unsigned char*)(c.lds + LX_TE);
    const unsigned* cntg = (const unsigned*)(p.ws + WS_CTL) + CW_CNT;
    __syncthreads();
    if (c.tid < NE) cnt[c.tid] = (int)__hip_atomic_load(cntg + 16 * c.tid, RLX_AGENT);
    __syncthreads();
    if (c.tid == 0) { int a = 0; for (int e = 0; e < NE; ++e) { tst[e] = a; a += (cnt[e] + 255) >> 8; } tst[NE] = a; }
    __syncthreads();
    if (c.tid < NE) { for (int t = tst[c.tid]; t < tst[c.tid + 1]; ++t) te[t] = (unsigned char)c.tid; }
    __syncthreads();
}
__device__ __forceinline__ void p13_final(const Params& p, const Ctx& c) {
    const float* XM = (const float*)(p.ws + WS_XMID); const bf16* DN = (const bf16*)(p.ws + WS_DOWN); const unsigned* sel = (const unsigned*)(p.ws + WS_SEL);
    const float* mod = (const float*)(p.ws + WS_MOD); const LAS int* tst = (const LAS int*)(c.lds + LX_TST);
    for (int row = c.gw; row < TL; row += c.NGW) {
        const int b = row / SEQ; const float* gate = mod + (size_t)b * (6 * D) + 5 * D;
        f32x4 a[4][2];
#pragma unroll
        for (int j = 0; j < 4; ++j) { a[j][0] = (f32x4){0.f, 0.f, 0.f, 0.f}; a[j][1] = a[j][0]; }
#pragma unroll
        for (int s = 0; s < 4; ++s) { const unsigned sv = sel[row * 4 + s]; const int e = (int)(sv >> 16), jj = (int)(sv & 0xffffu); const size_t pos = (size_t)tst[e] * 256 + jj;
#pragma unroll
            for (int j = 0; j < 4; ++j) { f32x4 x0, x1; pg8::unpack8(*(const u32x4*)(DN + pos * D + 8 * c.lane + 512 * j), x0, x1); a[j][0] += x0; a[j][1] += x1; } }
        float s = 0.f;
#pragma unroll
        for (int j = 0; j < 4; ++j)
#pragma unroll
            for (int hh = 0; hh < 2; ++hh) { const int col = 8 * c.lane + 512 * j + 4 * hh; a[j][hh] = *(const f32x4*)(XM + (size_t)row * D + col) * DN_ALPHA + *(const f32x4*)(gate + col) * a[j][hh];
                s += (a[j][hh][0] + a[j][hh][1]) + (a[j][hh][2] + a[j][hh][3]); }
        const float mean = wave_sum(s) * (1.f / D); float s2 = 0.f;
#pragma unroll
        for (int j = 0; j < 4; ++j)
#pragma unroll
            for (int hh = 0; hh < 2; ++hh) { a[j][hh] = a[j][hh] - mean; s2 += (a[j][hh][0] * a[j][hh][0] + a[j][hh][1] * a[j][hh][1]) + (a[j][hh][2] * a[j][hh][2] + a[j][hh][3] * a[j][hh][3]); }
        const float rstd = __builtin_amdgcn_rsqf(wave_sum(s2) * (1.f / D) + LN_EPS);
#pragma unroll
        for (int j = 0; j < 4; ++j)
#pragma unroll
            for (int hh = 0; hh < 2; ++hh) { const int col = 8 * c.lane + 512 * j + 4 * hh;
                *(f32x4*)(p.out + (size_t)row * D + col) = a[j][hh] * rstd * *(const f32x4*)(p.in[I_LN2G] + col) + *(const f32x4*)(p.in[I_LN2B] + col); }
    }
}

constexpr int N_PHASES = 14;
__global__ void __launch_bounds__(512, 2) fwd(Params p) {
    extern __shared__ __attribute__((aligned(16))) unsigned char lds_raw[];
    Ctx c; c.lds = (LAS unsigned char*)lds_raw; c.tid = threadIdx.x; c.lane = c.tid & 63; c.wave = __builtin_amdgcn_readfirstlane(c.tid >> 6);
    c.G = gridDim.x; c.bid = blockIdx.x; c.gw = c.bid * 8 + c.wave; c.NGW = c.G * 8;
    unsigned char* ws = p.ws;
    const int lo = p.ph_lo, hi = p.ph_hi;
    volatile LAS unsigned* MISC = (volatile LAS unsigned*)(c.lds + LX_MISC);
    if (c.tid < 64) MISC[c.tid] = 0u;
    __syncthreads();
    XcdBarrier bar; bar.bar = (unsigned*)(ws + WS_CTL) + CW_BAR; bar.x = 0; bar.st = nullptr;
    if (hi - lo > 1) bar = xcd_barrier_post((unsigned*)(ws + WS_CTL) + CW_BAR, MISC + 8);
#ifndef ONLY_PHASE
#define ONLY_PHASE -1
#endif
#define IN(k) ((ONLY_PHASE < 0 || ONLY_PHASE == (k)) && lo <= (k) && (k) < hi)
#define SEAM(k) do { if (IN(k) && IN((k) + 1)) xcd_barrier(bar); } while (0)
    LAS unsigned char* ring = c.lds;

#ifndef DUP_MASK
#define DUP_MASK 0
#endif
#define PH(k, ...) do { if (IN(k)) { __VA_ARGS__ if constexpr (((DUP_MASK) >> (k)) & 1) { if (hi - lo > 1) xcd_barrier(bar); __VA_ARGS__ } } SEAM(k); } while (0)
    PH(0, { p0_adaln(p, c); p0_small(p, c); p0_convert(p, c); if (!CONV_IN_SCAN) moe_convert(p, c.gw, c.NGW, c.lane); });
    PH(1, { p1_modulate(p, c); });
    PH(2, { pg8::InProjSched S{(const bf16*)(ws + WS_U), (const bf16*)(ws + WS_WIN), c.G, c.bid};
        pg8::EpiInProj E{(bf16*)(ws + WS_ZL), (bf16*)(ws + WS_ZC), (const float*)(ws + WS_BIN)};
        pg8::gemm_phase<pg8::EpiInProj, pg8::InProjSched, false, true>(ring, D / 2, S, E, nullptr); });
    PH(3, { p3_conv(p, c); p3_alora(p, c); });
    PH(4, {
        { pg8::PlainSched S{(const bf16*)(ws + WS_ALORA), (const bf16*)(ws + WS_WLORA), LORA_K, TT / 256, LORA_N / 256, c.G, c.bid};
          pg8::EpiBf16Plain E{(bf16*)(ws + WS_LORA), LORA_N, nullptr};
          pg8::gemm_phase<pg8::EpiBf16Plain, pg8::PlainSched, false>(ring, LORA_K, S, E, nullptr); }
        { pg8::PlainSched S{(const bf16*)(ws + WS_ACONV), (const bf16*)(ws + WS_WCO), DCV, TL / 256, D / 256, c.G, c.bid};
          pg8::EpiConvO E{(bf16*)(ws + WS_MIX), (const bf16*)(ws + WS_ZL), p.in[I_BCO]};
          pg8::gemm_phase<pg8::EpiConvO, pg8::PlainSched, false>(ring, DCV, S, E, nullptr); }
    });
    PH(5, { p5_prep(p, c); });
    PH(6, { p6_scan(p, c); });
    PH(7, { p7_rwkvout(p, c); });
    PH(8, { pg8::PlainSched S{(const bf16*)(ws + WS_ARWKV), (const bf16*)(ws + WS_WRO), DR, TL / 256, D / 256, c.G, c.bid};
        pg8::EpiRwkvO E{(bf16*)(ws + WS_MIX), (const bf16*)(ws + WS_ZL)};
        pg8::gemm_phase<pg8::EpiRwkvO, pg8::PlainSched, false>(ring, DR, S, E, nullptr); });
    PH(9, { pg8::PlainSched S{(const bf16*)(ws + WS_MIX), (const bf16*)(ws + WS_WOUT), D, TL / 256, D / 256, c.G, c.bid};
        pg8::EpiOut E{(float*)(ws + WS_T1), p.in[I_X], (const float*)(ws + WS_MOD), p.in[I_BOUT]};
        pg8::gemm_phase<pg8::EpiOut, pg8::PlainSched, false>(ring, D, S, E, nullptr); });
    PH(10, { p10_router(p, c); });
    PH(11, { moe_plan(p, c);
        pg8::MoeSched S{nullptr, (const bf16*)(ws + WS_WGU), (const int*)(ws + WS_ROWTOK), D / 2, 4096, 16, c.G, c.bid, (const LAS int*)(c.lds + LX_CNT), (const LAS int*)(c.lds + LX_TST), (const LAS unsigned char*)(c.lds + LX_TE)};
        pg8::EpiGateUp E{ws + WS_HID, (const float*)(ws + WS_BGU)};
        pg8::gemm_phase<pg8::EpiGateUp, pg8::MoeSched, true, true>(ring, D / 2, S, E, (const char*)(ws + WS_U2F8)); });
    PH(12, { moe_plan(p, c);
        pg8::MoeSched S{(const bf16*)(ws + WS_HID), (const bf16*)(ws + WS_WDN), (const int*)(ws + WS_ROWTOK), D / 2, D, 8, c.G, c.bid, (const LAS int*)(c.lds + LX_CNT), (const LAS int*)(c.lds + LX_TST), (const LAS unsigned char*)(c.lds + LX_TE)};
        pg8::EpiDown E{(bf16*)(ws + WS_DOWN), p.in[I_BDN], (const float*)(ws + WS_ROWW), (const LAS int*)(c.lds + LX_CNT)};
        pg8::gemm_phase<pg8::EpiDown, pg8::MoeSched, false, true>(ring, D / 2, S, E, nullptr); });
    PH(13, { moe_plan(p, c); p13_final(p, c); });
#undef PH
#undef IN
#undef SEAM
}

extern "C" void kernel_launch(void* const* d_in, const int* in_sizes, int n_in, void* d_out, int out_size, void* d_ws, size_t ws_size, hipStream_t stream) {
    static int grid = 0;
    if (grid == 0) {
        if (n_in != 38 || out_size != TL * D || ws_size < WS_END) { fprintf(stderr, "kernel_launch: unexpected shapes: n_in %d out %d ws %zu (need %zu)\n", n_in, out_size, ws_size, (size_t)WS_END); grid = -1; return; }
        int dev = 0, cus = 0, per_cu = 0;
        if (hipGetDevice(&dev) != hipSuccess || hipDeviceGetAttribute(&cus, hipDeviceAttributeMultiprocessorCount, dev) != hipSuccess) { grid = -1; return; }
        if (hipFuncSetAttribute((const void*)fwd, hipFuncAttributeMaxDynamicSharedMemorySize, LDS_BYTES) != hipSuccess) { fprintf(stderr, "kernel_launch: hipFuncSetAttribute failed\n"); grid = -1; return; }
        if (hipOccupancyMaxActiveBlocksPerMultiprocessor(&per_cu, (const void*)fwd, 512, LDS_BYTES) != hipSuccess || per_cu < 1) { fprintf(stderr, "kernel_launch: occupancy query says %d\n", per_cu); }
        (void)hipGetLastError();
        grid = cus;
    }
    if (grid < 0) return;
    (void)in_sizes;
    (void)hipMemsetAsync((char*)d_ws + WS_CTL, 0, CTL_ZERO_BYTES, stream);
    Params p; memset(&p, 0, sizeof(p));
    for (int i = 0; i < 38; ++i) p.in[i] = (const float*)d_in[i];
    p.out = (float*)d_out; p.ws = (unsigned char*)d_ws;
#if MK_FUSED
    p.ph_lo = 0; p.ph_hi = N_PHASES;
    hipLaunchKernelGGL(fwd, dim3(grid), dim3(512), LDS_BYTES, stream, p);
#else
    for (int k = 0; k < N_PHASES; ++k) { p.ph_lo = k; p.ph_hi = k + 1; hipLaunchKernelGGL(fwd, dim3(grid), dim3(512), LDS_BYTES, stream, p); }
#endif
}
```

```cpp
#include <hip/hip_runtime.h>
#include <cstdio>
#include <cstdint>
#include <cstring>

#ifndef CONV_IN_SCAN
#define CONV_IN_SCAN 1
#endif
#ifndef MK_FUSED
#define MK_FUSED 1
#endif

#define GAS __attribute__((address_space(1)))
#define LAS __attribute__((address_space(3)))
typedef unsigned short bf16;
typedef short bf16x8 __attribute__((ext_vector_type(8)));
typedef float f32x4 __attribute__((ext_vector_type(4)));
typedef float f32x2 __attribute__((ext_vector_type(2)));
typedef unsigned u32x4 __attribute__((ext_vector_type(4)));
typedef unsigned u32x2 __attribute__((ext_vector_type(2)));
typedef int v8i __attribute__((ext_vector_type(8)));
typedef int v4i __attribute__((ext_vector_type(4)));
typedef short v2s __attribute__((ext_vector_type(2)));

constexpr int D = 2048, NB = 8, SEQ = 2048, CTXL = 256, TL = NB * SEQ, TC = NB * CTXL, TT = TL + TC;
constexpr int DCV = 1024, DR = 1024, NH = 16, HS = 64, CWID = 31;
constexpr int DSHIFT = 3488, PIN = 9632;
constexpr int ZN = 9728, ZCN = 3584, ZR0 = 2048, ZG0 = 5632;
constexpr int NE = 32, ECAP = 16384, MAXMT = 288;
constexpr int LORA_K = 256, LORA_N = 5120;
constexpr int SCH = 16, NCHUNK = (CTXL + SEQ) / SCH;
constexpr float LN_EPS = 1e-5f, GN_EPS = 64e-5f, DN_ALPHA = 1.189207115002721f;
constexpr float SW_LIMIT = 7.0f, SW_ALPHA = 1.702f;
constexpr float W8_SCALE = 64.0f, W8_INV = 1.0f / 64.0f;
constexpr int SC_W8 = 0x79797979, SC_ONE = 0x7F7F7F7F;
constexpr float DN8_SCALE = 16.0f;

constexpr size_t MiB = 1u << 20;
constexpr size_t WS_CTL = 0, CTL_ZERO_BYTES = 32768;
constexpr size_t WS_MOD = 1 * MiB, WS_BIN = 2 * MiB, WS_BGU = 2 * MiB + 65536, WS_WR = 3 * MiB, WS_SEL = 4 * MiB, WS_RK = 5 * MiB;
constexpr size_t WS_ROWTOK = 6 * MiB, WS_ROWW = 8 * MiB, WS_WCO = 10 * MiB, WS_WRO = 14 * MiB, WS_WOUT = 18 * MiB, WS_WLORA = 26 * MiB;
constexpr size_t WS_WIN = 32 * MiB, WS_U = 70 * MiB, WS_ACONV = 142 * MiB, WS_ALORA = 174 * MiB, WS_ARWKV = 192 * MiB, WS_VS = 224 * MiB;
constexpr size_t WS_MIX = 256 * MiB, WS_U2HI = 320 * MiB, WS_U2LO = 384 * MiB, WS_T1 = 448 * MiB, WS_XMID = 576 * MiB, WS_Y = 704 * MiB;
constexpr size_t WS_ZC = 832 * MiB, WS_LORA = 848 * MiB, WS_ZL = 1028 * MiB, WS_SC = 1332 * MiB, WS_WGU = 1728 * MiB, WS_WDN = 2240 * MiB;
constexpr size_t WS_U2F8 = 1332 * MiB, WS_ALORA3 = 1364 * MiB;
constexpr size_t WS_HID = 2496 * MiB, WS_DOWN = 2784 * MiB, WS_END = 3072 * MiB;
constexpr int CW_BAR = 4096;
constexpr int CW_CNT = 1024;

constexpr int RING_BYTES = 131072;
constexpr int LDSX_OFF = 145408;
constexpr int LX_MISC = LDSX_OFF;
constexpr int LX_CNT = LDSX_OFF + 256;
constexpr int LX_TST = LDSX_OFF + 512;
constexpr int LX_TE = LDSX_OFF + 768;
constexpr int LDS_BYTES = 163840;

__device__ __forceinline__ unsigned f2bf(float f) { unsigned u = __builtin_bit_cast(unsigned, f); return (u + 0x7fffu + ((u >> 16) & 1u)) >> 16; }
__device__ __forceinline__ unsigned cvt_pk_bf16(float lo, float hi) { unsigned r; asm volatile("v_cvt_pk_bf16_f32 %0, %1, %2" : "=v"(r) : "v"(lo), "v"(hi)); return r; }
__device__ __forceinline__ float clamp448(float x) { return fminf(fmaxf(x, -448.f), 448.f); }
__device__ __forceinline__ unsigned pk_fp8x4(float a, float b, float c, float d) {
    unsigned w = 0u; w = (unsigned)__builtin_amdgcn_cvt_pk_fp8_f32(clamp448(a), clamp448(b), (int)w, false); w = (unsigned)__builtin_amdgcn_cvt_pk_fp8_f32(clamp448(c), clamp448(d), (int)w, true); return w; }
__device__ __forceinline__ unsigned pk_fp8x4_nc(float a, float b, float c, float d) {
    unsigned w = 0u; w = (unsigned)__builtin_amdgcn_cvt_pk_fp8_f32(a, b, (int)w, false); w = (unsigned)__builtin_amdgcn_cvt_pk_fp8_f32(c, d, (int)w, true); return w; }
__device__ __forceinline__ unsigned pk_fp8x4_w(float a, float b, float c, float d) {
    v2s r = {0, 0}; r = __builtin_amdgcn_cvt_scalef32_pk_fp8_f32(r, a, b, W8_INV, false); r = __builtin_amdgcn_cvt_scalef32_pk_fp8_f32(r, c, d, W8_INV, true);
    return __builtin_bit_cast(unsigned, r); }
__device__ __forceinline__ float bflo(unsigned u) { return __builtin_bit_cast(float, u << 16); }
__device__ __forceinline__ float bfhi(unsigned u) { return __builtin_bit_cast(float, u & 0xffff0000u); }
__device__ __forceinline__ float bf1(bf16 h) { return __builtin_bit_cast(float, ((unsigned)h) << 16); }
__device__ __forceinline__ float sigm(float x) { return __builtin_amdgcn_rcpf(1.f + __expf(-x)); }
__device__ __forceinline__ float wave_sum(float v) {
#pragma unroll
    for (int o = 1; o < 64; o <<= 1) v += __shfl_xor(v, o);
    return v;
}
#define RLX_AGENT __ATOMIC_RELAXED, __HIP_MEMORY_SCOPE_AGENT

#define XB_TMO      128
#define XB_XCNT(j)  (256  + 64 * (j))
#define XB_XSUB(j)  (1280 + 64 * (j))
#define XB_XGEN(j)  (2304 + 64 * (j))
#define XB_TOP      3328
#define XB_TOPGEN   3392
#define XCD_BAR_WORDS 3456
#define XB_SPIN_CAP (1u << 22)
__device__ __forceinline__ unsigned xb_ld(unsigned* p)              { return __hip_atomic_load(p, __ATOMIC_RELAXED, __HIP_MEMORY_SCOPE_AGENT); }
__device__ __forceinline__ unsigned xb_add(unsigned* p, unsigned v) { return __hip_atomic_fetch_add(p, v, __ATOMIC_RELAXED, __HIP_MEMORY_SCOPE_AGENT); }
__device__ __forceinline__ unsigned xb_xcc_id() { return (unsigned)__builtin_amdgcn_s_getreg((3 << 11) | 20) & 0xFu; }
#define XB_SPIN(cond, bar) do { unsigned _sp = 0; while (cond) { __builtin_amdgcn_s_sleep(1); \
    if ((++_sp & 255u) == 0u) { if (xb_ld(&(bar)[XB_TMO])) break; if (_sp > XB_SPIN_CAP) { atomicAdd(&(bar)[XB_TMO], 1u); break; } } } } while (0)
struct XcdBarrier { unsigned* bar; unsigned x; volatile LAS unsigned* st; };
__device__ __forceinline__ XcdBarrier xcd_barrier_post(unsigned* bar, volatile LAS unsigned* st) {
    XcdBarrier b; b.bar = bar; b.x = xb_xcc_id(); b.st = st;
    if (threadIdx.x == 0) (void)xb_add(&bar[XB_XCNT(b.x)], 1u);
    return b;
}
__device__ __forceinline__ void xcd_barrier_complete(unsigned* bar, unsigned x, unsigned& nloc, unsigned& nx) {
    const unsigned G = gridDim.x * gridDim.y * gridDim.z;
    unsigned sum, cnt, mine, sp = 0u;
    for (;;) {
        sum = 0u; cnt = 0u; mine = 0u;
#pragma unroll
        for (unsigned j = 0; j < 16; ++j) { const unsigned c = xb_ld(&bar[XB_XCNT(j)]); sum += c; cnt += (c > 0u) ? 1u : 0u; mine = (j == x) ? c : mine; }
        if (sum == G) break;
        __builtin_amdgcn_s_sleep(1);
        if ((++sp & 255u) == 0u) { if (xb_ld(&bar[XB_TMO])) break; if (sp > XB_SPIN_CAP) { atomicAdd(&bar[XB_TMO], 1u); break; } }
    }
    nloc = mine > 0u ? mine : 1u; nx = cnt > 0u ? cnt : 1u;
}
__device__ __forceinline__ void xcd_barrier(const XcdBarrier& b) {
    asm volatile("s_waitcnt vmcnt(0)" ::: "memory");
    __syncthreads();
    if (threadIdx.x == 0) {
        unsigned* bar = b.bar;
        __builtin_amdgcn_s_waitcnt(0);
        unsigned nloc = b.st[0], nx = b.st[1];
        if (nloc == 0u) { xcd_barrier_complete(bar, b.x, nloc, nx); b.st[0] = nloc; b.st[1] = nx; }
        const unsigned old = xb_add(&bar[XB_XSUB(b.x)], 1u);
        const unsigned gen = old / nloc;
        if (old + 1u == (gen + 1u) * nloc) {
            __builtin_amdgcn_fence(__ATOMIC_RELEASE, "agent");
            asm volatile("s_waitcnt vmcnt(0)" ::: "memory");
            const unsigned og = xb_add(&bar[XB_TOP], 1u);
            const unsigned tg = og / nx;
            if (og + 1u == (tg + 1u) * nx) xb_add(&bar[XB_TOPGEN], 1u);
            else XB_SPIN(xb_ld(&bar[XB_TOPGEN]) == tg, bar);
            __builtin_amdgcn_fence(__ATOMIC_ACQUIRE, "agent");
            xb_add(&bar[XB_XGEN(b.x)], 1u);
            asm volatile("s_waitcnt vmcnt(0)" ::: "memory");
        } else {
            XB_SPIN(xb_ld(&bar[XB_XGEN(b.x)]) == gen, bar);
            __builtin_amdgcn_fence(__ATOMIC_ACQUIRE, "agent");
            asm volatile("s_waitcnt vmcnt(0)" ::: "memory");
        }
    }
    __syncthreads();
}

namespace pg8 {
constexpr int BM = 256, BK = 64, HALF = 128, HTB = HALF * BK * 2, STAGE_BYTES = 8 * HTB, NXCD = 8, WGM = 8;
__host__ __device__ __forceinline__ int lds_byte(int r, int c) { const int st = (r >> 4) * 2 + (c >> 5), rr = r & 15, cc = c & 31, ob = rr * 64 + cc * 2; return st * 1024 + (ob ^ (((ob >> 9) & 1) << 5)); }
__host__ __device__ __forceinline__ void stage_rc(int b, int& R, int& C) { const int st = b / 1024, sb = b % 1024, swz = sb ^ (((sb >> 9) & 1) << 5); R = (st >> 1) * 16 + swz / 64; C = (st & 1) * 32 + (swz % 64) / 2; }
__host__ __device__ __forceinline__ int perm32(int rho) { const int n = rho >> 4, i = rho & 15; return 8 * (i >> 2) + 4 * n + (i & 3); }

struct Unit { int pm, pn, e, lt; };
__device__ __forceinline__ void map_tile(int wgid, int nwg, int nM, int nN, int& pm, int& pn) {
    { const int q = nwg / NXCD, r = nwg % NXCD, xcd = wgid % NXCD, off = wgid / NXCD; wgid = (xcd < r ? xcd * (q + 1) : r * (q + 1) + (xcd - r) * q) + off; }
    const int nig = WGM * nN, gid = wgid / nig, fm = gid * WGM, gsz = (nM - fm) < WGM ? (nM - fm) : WGM;
    pm = fm + ((wgid % nig) % gsz); pn = (wgid % nig) / gsz;
}
struct PlainSched {
    const bf16* A; const bf16* Bt; int K, nM, nN, G, c;
    __device__ __forceinline__ bool next(int i, Unit& u) const { const long L = (long)i * G + c; if (L >= (long)nM * nN) return false; map_tile((int)L, nM * nN, nM, nN, u.pm, u.pn); u.e = 0; u.lt = 0; return true; }
    __device__ __forceinline__ const char* aptr(const Unit& u) const { return (const char*)A + (size_t)u.pm * BM * K * 2; }
    __device__ __forceinline__ const char* bptr(const Unit& u) const { return (const char*)Bt + (size_t)u.pn * BM * K * 2; }
    __device__ __forceinline__ void rows(const Unit&, const int (&)[2], const int (&)[2], unsigned (&)[2][2]) const {}
    __device__ __forceinline__ void rows_issue(const Unit&, const int (&)[2], int (&)[2][2]) const {}
    __device__ __forceinline__ void rows_finish(const int (&)[2][2], const int (&)[2], unsigned (&)[2][2]) const {}
};
struct LoraSched {
    const bf16* A; const bf16* Bt; int G, c;
    __device__ __forceinline__ bool next(int i, Unit& u) const { const int L = i * G + c; constexpr int NU = (TT / 256) * (LORA_N / 256); if (L >= NU) return false; map_tile(L, NU, TT / 256, LORA_N / 256, u.pm, u.pn); u.e = u.pn < 8 ? 0 : (u.pn < 16 ? 1 : 2); u.lt = 0; return true; }
    __device__ __forceinline__ const char* aptr(const Unit& u) const { return (const char*)A + (unsigned)((u.e * TT + u.pm * BM) * (LORA_K * 2)); }
    __device__ __forceinline__ const char* bptr(const Unit& u) const { return (const char*)Bt + (unsigned)(u.pn * BM * LORA_K * 2); }
    __device__ __forceinline__ void rows(const Unit&, const int (&)[2], const int (&)[2], unsigned (&)[2][2]) const {}
    __device__ __forceinline__ void rows_issue(const Unit&, const int (&)[2], int (&)[2][2]) const {}
    __device__ __forceinline__ void rows_finish(const int (&)[2][2], const int (&)[2], unsigned (&)[2][2]) const {}
};
struct InProjSched {
    const bf16* A; const bf16* Bt; int G, c;
    __device__ __forceinline__ bool next(int i, Unit& u) const {
        const int L = i * G + c; constexpr int NL = 64 * 38, NCX = 8 * 14;
        if (L >= NL + NCX) return false;
        if (L < NL) map_tile(L, NL, 64, 38, u.pm, u.pn); else { map_tile(L - NL, NCX, 8, 14, u.pm, u.pn); u.pm += 64; u.pn += 8; }
        u.e = 0; u.lt = 0; return true; }
    __device__ __forceinline__ const char* aptr(const Unit& u) const { return (const char*)A + (size_t)u.pm * BM * D; }
    __device__ __forceinline__ const char* bptr(const Unit& u) const { return (const char*)Bt + (size_t)u.pn * BM * D; }
    __device__ __forceinline__ void rows(const Unit&, const int (&)[2], const int (&)[2], unsigned (&)[2][2]) const {}
    __device__ __forceinline__ void rows_issue(const Unit&, const int (&)[2], int (&)[2][2]) const {}
    __device__ __forceinline__ void rows_finish(const int (&)[2][2], const int (&)[2], unsigned (&)[2][2]) const {}
};
struct MoeSched {
    const bf16* A; const bf16* Bt; const int* rowtok; int K, N, nN, G, c; const LAS int* cnt; const LAS int* tst; const LAS unsigned char* te;
    __device__ __forceinline__ bool next(int i, Unit& u) const { const int nM = tst[NE]; const int L = i * G + c; if (L >= nM * nN) return false;
        map_tile(L, nM * nN, nM, nN, u.pm, u.pn); u.e = te[u.pm]; u.lt = u.pm - tst[u.e]; return true; }
    __device__ __forceinline__ const char* aptr(const Unit& u) const { return (const char*)A + (size_t)u.pm * BM * K * 2; }
    __device__ __forceinline__ const char* bptr(const Unit& u) const { return (const char*)Bt + ((size_t)u.e * N + (size_t)u.pn * BM) * K * 2; }
    __device__ __forceinline__ void rows(const Unit& u, const int (&sR)[2], const int (&sC2)[2], unsigned (&g)[2][2]) const {
        const int n = cnt[u.e]; const int* rt = rowtok + (size_t)u.e * ECAP;
#pragma unroll
        for (int h = 0; h < 2; ++h)
#pragma unroll
            for (int i = 0; i < 2; ++i) { const int j = u.lt * BM + h * HALF + sR[i]; const int tok = (j < n) ? rt[j] : 0; g[h][i] = (unsigned)tok * (unsigned)(K * 2) + (unsigned)sC2[i]; }
        asm volatile("s_waitcnt vmcnt(0)" ::: "memory");
    }
    __device__ __forceinline__ void rows_issue(const Unit& u, const int (&sR)[2], int (&tok)[2][2]) const {
        const int n = cnt[u.e]; const int* rt = rowtok + (size_t)u.e * ECAP;
#pragma unroll
        for (int h = 0; h < 2; ++h)
#pragma unroll
            for (int i = 0; i < 2; ++i) { const int j = u.lt * BM + h * HALF + sR[i]; const int tk = rt[j < n ? j : 0]; tok[h][i] = (j < n) ? tk : 0; }
    }
    __device__ __forceinline__ void rows_finish(const int (&tok)[2][2], const int (&sC2)[2], unsigned (&g)[2][2]) const {
#pragma unroll
        for (int h = 0; h < 2; ++h)
#pragma unroll
            for (int i = 0; i < 2; ++i) g[h][i] = (unsigned)tok[h][i] * (unsigned)(K * 2) + (unsigned)sC2[i];
    }
};

template <class Epi, class Sched, bool GATHER, bool F8 = false>
__device__ __forceinline__ void gemm_phase(LAS unsigned char* lds, const int K, const Sched& S, const Epi& E, const char* gatherA) {
    const int tid = threadIdx.x, wid = __builtin_amdgcn_readfirstlane(tid >> 6), lane = tid & 63, wr = wid >> 2, wc = wid & 3, fr = lane & 15, fq = lane >> 4;
    const int nt = K / BK;
    unsigned voffA[2], voffB[2]; int sR[2], sC2[2];
#pragma unroll
    for (int i = 0; i < 2; ++i) { int R, C; stage_rc(tid * 16 + i * 8192, R, C); const int Rb = Epi::PERM ? ((R & ~31) + perm32(R & 31)) : R;
        voffA[i] = (unsigned)(R * K + C) * 2u; voffB[i] = (unsigned)(Rb * K + C) * 2u; sR[i] = R; sC2[i] = C * 2; }
    const size_t kstep = (size_t)(BK * 2);
    const size_t hstep = (size_t)HALF * K * 2;
    const unsigned ldsw = (unsigned)wid * 1024u;
    const int aoff = lds_byte(wr * 64 + fr, fq * 8), boff = lds_byte(wc * 32 + fr, fq * 8);
#define PG8_SA(b, h) (((b) * 2 + (h)) * HTB)
#define PG8_SB(b, h) ((4 + (b) * 2 + (h)) * HTB)
#define PG8_STAGE(bufoff, gbase, voff) do { _Pragma("unroll") for (int _i = 0; _i < 2; ++_i) \
        __builtin_amdgcn_global_load_lds((const unsigned*)((const char*)(gbase) + (voff)[_i]), (LAS unsigned*)(lds + (bufoff) + ldsw + _i * 8192), 16, 0, 0); } while (0)
#define PG8_STG_A(bufoff, gbase, h, OFF) do { if constexpr (GATHER) { PG8_STAGE(bufoff, gbase, OFF); } else { PG8_STAGE(bufoff, (gbase) + (h) * hstep, voffA); } } while (0)
#define PG8_CAT(p0, p1) __builtin_shufflevector(*(const LAS v4i*)(p0), *(const LAS v4i*)(p1), 0, 1, 2, 3, 4, 5, 6, 7)
#define PG8_LDA(dst, b, h) do { _Pragma("unroll") for (int m = 0; m < 4; ++m) { if constexpr (F8) dst##8[m] = PG8_CAT(lds + PG8_SA(b, h) + aoff + m * 2048, lds + PG8_SA(b, h) + aoff + m * 2048 + 1024); \
        else { _Pragma("unroll") for (int k = 0; k < 2; ++k) dst[m][k] = *(const LAS bf16x8*)(lds + PG8_SA(b, h) + aoff + m * 2048 + k * 1024); } } } while (0)
#define PG8_LDB(dst, b, h) do { _Pragma("unroll") for (int n = 0; n < 2; ++n) { if constexpr (F8) dst##8[n] = PG8_CAT(lds + PG8_SB(b, h) + boff + n * 2048, lds + PG8_SB(b, h) + boff + n * 2048 + 1024); \
        else { _Pragma("unroll") for (int k = 0; k < 2; ++k) dst[n][k] = *(const LAS bf16x8*)(lds + PG8_SB(b, h) + boff + n * 2048 + k * 1024); } } } while (0)
#define PG8_MMA(ai, bj, At, Bt) do { __builtin_amdgcn_s_setprio(1); _Pragma("unroll") for (int m = 0; m < 4; ++m) _Pragma("unroll") for (int n = 0; n < 2; ++n) { \
        if constexpr (F8) asm volatile("v_mfma_scale_f32_16x16x128_f8f6f4 %0, %1, %2, %0, %3, %4 op_sel_hi:[0,0,0]" : "+v"(acc[ai][bj][m][n]) : "v"(Bt##8[n]), "v"(At##8[m]), "v"(scw8), "v"(sca8)); \
        else { _Pragma("unroll") for (int k = 0; k < 2; ++k) acc[ai][bj][m][n] = __builtin_amdgcn_mfma_f32_16x16x32_bf16(Bt[n][k], At[m][k], acc[ai][bj][m][n], 0, 0, 0); } } __builtin_amdgcn_s_setprio(0); } while (0)
#define PG8_WAIT_V(n) asm volatile("s_waitcnt vmcnt(" #n ")" ::: "memory")
#define PG8_WAIT_L(n) asm volatile("s_waitcnt lgkmcnt(" #n ")" ::: "memory")
#define PG8_BAR __builtin_amdgcn_s_barrier()
#define PG8_SCHED __builtin_amdgcn_sched_barrier(0)
    Unit cur, nxt; int ui = 0;
    if (!S.next(0, cur)) return;
    f32x4 acc[2][2][4][2];
#pragma unroll
    for (int a = 0; a < 2; ++a)
#pragma unroll
        for (int b = 0; b < 2; ++b)
#pragma unroll
            for (int m = 0; m < 4; ++m)
#pragma unroll
                for (int n = 0; n < 2; ++n) acc[a][b][m][n] = (f32x4){0.f, 0.f, 0.f, 0.f};
    bf16x8 At[4][2], B0[2][2], B1[2][2]; v8i At8[4], B08[2], B18[2]; const int scw8 = SC_W8, sca8 = SC_ONE;
    const char* cA = GATHER ? gatherA : S.aptr(cur); const char* cB = S.bptr(cur);
    unsigned gA[2][2] = {{0u, 0u}, {0u, 0u}}, gA1[2] = {0u, 0u}, gN[2][2] = {{0u, 0u}, {0u, 0u}};
    if constexpr (GATHER) S.rows(cur, sR, sC2, gA);
    PG8_STAGE(PG8_SB(0, 0), cB, voffB); PG8_STAGE(PG8_SB(0, 1), cB + hstep, voffB); PG8_STG_A(PG8_SA(0, 0), cA, 0, gA[0]); PG8_STG_A(PG8_SA(0, 1), cA, 1, gA[1]);
    if (wr == 1) PG8_BAR;
    PG8_WAIT_V(2); PG8_BAR;
    PG8_STAGE(PG8_SB(1, 0), cB + kstep, voffB); PG8_STG_A(PG8_SA(1, 0), cA + kstep, 0, gA[0]); PG8_STAGE(PG8_SB(1, 1), cB + hstep + kstep, voffB);
    PG8_WAIT_V(6); PG8_BAR;
    for (;;) {
        const bool has_next = S.next(ui + 1, nxt);
        const char* nA = GATHER ? gatherA : (has_next ? S.aptr(nxt) : cA); const char* nB = has_next ? S.bptr(nxt) : cB;
        for (int t = 0; t < nt; t += 2) {
            const bool last = (t == nt - 2);
            const char* a1 = cA + (size_t)(t + 1) * kstep;
            const char* a2 = last ? nA : cA + (size_t)(t + 2) * kstep; const char* b2 = last ? nB : cB + (size_t)(t + 2) * kstep;
            const char* a3 = a2 + kstep; const char* b3 = b2 + kstep;
            int tkn[2][2];
            if constexpr (GATHER) { gA1[0] = gA[1][0]; gA1[1] = gA[1][1];
                if (t == 0 && has_next) S.rows_issue(nxt, sR, tkn);
                if (last && has_next) { gA[0][0] = gN[0][0]; gA[0][1] = gN[0][1]; gA[1][0] = gN[1][0]; gA[1][1] = gN[1][1]; } }
            PG8_LDB(B0, 0, 0); PG8_LDB(B1, 0, 1); PG8_SCHED; PG8_LDA(At, 0, 0); PG8_STG_A(PG8_SA(1, 1), a1, 1, gA1);
            PG8_WAIT_V(8); PG8_WAIT_L(0); PG8_BAR; PG8_MMA(0, 0, At, B0); PG8_MMA(0, 1, At, B1); PG8_BAR; PG8_SCHED;
            PG8_LDA(At, 0, 1); PG8_STAGE(PG8_SB(0, 0), b2, voffB); PG8_STAGE(PG8_SB(0, 1), b2 + hstep, voffB); PG8_STG_A(PG8_SA(0, 0), a2, 0, gA[0]);
            PG8_WAIT_V(8); PG8_WAIT_L(0); PG8_BAR; PG8_MMA(1, 0, At, B0); PG8_MMA(1, 1, At, B1); PG8_BAR; PG8_SCHED;
            PG8_LDB(B0, 1, 0); PG8_LDB(B1, 1, 1); PG8_SCHED; PG8_LDA(At, 1, 0); PG8_STG_A(PG8_SA(0, 1), a2, 1, gA[1]);
            PG8_WAIT_V(8); PG8_WAIT_L(0); PG8_BAR; PG8_MMA(0, 0, At, B0); PG8_MMA(0, 1, At, B1); PG8_BAR; PG8_SCHED;
            PG8_LDA(At, 1, 1); PG8_STAGE(PG8_SB(1, 0), b3, voffB); PG8_STAGE(PG8_SB(1, 1), b3 + hstep, voffB); PG8_STG_A(PG8_SA(1, 0), a3, 0, gA[0]);
            PG8_WAIT_V(8); PG8_WAIT_L(0); PG8_BAR; PG8_MMA(1, 0, At, B0); PG8_MMA(1, 1, At, B1); PG8_BAR; PG8_SCHED;
            if constexpr (GATHER) { if (t == 0 && has_next) S.rows_finish(tkn, sC2, gN); }
        }
        if (wr == 0) PG8_BAR;
        if constexpr (F8) asm volatile("s_nop 7\n\ts_nop 7\n\ts_nop 7" ::: "memory");
        E(acc, cur, wr, wc, fr, fq);
        if (!has_next) break;
#pragma unroll
        for (int a = 0; a < 2; ++a)
#pragma unroll
            for (int b = 0; b < 2; ++b)
#pragma unroll
                for (int m = 0; m < 4; ++m)
#pragma unroll
                    for (int n = 0; n < 2; ++n) acc[a][b][m][n] = (f32x4){0.f, 0.f, 0.f, 0.f};
        cur = nxt; cA = nA; cB = nB; ++ui;
        if (wr == 1) PG8_BAR;
    }
    PG8_WAIT_V(0);
    PG8_BAR;
#undef PG8_SA
#undef PG8_SB
#undef PG8_STAGE
#undef PG8_STG_A
#undef PG8_LDA
#undef PG8_CAT
#undef PG8_LDB
#undef PG8_MMA
#undef PG8_WAIT_V
#undef PG8_WAIT_L
#undef PG8_BAR
#undef PG8_SCHED
}

typedef const f32x4 (&AccT)[2][2][4][2];
__device__ __forceinline__ u32x4 pack8(f32x4 v0, f32x4 v1) { u32x4 w; w.x = cvt_pk_bf16(v0[0], v0[1]); w.y = cvt_pk_bf16(v0[2], v0[3]); w.z = cvt_pk_bf16(v1[0], v1[1]); w.w = cvt_pk_bf16(v1[2], v1[3]); return w; }
__device__ __forceinline__ void unpack8(u32x4 w, f32x4& v0, f32x4& v1) { v0 = (f32x4){bflo(w.x), bfhi(w.x), bflo(w.y), bfhi(w.y)}; v1 = (f32x4){bflo(w.z), bfhi(w.z), bflo(w.w), bfhi(w.w)}; }
__device__ __forceinline__ f32x4 sig4(f32x4 v) { return (f32x4){sigm(v[0]), sigm(v[1]), sigm(v[2]), sigm(v[3])}; }

struct EpiBf16Plain {
    static constexpr bool PERM = true;
    bf16* O; int ldc; const float* bias;
    __device__ __forceinline__ void operator()(AccT acc, const Unit& u, int wr, int wc, int fr, int fq) const {
        const int row0 = u.pm * BM + wr * 64 + fr, col0 = u.pn * BM + wc * 32 + 8 * fq;
        f32x4 bv[2][2];
#pragma unroll
        for (int bj = 0; bj < 2; ++bj)
#pragma unroll
            for (int n = 0; n < 2; ++n) bv[bj][n] = bias ? *(const f32x4*)(bias + col0 + bj * HALF + 4 * n) : (f32x4){0.f, 0.f, 0.f, 0.f};
#pragma unroll
        for (int ai = 0; ai < 2; ++ai)
#pragma unroll
            for (int m = 0; m < 4; ++m) { bf16* rowp = O + (size_t)(row0 + ai * HALF + m * 16) * ldc + col0;
#pragma unroll
                for (int bj = 0; bj < 2; ++bj) *(u32x4*)(rowp + bj * HALF) = pack8(acc[ai][bj][m][0] + bv[bj][0], acc[ai][bj][m][1] + bv[bj][1]); }
    }
};
struct EpiInProj {
    static constexpr bool PERM = true;
    bf16* ZL; bf16* ZC; const float* bias;
    __device__ __forceinline__ void operator()(AccT acc, const Unit& u, int wr, int wc, int fr, int fq) const {
        const int row0 = u.pm * BM + wr * 64 + fr, col0 = u.pn * BM + wc * 32 + 8 * fq;
        f32x4 bv[2][2];
#pragma unroll
        for (int bj = 0; bj < 2; ++bj)
#pragma unroll
            for (int n = 0; n < 2; ++n) bv[bj][n] = *(const f32x4*)(bias + col0 + bj * HALF + 4 * n);
        const bool lat = u.pm < 64;
#pragma unroll
        for (int ai = 0; ai < 2; ++ai)
#pragma unroll
            for (int m = 0; m < 4; ++m) { const int r = row0 + ai * HALF + m * 16;
                bf16* rowp = lat ? ZL + (size_t)r * ZN + col0 : ZC + (size_t)(r - TL) * ZCN + (col0 - ZR0);
#pragma unroll
                for (int bj = 0; bj < 2; ++bj) *(u32x4*)(rowp + bj * HALF) = pack8(acc[ai][bj][m][0] + bv[bj][0], acc[ai][bj][m][1] + bv[bj][1]); }
    }
};
struct EpiConvO {
    static constexpr bool PERM = true;
    bf16* MIX; const bf16* ZL; const float* bias;
    __device__ __forceinline__ void operator()(AccT acc, const Unit& u, int wr, int wc, int fr, int fq) const {
        const int row0 = u.pm * BM + wr * 64 + fr, col0 = u.pn * BM + wc * 32 + 8 * fq;
        f32x4 bv[2][2];
#pragma unroll
        for (int bj = 0; bj < 2; ++bj)
#pragma unroll
            for (int n = 0; n < 2; ++n) bv[bj][n] = *(const f32x4*)(bias + col0 + bj * HALF + 4 * n);
#pragma unroll
        for (int ai = 0; ai < 2; ++ai)
#pragma unroll
            for (int m = 0; m < 4; ++m) { const size_t r = (size_t)(row0 + ai * HALF + m * 16);
#pragma unroll
                for (int bj = 0; bj < 2; ++bj) { const int c = col0 + bj * HALF; f32x4 g0, g1; unpack8(*(const u32x4*)(ZL + r * ZN + ZG0 + c), g0, g1);
                    *(u32x4*)(MIX + r * D + c) = pack8(sig4(g0) * (acc[ai][bj][m][0] + bv[bj][0]), sig4(g1) * (acc[ai][bj][m][1] + bv[bj][1])); } }
    }
};
struct EpiRwkvO {
    static constexpr bool PERM = true;
    bf16* MIX; const bf16* ZL;
    __device__ __forceinline__ void operator()(AccT acc, const Unit& u, int wr, int wc, int fr, int fq) const {
        const int row0 = u.pm * BM + wr * 64 + fr, col0 = u.pn * BM + wc * 32 + 8 * fq;
#pragma unroll
        for (int ai = 0; ai < 2; ++ai)
#pragma unroll
            for (int m = 0; m < 4; ++m) { const size_t r = (size_t)(row0 + ai * HALF + m * 16);
#pragma unroll
                for (int bj = 0; bj < 2; ++bj) { const int c = col0 + bj * HALF; f32x4 g0, g1, m0, m1; unpack8(*(const u32x4*)(ZL + r * ZN + ZG0 + D + c), g0, g1); unpack8(*(const u32x4*)(MIX + r * D + c), m0, m1);
                    *(u32x4*)(MIX + r * D + c) = pack8(m0 + sig4(g0) * acc[ai][bj][m][0], m1 + sig4(g1) * acc[ai][bj][m][1]); } }
    }
};
struct EpiOut {
    static constexpr bool PERM = true;
    float* T1; const float* x; const float* mod; const float* bias;
    __device__ __forceinline__ void operator()(AccT acc, const Unit& u, int wr, int wc, int fr, int fq) const {
        const int row0 = u.pm * BM + wr * 64 + fr, col0 = u.pn * BM + wc * 32 + 8 * fq;
        const float* gate = mod + (size_t)(u.pm / 8) * (6 * D) + 2 * D;
        f32x4 bv[2][2], gv[2][2];
#pragma unroll
        for (int bj = 0; bj < 2; ++bj)
#pragma unroll
            for (int n = 0; n < 2; ++n) { bv[bj][n] = *(const f32x4*)(bias + col0 + bj * HALF + 4 * n); gv[bj][n] = *(const f32x4*)(gate + col0 + bj * HALF + 4 * n); }
#pragma unroll
        for (int ai = 0; ai < 2; ++ai)
#pragma unroll
            for (int m = 0; m < 4; ++m) { const size_t off = (size_t)(row0 + ai * HALF + m * 16) * D + col0;
#pragma unroll
                for (int bj = 0; bj < 2; ++bj)
#pragma unroll
                    for (int n = 0; n < 2; ++n) { const f32x4 xv = *(const f32x4*)(x + off + bj * HALF + 4 * n);
                        *(f32x4*)(T1 + off + bj * HALF + 4 * n) = xv * DN_ALPHA + gv[bj][n] * (acc[ai][bj][m][n] + bv[bj][n]); } }
    }
};
struct EpiGateUp {
    static constexpr bool PERM = true;
    unsigned char* HID; const float* bias;
    __device__ __forceinline__ void operator()(AccT acc, const Unit& u, int wr, int wc, int fr, int fq) const {
        const int row0 = u.pm * BM + wr * 64 + fr, cb = u.pn * BM + wc * 32 + 8 * fq, co = u.pn * HALF + wc * 32 + 8 * fq;
        const float* bp = bias + (size_t)u.e * 4096 + cb;
        f32x4 bv[2][2];
#pragma unroll
        for (int bj = 0; bj < 2; ++bj)
#pragma unroll
            for (int n = 0; n < 2; ++n) bv[bj][n] = *(const f32x4*)(bp + bj * HALF + 4 * n);
#pragma unroll
        for (int ai = 0; ai < 2; ++ai)
#pragma unroll
            for (int m = 0; m < 4; ++m) { f32x4 h[2];
#pragma unroll
                for (int n = 0; n < 2; ++n) { const f32x4 g = acc[ai][0][m][n] + bv[0][n], up = acc[ai][1][m][n] + bv[1][n];
#pragma unroll
                    for (int j = 0; j < 4; ++j) { const float gg = fminf(g[j], SW_LIMIT), uu = fminf(fmaxf(up[j], -SW_LIMIT), SW_LIMIT); h[n][j] = (uu + 1.0f) * (gg * sigm(SW_ALPHA * gg)); } }
                u32x2 o; o.x = pk_fp8x4_nc(h[0][0], h[0][1], h[0][2], h[0][3]); o.y = pk_fp8x4_nc(h[1][0], h[1][1], h[1][2], h[1][3]);
                *(u32x2*)(HID + (size_t)(row0 + ai * HALF + m * 16) * D + co) = o; }
    }
};
struct EpiDown {
    static constexpr bool PERM = true;
    unsigned char* DOWN; const float* bias; const float* roww; const LAS int* cnt;
    __device__ __forceinline__ void operator()(AccT acc, const Unit& u, int wr, int wc, int fr, int fq) const {
        const int rl0 = wr * 64 + fr, col0 = u.pn * BM + wc * 32 + 8 * fq; const int n_e = cnt[u.e];
        const float* bp = bias + (size_t)u.e * D + col0; const float* rw = roww + (size_t)u.e * ECAP + u.lt * BM;
        f32x4 bv[2][2];
#pragma unroll
        for (int bj = 0; bj < 2; ++bj)
#pragma unroll
            for (int n = 0; n < 2; ++n) bv[bj][n] = *(const f32x4*)(bp + bj * HALF + 4 * n);
#pragma unroll
        for (int ai = 0; ai < 2; ++ai)
#pragma unroll
            for (int m = 0; m < 4; ++m) { const int rl = rl0 + ai * HALF + m * 16; const float gw = (u.lt * BM + rl < n_e) ? rw[rl] * DN8_SCALE : 0.f;
                unsigned char* rowp = DOWN + (size_t)(u.pm * BM + rl) * D + col0;
#pragma unroll
                for (int bj = 0; bj < 2; ++bj) { const f32x4 v0 = (acc[ai][bj][m][0] + bv[bj][0]) * gw, v1 = (acc[ai][bj][m][1] + bv[bj][1]) * gw;
                    u32x2 o; o.x = pk_fp8x4(v0[0], v0[1], v0[2], v0[3]); o.y = pk_fp8x4(v1[0], v1[1], v1[2], v1[3]); *(u32x2*)(rowp + bj * HALF) = o; } }
    }
};
}
__device__ __forceinline__ void unpack8(u32x4 w, f32x4& a, f32x4& b) { pg8::unpack8(w, a, b); }

struct Params { const float* in[38]; float* out; unsigned char* ws; int ph_lo, ph_hi; };
enum { I_X = 0, I_C, I_CTX, I_CCTX, I_WADA, I_BADA, I_WIN, I_BIN, I_SMU, I_CONVW, I_CONVB, I_CLNG, I_CLNB, I_WCO, I_BCO, I_W0, I_W2, I_A0, I_A2, I_G2,
       I_KK, I_KA, I_RK, I_LNXG, I_LNXB, I_WRO, I_WOUT, I_BOUT, I_LN1G, I_LN1B, I_WROUTER, I_BROUTER, I_WGU, I_BGU, I_WDN, I_BDN, I_LN2G, I_LN2B };

struct Ctx { LAS unsigned char* lds; int tid, lane, wave, G, bid, gw, NGW; };

__device__ __forceinline__ void cvt_item(const float* W, int N, int K, int k0, int n0, bf16* WT, int drow0, int lane) {
    const int ko = lane & 7, ng = lane >> 3;
    const float* src = W + (size_t)(k0 + 8 * ko) * N + n0 + 4 * ng;
    f32x4 v[8];
#pragma unroll
    for (int j = 0; j < 8; ++j) v[j] = *(const f32x4*)(src + (size_t)j * N);
#pragma unroll
    for (int jn = 0; jn < 4; ++jn) { u32x4 o; o.x = cvt_pk_bf16(v[0][jn], v[1][jn]); o.y = cvt_pk_bf16(v[2][jn], v[3][jn]); o.z = cvt_pk_bf16(v[4][jn], v[5][jn]); o.w = cvt_pk_bf16(v[6][jn], v[7][jn]);
        *(u32x4*)(WT + (size_t)(drow0 + 4 * ng + jn) * K + k0 + 8 * ko) = o; }
}
__device__ __forceinline__ void cvt8_item(const float* W, int N, int k0, int n0, unsigned char* WT, int pitch, int drow0, int lane) {
    const int ko = lane & 7, ng = lane >> 3;
    const float* src = W + (size_t)(k0 + 16 * ko) * N + n0 + 4 * ng;
    f32x4 v[16];
#pragma unroll
    for (int j = 0; j < 16; ++j) v[j] = *(const f32x4*)(src + (size_t)j * N) * W8_SCALE;
#pragma unroll
    for (int jn = 0; jn < 4; ++jn) { u32x4 o; o.x = pk_fp8x4(v[0][jn], v[1][jn], v[2][jn], v[3][jn]); o.y = pk_fp8x4(v[4][jn], v[5][jn], v[6][jn], v[7][jn]);
        o.z = pk_fp8x4(v[8][jn], v[9][jn], v[10][jn], v[11][jn]); o.w = pk_fp8x4(v[12][jn], v[13][jn], v[14][jn], v[15][jn]);
        *(u32x4*)(WT + (size_t)(drow0 + 4 * ng + jn) * pitch + k0 + 16 * ko) = o; }
}
__device__ __forceinline__ void p0_convert(const Params& p, const Ctx& c) {
    unsigned char* ws = p.ws;
    constexpr int I_IN = 16 * 301, I_CO = 16 * 64, I_RO = 16 * 64, I_OUT = 32 * 64;
    constexpr int NITEMS = I_IN + I_CO + I_RO + I_OUT;
    for (int it = c.gw; it < NITEMS; it += c.NGW) {
        int r = it;
        if (r < I_IN) { const int kb = r / 301, nb = r % 301, n0 = 32 * nb; cvt8_item(p.in[I_WIN], PIN, 128 * kb, n0, ws + WS_WIN, D, n0 < 5536 ? n0 : n0 + 96, c.lane); continue; } r -= I_IN;
        if (r < I_CO) { const int kb = r / 64, nb = r % 64; cvt_item(p.in[I_WCO], D, DCV, 64 * kb, 32 * nb, (bf16*)(ws + WS_WCO), 32 * nb, c.lane); continue; } r -= I_CO;
        if (r < I_RO) { const int kb = r / 64, nb = r % 64; cvt_item(p.in[I_WRO], D, DR, 64 * kb, 32 * nb, (bf16*)(ws + WS_WRO), 32 * nb, c.lane); continue; } r -= I_RO;
        { const int kb = r / 64, nb = r % 64; cvt_item(p.in[I_WOUT], D, D, 64 * kb, 32 * nb, (bf16*)(ws + WS_WOUT), 32 * nb, c.lane); }
    }
}
struct CvtAddr { const float* src; unsigned char* dst; int N; };
__device__ __forceinline__ CvtAddr moe_cvt_addr(const Params& p, int it, int lane) {
    constexpr int I_GU1 = 16 * 128, I_GU = NE * I_GU1, I_DN1 = 16 * 64;
    const int ko = lane & 7, ng = lane >> 3; CvtAddr a;
    if (it < I_GU) { const int e = it / I_GU1, q = it % I_GU1, kb = q / 128, nb = q % 128, n0 = 32 * nb; const int nn = n0 & 2047;
        const int drow = (nn >> 7) * 256 + (n0 >= 2048 ? 128 : 0) + (nn & 127);
        a.N = 4096; a.src = p.in[I_WGU] + (size_t)e * D * 4096 + (size_t)(128 * kb + 16 * ko) * 4096 + n0 + 4 * ng;
        a.dst = p.ws + WS_WGU + (size_t)e * 4096 * D + (size_t)(drow + 4 * ng) * D + 128 * kb + 16 * ko; }
    else { const int r = it - I_GU; const int e = r / I_DN1, q = r % I_DN1, kb = q / 64, nb = q % 64;
        a.N = D; a.src = p.in[I_WDN] + (size_t)e * D * D + (size_t)(128 * kb + 16 * ko) * D + 32 * nb + 4 * ng;
        a.dst = p.ws + WS_WDN + (size_t)e * D * D + (size_t)(32 * nb + 4 * ng) * D + 128 * kb + 16 * ko; }
    return a;
}
__device__ __forceinline__ void moe_cvt_load(const CvtAddr& a, f32x4 (&v)[16]) {
#pragma unroll
    for (int j = 0; j < 16; ++j) v[j] = __builtin_nontemporal_load((const f32x4*)(a.src + (size_t)j * a.N));
}
__device__ __forceinline__ void moe_cvt_store(const CvtAddr& a, const f32x4 (&v)[16]) {
#pragma unroll
    for (int jn = 0; jn < 4; ++jn) { u32x4 o;
        o.x = pk_fp8x4_w(v[0][jn], v[1][jn], v[2][jn], v[3][jn]); o.y = pk_fp8x4_w(v[4][jn], v[5][jn], v[6][jn], v[7][jn]);
        o.z = pk_fp8x4_w(v[8][jn], v[9][jn], v[10][jn], v[11][jn]); o.w = pk_fp8x4_w(v[12][jn], v[13][jn], v[14][jn], v[15][jn]);
        *(u32x4*)(a.dst + (size_t)jn * D) = o; }
}
__device__ __forceinline__ void moe_convert(const Params& p, int wi, int nw, int lane) {
    constexpr int NIT = NE * (16 * 128 + 16 * 64);
    f32x4 va[16], vb[16];
    int it = wi; if (it >= NIT) return;
    CvtAddr aa = moe_cvt_addr(p, it, lane), ab = aa; moe_cvt_load(aa, va);
    for (;;) {
        const int i1 = it + nw; ab = moe_cvt_addr(p, i1 < NIT ? i1 : NIT - 1, lane); moe_cvt_load(ab, vb);
        moe_cvt_store(aa, va); if (i1 >= NIT) break;
        const int i2 = i1 + nw; aa = moe_cvt_addr(p, i2 < NIT ? i2 : NIT - 1, lane); moe_cvt_load(aa, va);
        moe_cvt_store(ab, vb); if (i2 >= NIT) break;
        it = i2;
    }
}
__device__ __forceinline__ void p0_small(const Params& p, const Ctx& c) {
    unsigned char* ws = p.ws;
    const int gt = c.bid * 512 + c.tid, NT = c.G * 512;
    bf16* WL = (bf16*)(ws + WS_WLORA);
    for (int t = gt; t < LORA_N * (LORA_K / 8); t += NT) {
        const int n = t / (LORA_K / 8), k0 = (t % (LORA_K / 8)) * 8, g = n >> 10, ch = n & 1023; float v[8];
#pragma unroll
        for (int j = 0; j < 8; ++j) { const int k = k0 + j; float x = 0.f;
            if (g < 4) { const int gd = g & 1; if (k >= 64 * gd && k < 64 * gd + 64) { const float* src = (g < 2) ? p.in[I_W2] : p.in[I_A2]; x = src[((size_t)gd * 64 + (k - 64 * gd)) * DR + ch]; } }
            else { if (k < 160) x = p.in[I_G2][(size_t)k * DR + ch]; }
            v[j] = x; }
        u32x4 o; o.x = cvt_pk_bf16(v[0], v[1]); o.y = cvt_pk_bf16(v[2], v[3]); o.z = cvt_pk_bf16(v[4], v[5]); o.w = cvt_pk_bf16(v[6], v[7]);
        *(u32x4*)(WL + (size_t)n * LORA_K + k0) = o;
    }
    bf16* WRt = (bf16*)(ws + WS_WR);
    for (int t = gt; t < NE * D; t += NT) { const int e = t / D, k = t % D; const float w = p.in[I_WROUTER][(size_t)k * NE + e]; const unsigned hi = f2bf(w); const float lo = w - bflo(hi);
        WRt[t] = (bf16)hi; WRt[NE * D + t] = (bf16)f2bf(lo); }
    float* bin = (float*)(ws + WS_BIN);
    for (int t = gt; t < ZN; t += NT) bin[t] = t < 5536 ? p.in[I_BIN][t] : (t < ZG0 ? 0.f : p.in[I_BIN][t - 96]);
    float* bgu = (float*)(ws + WS_BGU);
    for (int t = gt; t < NE * 4096; t += NT) { const int e = t >> 12, q = t & 4095, pn = q >> 8, rr = q & 255; bgu[t] = p.in[I_BGU][(size_t)e * 4096 + (rr < 128 ? 128 * pn + rr : 2048 + 128 * pn + rr - 128)]; }
    unsigned char* WI = ws + WS_WIN;
    for (int t = gt; t < 96 * D / 16; t += NT) *(u32x4*)(WI + (size_t)5536 * D + (size_t)t * 16) = (u32x4){0u, 0u, 0u, 0u};
}
__device__ __forceinline__ void p0_adaln(const Params& p, const Ctx& c) {
    LAS float* act = (LAS float*)c.lds; LAS float* red = (LAS float*)(c.lds + 73728);
    for (int i = c.tid; i < 9 * D; i += 512) { const int r = i / D, k = i % D; const float v = r < 8 ? p.in[I_C][r * D + k] : p.in[I_CCTX][k]; act[i] = v * sigm(v); }
    __syncthreads();
    const int cg = c.tid & 15, ks = c.tid >> 4;
    float* mod = (float*)(p.ws + WS_MOD);
    for (int u = c.bid; u < 192; u += c.G) {
        f32x4 acc[9];
#pragma unroll
        for (int r = 0; r < 9; ++r) acc[r] = (f32x4){0.f, 0.f, 0.f, 0.f};
        const float* wp = p.in[I_WADA] + 64 * u + 4 * cg;
#pragma unroll 4
        for (int k = ks; k < D; k += 32) { const f32x4 w = *(const f32x4*)(wp + (size_t)k * (6 * D));
#pragma unroll
            for (int r = 0; r < 9; ++r) acc[r] += w * act[r * D + k]; }
#pragma unroll
        for (int r = 0; r < 9; ++r)
#pragma unroll
            for (int j = 0; j < 4; ++j) { float v = acc[r][j]; v += __shfl_xor(v, 16); v += __shfl_xor(v, 32); acc[r][j] = v; }
        if (c.lane < 16) {
#pragma unroll
            for (int r = 0; r < 9; ++r) *(LAS f32x4*)(red + (c.wave * 9 + r) * 64 + 4 * cg) = acc[r]; }
        __syncthreads();
        for (int i = c.tid; i < 9 * 64; i += 512) { const int r = i / 64, col = i % 64; float s = 0.f;
#pragma unroll
            for (int w = 0; w < 8; ++w) s += red[(w * 9 + r) * 64 + col];
            mod[r * (6 * D) + 64 * u + col] = s + p.in[I_BADA][64 * u + col]; }
        __syncthreads();
    }
}

__device__ __forceinline__ void p1_modulate(const Params& p, const Ctx& c) {
    const float* mod = (const float*)(p.ws + WS_MOD); unsigned char* U = p.ws + WS_U;
    for (int row = c.gw; row < TT; row += c.NGW) {
        const float* src = row < TL ? p.in[I_X] + (size_t)row * D : p.in[I_CTX] + (size_t)(row - TL) * D;
        const int b = row < TL ? row / SEQ : 8;
        const float* sh = mod + (size_t)b * (6 * D); const float* sc = sh + D;
        f32x4 v[8]; float s = 0.f;
#pragma unroll
        for (int j = 0; j < 8; ++j) { v[j] = *(const f32x4*)(src + 4 * c.lane + 256 * j); s += (v[j][0] + v[j][1]) + (v[j][2] + v[j][3]); }
        const float mean = wave_sum(s) * (1.f / D); float s2 = 0.f;
#pragma unroll
        for (int j = 0; j < 8; ++j) { v[j] = v[j] - mean; s2 += (v[j][0] * v[j][0] + v[j][1] * v[j][1]) + (v[j][2] * v[j][2] + v[j][3] * v[j][3]); }
        const float rstd = __builtin_amdgcn_rsqf(wave_sum(s2) * (1.f / D) + LN_EPS);
#pragma unroll
        for (int j = 0; j < 8; ++j) { const int col = 4 * c.lane + 256 * j; const f32x4 a = *(const f32x4*)(sc + col), bb = *(const f32x4*)(sh + col);
            const f32x4 o = v[j] * rstd * (a + 1.0f) + bb;
            *(unsigned*)(U + (size_t)row * D + col) = pk_fp8x4(o[0], o[1], o[2], o[3]); }
    }
}

__device__ __forceinline__ void p3_conv(const Params& p, const Ctx& c) {
    const bf16* ZL = (const bf16*)(p.ws + WS_ZL); bf16* AC = (bf16*)(p.ws + WS_ACONV);
    LAS unsigned* tile = (LAS unsigned*)c.lds;
    for (int gr = c.bid; gr < TL / 64; gr += c.G) {
        const int row0 = gr * 64, c0 = 2 * c.tid;
#pragma unroll 4
        for (int i = 0; i < 16; ++i) { const int ch = c.tid + 512 * i, t = ch >> 7, cg = ch & 127;
            f32x4 a0, a1, g0, g1; unpack8(*(const u32x4*)(ZL + (size_t)(row0 + t) * ZN + 8 * cg), a0, a1); unpack8(*(const u32x4*)(ZL + (size_t)(row0 + t) * ZN + DCV + 8 * cg), g0, g1);
            *(LAS u32x4*)(tile + t * 512 + 4 * cg) = pg8::pack8(a0 * pg8::sig4(g0), a1 * pg8::sig4(g1)); }
        __syncthreads();
#pragma unroll 1
        for (int cc = 0; cc < 2; ++cc) {
            float w[CWID];
#pragma unroll
            for (int j = 0; j < CWID; ++j) w[j] = p.in[I_CONVW][j * DCV + c0 + cc];
            const float cb = p.in[I_CONVB][c0 + cc];
            float h[64];
#pragma unroll
            for (int t = 0; t < 64; ++t) { const unsigned a = tile[t * 512 + c.tid]; h[t] = cc ? bfhi(a) : bflo(a); }
#pragma clang loop unroll(full)
            for (int t = 0; t < 64; ++t) { float a = cb;
#pragma clang loop unroll(full)
                for (int j = 0; j < CWID; ++j) { const int tt = t + j - CWID / 2; if (tt >= 0 && tt < 64) a += w[j] * h[tt]; }
                ((LAS bf16*)tile)[t * DCV + c0 + cc] = (bf16)f2bf(a); }
        }
        __syncthreads();
        f32x4 g[4], bb[4];
#pragma unroll
        for (int q = 0; q < 4; ++q) { g[q] = *(const f32x4*)(p.in[I_CLNG] + 16 * c.lane + 4 * q); bb[q] = *(const f32x4*)(p.in[I_CLNB] + 16 * c.lane + 4 * q); }
#pragma unroll 2
        for (int i = 0; i < 8; ++i) { const int t = c.wave * 8 + i;
            const u32x4 r0 = *(const LAS u32x4*)(tile + t * 512 + 8 * c.lane), r1 = *(const LAS u32x4*)(tile + t * 512 + 8 * c.lane + 4);
            f32x4 v[4]; unpack8(r0, v[0], v[1]); unpack8(r1, v[2], v[3]);
            float s = 0.f;
#pragma unroll
            for (int q = 0; q < 4; ++q) s += (v[q][0] + v[q][1]) + (v[q][2] + v[q][3]);
            const float mean = wave_sum(s) * (1.f / DCV); float s2 = 0.f;
#pragma unroll
            for (int q = 0; q < 4; ++q) { v[q] = v[q] - mean; s2 += (v[q][0] * v[q][0] + v[q][1] * v[q][1]) + (v[q][2] * v[q][2] + v[q][3] * v[q][3]); }
            const float rstd = __builtin_amdgcn_rsqf(wave_sum(s2) * (1.f / DCV) + LN_EPS);
#pragma unroll
            for (int q = 0; q < 4; ++q) { v[q] = v[q] * rstd * g[q] + bb[q];
#pragma unroll
                for (int j = 0; j < 4; ++j) v[q][j] = v[q][j] * sigm(v[q][j]); }
            bf16* o = AC + (size_t)(row0 + t) * DCV + 16 * c.lane;
            *(u32x4*)o = pg8::pack8(v[0], v[1]); *(u32x4*)(o + 8) = pg8::pack8(v[2], v[3]); }
        __syncthreads();
    }
}
__device__ __forceinline__ void p3_alora(const Params& p, const Ctx& c) {
    const bf16* ZL = (const bf16*)(p.ws + WS_ZL); const bf16* ZC = (const bf16*)(p.ws + WS_ZC); bf16* AL = (bf16*)(p.ws + WS_ALORA3);
    const float* mu = p.in[I_SMU];
    for (int row = c.gw; row < TT; row += c.NGW) {
        const bool lat = row < TL; const int pitch = lat ? ZN : ZCN; const int len = lat ? SEQ : CTXL; const int t = lat ? row % SEQ : (row - TL) % CTXL;
        const bf16* zp = lat ? ZL + (size_t)row * ZN + ZR0 : ZC + (size_t)(row - TL) * ZCN;
        const bool hp = t > 0, hn = t < len - 1; const int po = hp ? pitch : 0, no = hn ? pitch : 0; const float mp = hp ? 1.f : 0.f, mn = hn ? 1.f : 0.f;
#pragma unroll
        for (int i = 0; i < 12; ++i) { const int g = i >> 2, kk = c.lane + 64 * (i & 3); float o = 0.f;
            const int nv = g == 2 ? 160 : 128;
            if (kk < nv) { const int col = 3072 + 128 * g + kk; const float z = bf1(zp[col]); const float pv = mp * bf1(zp[col - po]), nx = mn * bf1(zp[col + no]);
                const float zs = z + mu[col] * (pv - z) + mu[DSHIFT + col] * (nx - z);
                o = g == 0 ? (1.f - 2.f * __builtin_amdgcn_rcpf(__expf(2.f * zs) + 1.f)) : (g == 1 ? zs : sigm(zs)); }
            AL[((size_t)g * TT + row) * LORA_K + kk] = (bf16)f2bf(o); }
    }
}

constexpr int PH = 72, PT = 20, PM = 20;
constexpr int SB_XAH = 0, SB_XRH = SB_XAH + 16 * PH * 2, SB_XBH = SB_XRH + 16 * PH * 2, SB_XKH = SB_XBH + 16 * PH * 2, SB_XBT = SB_XKH + 16 * PH * 2, SB_XKT = SB_XBT + 64 * PT * 2,
              SB_V = SB_XKT + 64 * PT * 2, SB_GAM = SB_V + 4096, SB_MAK = SB_GAM + 256, SB_TT = SB_MAK + 16 * PM * 4, SB_MBR = SB_TT + 16 * PM * 4, SB_MKR = SB_MBR + 16 * PM * 4, SB_NS = SB_MKR + 16 * PM * 4, SLOT = SB_NS + 1024;
constexpr int SNB = 5, S_FULL = LX_MISC + 64, S_DONE = LX_MISC + 128;
static_assert(SNB * SLOT <= LDSX_OFF && SLOT % 16 == 0 && SB_V % 16 == 0 && SB_XBT % 16 == 0, "scan ring");
typedef float f32x4v __attribute__((ext_vector_type(4)));
__device__ __forceinline__ f32x4 mfma4(float a, float b, f32x4 c) { return __builtin_amdgcn_mfma_f32_16x16x4f32(a, b, c, 0, 0, 0); }
__device__ __forceinline__ void red8x4(float& a, float& b, float& c, float& d) {
#define R4(ctrl) "v_add_f32_dpp %0, %0, %0 " ctrl " row_mask:0xf bank_mask:0xf\n\tv_add_f32_dpp %1, %1, %1 " ctrl " row_mask:0xf bank_mask:0xf\n\tv_add_f32_dpp %2, %2, %2 " ctrl " row_mask:0xf bank_mask:0xf\n\t" \
               "v_add_f32_dpp %3, %3, %3 " ctrl " row_mask:0xf bank_mask:0xf\n\t"
    asm volatile("s_nop 1\n\t" R4("quad_perm:[1,0,3,2]") R4("quad_perm:[2,3,0,1]") R4("row_half_mirror") "s_nop 1" : "+v"(a), "+v"(b), "+v"(c), "+v"(d));
#undef R4
}
__device__ __forceinline__ float rdl63(float x) { return __builtin_bit_cast(float, __builtin_amdgcn_readlane(__builtin_bit_cast(int, x), 63)); }
#define WR_STEP(N, ctrl) WR_##N(ctrl)
#define WR_2(ctrl) "v_add_f32_dpp %0, %0, %0 " ctrl "\n\tv_add_f32_dpp %1, %1, %1 " ctrl "\n\ts_nop 0\n\t"
#define WR_4(ctrl) "v_add_f32_dpp %0, %0, %0 " ctrl "\n\tv_add_f32_dpp %1, %1, %1 " ctrl "\n\tv_add_f32_dpp %2, %2, %2 " ctrl "\n\tv_add_f32_dpp %3, %3, %3 " ctrl "\n\t"
#define WR_6(ctrl) WR_4(ctrl) "v_add_f32_dpp %4, %4, %4 " ctrl "\n\tv_add_f32_dpp %5, %5, %5 " ctrl "\n\t"
#define WR_ALL(N) "s_nop 1\n\t" WR_STEP(N, "quad_perm:[1,0,3,2] row_mask:0xf bank_mask:0xf") WR_STEP(N, "quad_perm:[2,3,0,1] row_mask:0xf bank_mask:0xf") WR_STEP(N, "row_half_mirror row_mask:0xf bank_mask:0xf") \
    WR_STEP(N, "row_mirror row_mask:0xf bank_mask:0xf") WR_STEP(N, "row_bcast:15 row_mask:0xa bank_mask:0xf") WR_STEP(N, "row_bcast:31 row_mask:0xc bank_mask:0xf") "s_nop 1"
__device__ __forceinline__ void wred2(float& a, float& b) { asm volatile(WR_ALL(2) : "+v"(a), "+v"(b)); a = rdl63(a); b = rdl63(b); }
__device__ __forceinline__ void wred4(float& a, float& b, float& c, float& d) { asm volatile(WR_ALL(4) : "+v"(a), "+v"(b), "+v"(c), "+v"(d));
    a = rdl63(a); b = rdl63(b); c = rdl63(c); d = rdl63(d); }
__device__ __forceinline__ void wred6(float& a, float& b, float& c, float& d, float& e, float& f) { asm volatile(WR_ALL(6) : "+v"(a), "+v"(b), "+v"(c), "+v"(d), "+v"(e), "+v"(f));
    a = rdl63(a); b = rdl63(b); c = rdl63(c); d = rdl63(d); e = rdl63(e); f = rdl63(f); }
struct ScanCoef { f32x4 a0, a1, b0, b1, k0, k1, r0, r1; f32x2 vv, cc; };
__device__ __forceinline__ ScanCoef scan_ld(const LAS unsigned char* sb, const LAS unsigned char* vb, const LAS unsigned char* cb) {
    ScanCoef o; o.a0 = *(const LAS f32x4*)(sb); o.a1 = *(const LAS f32x4*)(sb + 16); o.b0 = *(const LAS f32x4*)(sb + 256); o.b1 = *(const LAS f32x4*)(sb + 272);
    o.k0 = *(const LAS f32x4*)(sb + 512); o.k1 = *(const LAS f32x4*)(sb + 528); o.r0 = *(const LAS f32x4*)(sb + 768); o.r1 = *(const LAS f32x4*)(sb + 784);
    o.vv = *(const LAS f32x2*)(vb); o.cc = *(const LAS f32x2*)(cb); return o;
}
typedef unsigned short us2 __attribute__((ext_vector_type(2)));
struct ScanRaw { us2 zr[9], zk[9], zv[9], lw[8], la[8], lo[8]; };
template <int DIR>
__device__ __forceinline__ void scan_geom(int b, int ch, bool& lat, int& pitch, int& len, int& t0, size_t& rowbase) {
    lat = ch >= CTXL / SCH;
    const int m = lat ? (DIR ? NCHUNK - 1 - ch : ch - CTXL / SCH) : (DIR ? CTXL / SCH - 1 - ch : ch);
    pitch = lat ? ZN : ZCN; len = lat ? SEQ : CTXL; t0 = 16 * m;
    rowbase = lat ? (size_t)b * SEQ + t0 : (size_t)b * CTXL + t0;
}
template <int DIR>
__device__ __forceinline__ ScanRaw scan_prefetch(const Params& p, int b, int h, int ch, int lane) {
    const bf16* ZL = (const bf16*)(p.ws + WS_ZL); const bf16* ZC = (const bf16*)(p.ws + WS_ZC); const bf16* LO = (const bf16*)(p.ws + WS_LORA);
    bool lat; int pitch, len, t0; size_t rowbase; scan_geom<DIR>(b, ch, lat, pitch, len, t0, rowbase);
    const int hc = h * HS + lane;
    const bf16* zp = lat ? ZL + rowbase * ZN + ZR0 : ZC + rowbase * ZCN;
    const size_t lrow = lat ? rowbase : (size_t)TL + rowbase;
    ScanRaw r;
#pragma unroll
    for (int i = 0; i < 18; ++i) { const int t = t0 - 1 + i; const int tc = t < 0 ? 0 : (t >= len ? len - 1 : t);
        const bf16* q = zp + (ptrdiff_t)(tc - t0) * pitch;
        if (i & 1) { r.zr[i >> 1].y = q[hc]; r.zk[i >> 1].y = q[DR + hc]; r.zv[i >> 1].y = q[2 * DR + hc]; } else { r.zr[i >> 1].x = q[hc]; r.zk[i >> 1].x = q[DR + hc]; r.zv[i >> 1].x = q[2 * DR + hc]; } }
#pragma unroll
    for (int i = 0; i < 16; ++i) { const bf16* lp = LO + (lrow + i) * LORA_N + hc;
        if (i & 1) { r.lw[i >> 1].y = lp[DIR * DR]; r.la[i >> 1].y = lp[(2 + DIR) * DR]; r.lo[i >> 1].y = lp[(3 - DIR) * DR]; } else { r.lw[i >> 1].x = lp[DIR * DR]; r.la[i >> 1].x = lp[(2 + DIR) * DR]; r.lo[i >> 1].x = lp[(3 - DIR) * DR]; } }
    return r;
}
struct ScanPar { float mpr, mnr, mpk, mnk, mpv, mnv, kk_, ka_, rk_, w0d, a0d, a0o; };
__device__ __forceinline__ ScanPar scan_par(const Params& p, int h, int d, int lane) {
    const float* mu = p.in[I_SMU]; const int hc = h * HS + lane; ScanPar q;
    q.mpr = mu[hc]; q.mnr = mu[DSHIFT + hc]; q.mpk = mu[DR + hc]; q.mnk = mu[DSHIFT + DR + hc]; q.mpv = mu[2 * DR + hc]; q.mnv = mu[DSHIFT + 2 * DR + hc];
    q.kk_ = p.in[I_KK][hc]; q.ka_ = p.in[I_KA][hc]; q.rk_ = p.in[I_RK][hc];
    q.w0d = p.in[I_W0][d * DR + hc]; q.a0d = p.in[I_A0][d * DR + hc]; q.a0o = p.in[I_A0][(1 - d) * DR + hc]; return q;
}
template <int DIR>
__device__ __forceinline__ void scan_produce(const Params& p, const ScanPar& sp_, const ScanRaw& raw, int b, int h, int ch, LAS unsigned char* slot, int lane) {
    bf16* VS = (bf16*)(p.ws + WS_VS); float* RK = (float*)(p.ws + WS_RK);
    bool lat; int pitch, len, t0; size_t rowbase; scan_geom<DIR>(b, ch, lat, pitch, len, t0, rowbase);
    const int hc = h * HS + lane;
    const float mpr = sp_.mpr, mnr = sp_.mnr, mpk = sp_.mpk, mnk = sp_.mnk, mpv = sp_.mpv, mnv = sp_.mnv, kk_ = sp_.kk_, ka_ = sp_.ka_, rk_ = sp_.rk_, w0d = sp_.w0d, a0d = sp_.a0d, a0o = sp_.a0o;
    float zr[18], zk[18], zv[18];
#pragma unroll
    for (int i = 0; i < 18; ++i) { zr[i] = bf1((i & 1) ? raw.zr[i >> 1].y : raw.zr[i >> 1].x); zk[i] = bf1((i & 1) ? raw.zk[i >> 1].y : raw.zk[i >> 1].x); zv[i] = bf1((i & 1) ? raw.zv[i >> 1].y : raw.zv[i >> 1].x); }
    { const float m0 = (t0 > 0) ? 1.f : 0.f, m1 = (t0 + 16 < len) ? 1.f : 0.f;
      zr[0] *= m0; zk[0] *= m0; zv[0] *= m0; zr[17] *= m1; zk[17] *= m1; zv[17] *= m1; }
    bf16 lw[16], la[16], lo[16];
#pragma unroll
    for (int i = 0; i < 16; ++i) { lw[i] = (i & 1) ? raw.lw[i >> 1].y : raw.lw[i >> 1].x; la[i] = (i & 1) ? raw.la[i >> 1].y : raw.la[i >> 1].x; lo[i] = (i & 1) ? raw.lo[i >> 1].y : raw.lo[i >> 1].x; }
    LAS unsigned char* SL = slot;
    float gam = 1.f;
#pragma unroll
    for (int sp = 0; sp < 16; sp += 2) {
        float r[2], k[2], v[2], kr[2], n2[2];
#pragma unroll
        for (int e = 0; e < 2; ++e) { const int i = DIR ? 15 - (sp + e) : sp + e;
            r[e] = zr[i + 1] + mpr * (zr[i] - zr[i + 1]) + mnr * (zr[i + 2] - zr[i + 1]);
            k[e] = zk[i + 1] + mpk * (zk[i] - zk[i + 1]) + mnk * (zk[i + 2] - zk[i + 1]);
            v[e] = zv[i + 1] + mpv * (zv[i] - zv[i + 1]) + mnv * (zv[i + 2] - zv[i + 1]);
            kr[e] = k[e] * kk_; n2[e] = kr[e] * kr[e]; }
        wred2(n2[0], n2[1]);
        float rs[2];
#pragma unroll
        for (int e = 0; e < 2; ++e) { const int s = sp + e, i = DIR ? 15 - s : s;
            const float kk = kr[e] * __builtin_amdgcn_rsqf(fmaxf(n2[e], 1e-24f));
            const float aa = sigm(a0d + bf1(la[i])); const float w = __expf(-0.6065306597f * sigm(w0d + bf1(lw[i])));
            const float kd = k[e] * (1.f + (aa - 1.f) * ka_), bb = kk * aa;
            const float gprev = gam; gam *= w; const float inv = __builtin_amdgcn_rcpf(gam);
            { const bf16 ha = (bf16)f2bf(gprev * -kk), hr = (bf16)f2bf(gam * r[e]), hb = (bf16)f2bf(bb * inv), hk = (bf16)f2bf(kd * inv);
              ((LAS bf16*)(SL + SB_XAH))[s * PH + lane] = ha; ((LAS bf16*)(SL + SB_XRH))[s * PH + lane] = hr; ((LAS bf16*)(SL + SB_XBH))[s * PH + lane] = hb; ((LAS bf16*)(SL + SB_XKH))[s * PH + lane] = hk;
              ((LAS bf16*)(SL + SB_XBT))[lane * PT + s] = hb; ((LAS bf16*)(SL + SB_XKT))[lane * PT + s] = hk; ((LAS float*)(SL + SB_V))[s * 64 + lane] = v[e]; }
            rs[e] = 0.f;
            if (DIR == 0) { const float ao = sigm(a0o + bf1(lo[i])); const float kdo = k[e] * (1.f + (ao - 1.f) * ka_); rs[e] = r[e] * (kd + kdo) * rk_; } }
        if (DIR == 0 && lat) {
            wred2(rs[0], rs[1]);
#pragma unroll
            for (int e = 0; e < 2; ++e) { const int i = sp + e; if (lane == 0) RK[(rowbase + i) * NH + h] = rs[e]; VS[(rowbase + i) * DR + hc] = (bf16)f2bf(v[e]); } }
    }
    ((LAS float*)(SL + SB_GAM))[lane] = gam;
    asm volatile("s_waitcnt lgkmcnt(0)" ::: "memory");
    { const int rw = lane & 15, g = lane >> 4; LAS float* S = (LAS float*)SL; constexpr int SO_MAK = SB_MAK / 4, SO_MBR = SB_MBR / 4, SO_MKR = SB_MKR / 4, SO_NS = SB_NS / 4, SO_TT = SB_TT / 4;
      f32x4 mab = (f32x4){0.f, 0.f, 0.f, 0.f}, mak = mab, mbr = mab, mkr = mab;
#pragma unroll
      for (int m = 0; m < 2; ++m) { const int off = (rw * PH + 32 * m + 8 * g) * 2;
          const bf16x8 a8 = *(const LAS bf16x8*)(SL + SB_XAH + off), r8 = *(const LAS bf16x8*)(SL + SB_XRH + off), b8 = *(const LAS bf16x8*)(SL + SB_XBH + off), k8 = *(const LAS bf16x8*)(SL + SB_XKH + off);
          mab = __builtin_amdgcn_mfma_f32_16x16x32_bf16(b8, a8, mab, 0, 0, 0); mak = __builtin_amdgcn_mfma_f32_16x16x32_bf16(k8, a8, mak, 0, 0, 0);
          mbr = __builtin_amdgcn_mfma_f32_16x16x32_bf16(b8, r8, mbr, 0, 0, 0); mkr = __builtin_amdgcn_mfma_f32_16x16x32_bf16(k8, r8, mkr, 0, 0, 0); }
      f32x4 oab, oak, obr, okr;
#pragma unroll
      for (int i = 0; i < 4; ++i) { const int r = 4 * g + i; oab[i] = r < rw ? mab[i] : 0.f; oak[i] = r < rw ? mak[i] : 0.f; obr[i] = r <= rw ? mbr[i] : 0.f; okr[i] = r <= rw ? mkr[i] : 0.f; }
      *(LAS f32x4*)(S + SO_MAK + rw * PM + 4 * g) = oak; *(LAS f32x4*)(S + SO_MBR + rw * PM + 4 * g) = obr; *(LAS f32x4*)(S + SO_MKR + rw * PM + 4 * g) = okr;
#pragma unroll
      for (int i = 0; i < 4; ++i) S[SO_NS + (4 * g + i) * 16 + rw] = oab[i];
      asm volatile("s_waitcnt lgkmcnt(0)" ::: "memory");
      float tc[16];
#pragma unroll
      for (int r = 0; r < 16; ++r) tc[r] = (r == rw) ? 1.f : 0.f;
#pragma unroll
      for (int r = 14; r >= 0; --r) { float acc = tc[r]; int zdep; asm volatile("v_and_b32 %0, 0, %1" : "=v"(zdep) : "v"(tc[r + 1]));
#pragma unroll
          for (int q4 = (r + 1) / 4; q4 < 4; ++q4) { const f32x4 n4 = *(const LAS f32x4*)(S + SO_NS + r * 16 + 4 * q4 + zdep);
#pragma unroll
              for (int i = 0; i < 4; ++i) { const int rp = 4 * q4 + i; if (rp > r) acc += n4[i] * tc[rp]; } }
          tc[r] = acc; }
      if (g == 0) {
#pragma unroll
          for (int q4 = 0; q4 < 4; ++q4) *(LAS f32x4*)(S + SO_TT + rw * PM + 4 * q4) = (f32x4){tc[4 * q4], tc[4 * q4 + 1], tc[4 * q4 + 2], tc[4 * q4 + 3]}; }
    }
}
constexpr int S_CVT = LX_MISC + 192, CVT_PER_WG = (NE * (16 * 128 + 16 * 64)) / 256;
__device__ __forceinline__ bool scan_try_convert(const Params& p, const Ctx& c, bool enabled) {
    if (!enabled) return false;
    int idx = 0; if (c.lane == 0) idx = (int)__hip_atomic_fetch_add((LAS unsigned*)(c.lds + S_CVT), 1u, __ATOMIC_RELAXED, __HIP_MEMORY_SCOPE_WORKGROUP);
    idx = __builtin_amdgcn_readfirstlane(idx);
    if (idx >= CVT_PER_WG) return false;
    f32x4 v[16]; const CvtAddr ca = moe_cvt_addr(p, c.bid + c.G * idx, c.lane); moe_cvt_load(ca, v); moe_cvt_store(ca, v); return true;
}
__device__ __forceinline__ void p6_scan(const Params& p, const Ctx& c) {
    LAS unsigned char* L = c.lds; volatile LAS unsigned* full = (volatile LAS unsigned*)(L + S_FULL); volatile LAS unsigned* done = (volatile LAS unsigned*)(L + S_DONE);
    float* Y = (float*)(p.ws + WS_Y);
    for (int sid = c.bid; sid < NB * NH * 2; sid += c.G) {
        if (c.tid < 8) { full[c.tid] = 0u; done[c.tid] = 0u; }
        if (c.tid == 8 && sid == c.bid) *(LAS unsigned*)(L + S_CVT) = 0u;
        __syncthreads();
        const bool cvt_on = (c.G == 256);
        const int d = sid & 1, bh = sid >> 1, h = bh % NH, b = bh / NH;
        if (c.wave >= 4) {
            const int j = c.wave - 4;
            const ScanPar spar = scan_par(p, h, d, c.lane);
            ScanRaw raw = d ? scan_prefetch<1>(p, b, h, j, c.lane) : scan_prefetch<0>(p, b, h, j, c.lane);
            for (int ch = j; ch < NCHUNK; ch += 4) {
                const int buf = ch % SNB;
                if (ch >= SNB) { const unsigned want = 4u * (unsigned)(ch / SNB); unsigned sp = 0;
                    while (done[buf] < want) { __builtin_amdgcn_s_sleep(1); if (++sp > (1u << 24)) break; } }
                if (d) scan_produce<1>(p, spar, raw, b, h, ch, L + buf * SLOT, c.lane); else scan_produce<0>(p, spar, raw, b, h, ch, L + buf * SLOT, c.lane);
                asm volatile("s_waitcnt lgkmcnt(0)" ::: "memory");
                if (c.lane == 0) full[buf] = (unsigned)(ch + 1);
                { const int nc = ch + 4 < NCHUNK ? ch + 4 : ch; raw = d ? scan_prefetch<1>(p, b, h, nc, c.lane) : scan_prefetch<0>(p, b, h, nc, c.lane); }
            }
            while (scan_try_convert(p, c, cvt_on)) {}
        } else {
            const int vl = c.lane & 15, g = c.lane >> 4, w = c.wave;
            f32x4 sd[4];
#pragma unroll
            for (int kt = 0; kt < 4; ++kt) sd[kt] = (f32x4){0.f, 0.f, 0.f, 0.f};
            float* yb = Y + ((size_t)d * TL + (size_t)b * SEQ) * DR + h * HS + 16 * w + vl;
            for (int ch = 0; ch < NCHUNK; ++ch) {
                const int buf = ch % SNB; { unsigned sp = 0; while (full[buf] != (unsigned)(ch + 1)) { if (!scan_try_convert(p, c, cvt_on)) { __builtin_amdgcn_s_sleep(1); if (++sp > (1u << 24)) break; } } }
                const LAS unsigned char* SL = L + buf * SLOT; const LAS float* S = (const LAS float*)SL;
                constexpr int SO_V = SB_V / 4, SO_GAM = SB_GAM / 4, SO_MAK = SB_MAK / 4, SO_MBR = SB_MBR / 4, SO_MKR = SB_MKR / 4, SO_TT = SB_TT / 4;
                const bool lat = ch >= CTXL / SCH;
                f32x4 gt = (f32x4){0.f, 0.f, 0.f, 0.f}, ht = gt;
#pragma unroll
                for (int m = 0; m < 2; ++m) {
                    u32x4 sb; sb.x = cvt_pk_bf16(sd[2 * m][0], sd[2 * m][1]); sb.y = cvt_pk_bf16(sd[2 * m][2], sd[2 * m][3]); sb.z = cvt_pk_bf16(sd[2 * m + 1][0], sd[2 * m + 1][1]); sb.w = cvt_pk_bf16(sd[2 * m + 1][2], sd[2 * m + 1][3]);
                    const LAS bf16* pa = (const LAS bf16*)(SL + SB_XAH) + vl * PH + 32 * m + 4 * g; const LAS bf16* pr = (const LAS bf16*)(SL + SB_XRH) + vl * PH + 32 * m + 4 * g;
                    const u32x2 a0 = *(const LAS u32x2*)pa, a1 = *(const LAS u32x2*)(pa + 16), r0 = *(const LAS u32x2*)pr, r1 = *(const LAS u32x2*)(pr + 16);
                    const u32x4 av = (u32x4){a0.x, a0.y, a1.x, a1.y}, rv = (u32x4){r0.x, r0.y, r1.x, r1.y};
                    gt = __builtin_amdgcn_mfma_f32_16x16x32_bf16(__builtin_bit_cast(bf16x8, av), __builtin_bit_cast(bf16x8, sb), gt, 0, 0, 0);
                    ht = __builtin_amdgcn_mfma_f32_16x16x32_bf16(__builtin_bit_cast(bf16x8, rv), __builtin_bit_cast(bf16x8, sb), ht, 0, 0, 0); }
                f32x4 vt;
#pragma unroll
                for (int i = 0; i < 4; ++i) vt[i] = S[SO_V + (4 * g + i) * 64 + 16 * w + vl];
                { const f32x4 m4 = *(const LAS f32x4*)(S + SO_MAK + vl * PM + 4 * g);
#pragma unroll
                  for (int i = 0; i < 4; ++i) gt = mfma4(m4[i], vt[i], gt); }
                f32x4 ut = (f32x4){0.f, 0.f, 0.f, 0.f};
                { const f32x4 t4 = *(const LAS f32x4*)(S + SO_TT + vl * PM + 4 * g);
#pragma unroll
                  for (int i = 0; i < 4; ++i) ut = mfma4(t4[i], gt[i], ut); }
                if (lat) {
                    const f32x4 b4 = *(const LAS f32x4*)(S + SO_MBR + vl * PM + 4 * g), k4 = *(const LAS f32x4*)(S + SO_MKR + vl * PM + 4 * g);
#pragma unroll
                    for (int i = 0; i < 4; ++i) { ht = mfma4(b4[i], ut[i], ht); ht = mfma4(k4[i], vt[i], ht); }
#pragma unroll
                    for (int i = 0; i < 4; ++i) { const int P = ch * SCH + 4 * g + i - CTXL; const int t = d ? SEQ - 1 - P : P; yb[(size_t)t * DR] = ht[i]; }
                }
                { u32x4 ub; ub.x = cvt_pk_bf16(ut[0], ut[1]); ub.y = cvt_pk_bf16(ut[2], ut[3]); ub.z = cvt_pk_bf16(vt[0], vt[1]); ub.w = cvt_pk_bf16(vt[2], vt[3]);
#pragma unroll
                  for (int kt = 0; kt < 4; ++kt) {
                    const u32x2 xb = *(const LAS u32x2*)((const LAS bf16*)(SL + SB_XBT) + (16 * kt + vl) * PT + 4 * g), xk = *(const LAS u32x2*)((const LAS bf16*)(SL + SB_XKT) + (16 * kt + vl) * PT + 4 * g);
                    const u32x4 av = (u32x4){xb.x, xb.y, xk.x, xk.y};
                    sd[kt] = __builtin_amdgcn_mfma_f32_16x16x32_bf16(__builtin_bit_cast(bf16x8, av), __builtin_bit_cast(bf16x8, ub), sd[kt], 0, 0, 0);
                    sd[kt] *= *(const LAS f32x4*)(S + SO_GAM + 16 * kt + 4 * g); } }
                asm volatile("s_waitcnt lgkmcnt(0)" ::: "memory");
                if (c.lane == 0) __hip_atomic_fetch_add((LAS unsigned*)(L + S_DONE) + buf, 1u, __ATOMIC_RELAXED, __HIP_MEMORY_SCOPE_WORKGROUP);
            }
            while (scan_try_convert(p, c, cvt_on)) {}
        }
        __syncthreads();
    }
}

__device__ __forceinline__ void p7_rwkvout(const Params& p, const Ctx& c) {
    const float* Y = (const float*)(p.ws + WS_Y); const float* RK = (const float*)(p.ws + WS_RK); const bf16* VS = (const bf16*)(p.ws + WS_VS);
    const bf16* LO = (const bf16*)(p.ws + WS_LORA); bf16* AR = (bf16*)(p.ws + WS_ARWKV);
    const int c0 = 16 * c.lane, hd = c.lane >> 2;
    f32x4 g[4], bb[4];
#pragma unroll
    for (int q = 0; q < 4; ++q) { g[q] = *(const f32x4*)(p.in[I_LNXG] + c0 + 4 * q); bb[q] = *(const f32x4*)(p.in[I_LNXB] + c0 + 4 * q); }
    for (int row = c.gw; row < TL; row += c.NGW) {
        f32x4 y[4]; float s = 0.f;
#pragma unroll
        for (int q = 0; q < 4; ++q) { y[q] = *(const f32x4*)(Y + (size_t)row * DR + c0 + 4 * q) + *(const f32x4*)(Y + ((size_t)TL + row) * DR + c0 + 4 * q); s += (y[q][0] + y[q][1]) + (y[q][2] + y[q][3]); }
        s += __shfl_xor(s, 1); s += __shfl_xor(s, 2); const float mean = s * (1.f / HS); float s2 = 0.f;
#pragma unroll
        for (int q = 0; q < 4; ++q) { y[q] = y[q] - mean; s2 += (y[q][0] * y[q][0] + y[q][1] * y[q][1]) + (y[q][2] * y[q][2] + y[q][3] * y[q][3]); }
        s2 += __shfl_xor(s2, 1); s2 += __shfl_xor(s2, 2); const float rstd = __builtin_amdgcn_rsqf(s2 * (1.f / HS) + GN_EPS);
        const float rk = RK[(size_t)row * NH + hd];
        f32x4 v[4], gt[4];
        unpack8(*(const u32x4*)(VS + (size_t)row * DR + c0), v[0], v[1]); unpack8(*(const u32x4*)(VS + (size_t)row * DR + c0 + 8), v[2], v[3]);
        unpack8(*(const u32x4*)(LO + (size_t)row * LORA_N + 4 * DR + c0), gt[0], gt[1]); unpack8(*(const u32x4*)(LO + (size_t)row * LORA_N + 4 * DR + c0 + 8), gt[2], gt[3]);
#pragma unroll
        for (int q = 0; q < 4; ++q) y[q] = (y[q] * rstd * g[q] + bb[q] + v[q] * rk) * gt[q];
        bf16* o = AR + (size_t)row * DR + c0; *(u32x4*)o = pg8::pack8(y[0], y[1]); *(u32x4*)(o + 8) = pg8::pack8(y[2], y[3]);
    }
}

constexpr int RT_PITCH = 4096 + 16, RT_LO = 16 * RT_PITCH, RT_PART = LDSX_OFF + 2048;
static_assert(2 * RT_LO <= LDSX_OFF && RT_PART + 4 * 2048 <= LDS_BYTES, "router LDS map");
__device__ __forceinline__ void p10_router(const Params& p, const Ctx& c) {
    const float* T1 = (const float*)(p.ws + WS_T1); float* XM = (float*)(p.ws + WS_XMID);
    const float* mod = (const float*)(p.ws + WS_MOD); const bf16* WRt = (const bf16*)(p.ws + WS_WR); unsigned char* U8 = p.ws + WS_U2F8;
    unsigned* cntg = (unsigned*)(p.ws + WS_CTL) + CW_CNT; int* rowtok = (int*)(p.ws + WS_ROWTOK); float* roww = (float*)(p.ws + WS_ROWW); unsigned* sel = (unsigned*)(p.ws + WS_SEL);
    LAS unsigned char* L = c.lds;
    for (int un = c.bid; un < TL / 64; un += c.G) {
        const int r0 = un * 64, b = r0 / SEQ;
        const float* sh = mod + (size_t)b * (6 * D) + 3 * D; const float* sc = sh + D;
        for (int g = 0; g < 4; ++g) {
            for (int i = 0; i < 2; ++i) { const int tl = 2 * c.wave + i, row = r0 + 16 * g + tl;
                f32x4 v[8]; float s = 0.f;
#pragma unroll
                for (int j = 0; j < 8; ++j) { v[j] = *(const f32x4*)(T1 + (size_t)row * D + 4 * c.lane + 256 * j); s += (v[j][0] + v[j][1]) + (v[j][2] + v[j][3]); }
                float mean = wave_sum(s) * (1.f / D), s2 = 0.f;
#pragma unroll
                for (int j = 0; j < 8; ++j) { v[j] = v[j] - mean; s2 += (v[j][0] * v[j][0] + v[j][1] * v[j][1]) + (v[j][2] * v[j][2] + v[j][3] * v[j][3]); }
                float rstd = __builtin_amdgcn_rsqf(wave_sum(s2) * (1.f / D) + LN_EPS); s = 0.f;
#pragma unroll
                for (int j = 0; j < 8; ++j) { const int col = 4 * c.lane + 256 * j; v[j] = v[j] * rstd * *(const f32x4*)(p.in[I_LN1G] + col) + *(const f32x4*)(p.in[I_LN1B] + col);
                    *(f32x4*)(XM + (size_t)row * D + col) = v[j]; s += (v[j][0] + v[j][1]) + (v[j][2] + v[j][3]); }
                mean = wave_sum(s) * (1.f / D); s2 = 0.f;
#pragma unroll
                for (int j = 0; j < 8; ++j) { v[j] = v[j] - mean; s2 += (v[j][0] * v[j][0] + v[j][1] * v[j][1]) + (v[j][2] * v[j][2] + v[j][3] * v[j][3]); }
                rstd = __builtin_amdgcn_rsqf(wave_sum(s2) * (1.f / D) + LN_EPS);
#pragma unroll
                for (int j = 0; j < 8; ++j) { const int col = 4 * c.lane + 256 * j; const f32x4 o = v[j] * rstd * (*(const f32x4*)(sc + col) + 1.0f) + *(const f32x4*)(sh + col);
                    u32x2 hi; hi.x = cvt_pk_bf16(o[0], o[1]); hi.y = cvt_pk_bf16(o[2], o[3]);
                    u32x2 lo; lo.x = cvt_pk_bf16(o[0] - bflo(hi.x), o[1] - bfhi(hi.x)); lo.y = cvt_pk_bf16(o[2] - bflo(hi.y), o[3] - bfhi(hi.y));
                    *(LAS u32x2*)(L + tl * RT_PITCH + 2 * col) = hi; *(LAS u32x2*)(L + RT_LO + tl * RT_PITCH + 2 * col) = lo;
                    *(unsigned*)(U8 + (size_t)row * D + col) = pk_fp8x4(o[0], o[1], o[2], o[3]); }
            }
            __syncthreads();
            if (c.wave < 4) {
                const int t = c.lane & 15, kq = 8 * (c.lane >> 4), k0 = 512 * c.wave;
                f32x4 acc0 = (f32x4){0.f, 0.f, 0.f, 0.f}, acc1 = acc0;
                const LAS unsigned char* ah = L + t * RT_PITCH + 2 * (k0 + kq); const LAS unsigned char* al = ah + RT_LO;
                const bf16* bh0 = WRt + (size_t)t * D + k0 + kq; const bf16* bh1 = bh0 + 16 * D; const bf16* bl0 = bh0 + NE * D; const bf16* bl1 = bl0 + 16 * D;
#pragma unroll 4
                for (int s = 0; s < 16; ++s) {
                    const bf16x8 xh = *(const LAS bf16x8*)(ah + 64 * s), xl = *(const LAS bf16x8*)(al + 64 * s);
                    const bf16x8 wh0 = *(const bf16x8*)(bh0 + 32 * s), wh1 = *(const bf16x8*)(bh1 + 32 * s), wl0 = *(const bf16x8*)(bl0 + 32 * s), wl1 = *(const bf16x8*)(bl1 + 32 * s);
                    acc0 = __builtin_amdgcn_mfma_f32_16x16x32_bf16(xh, wh0, acc0, 0, 0, 0); acc1 = __builtin_amdgcn_mfma_f32_16x16x32_bf16(xh, wh1, acc1, 0, 0, 0);
                    acc0 = __builtin_amdgcn_mfma_f32_16x16x32_bf16(xl, wh0, acc0, 0, 0, 0); acc1 = __builtin_amdgcn_mfma_f32_16x16x32_bf16(xl, wh1, acc1, 0, 0, 0);
                    acc0 = __builtin_amdgcn_mfma_f32_16x16x32_bf16(xh, wl0, acc0, 0, 0, 0); acc1 = __builtin_amdgcn_mfma_f32_16x16x32_bf16(xh, wl1, acc1, 0, 0, 0);
                }
                LAS float* pw = (LAS float*)(L + RT_PART + c.wave * 2048);
#pragma unroll
                for (int i = 0; i < 4; ++i) { const int tk = (c.lane >> 4) * 4 + i; pw[tk * 32 + (c.lane & 15)] = acc0[i]; pw[tk * 32 + 16 + (c.lane & 15)] = acc1[i]; }
            }
            __syncthreads();
            if (c.wave == 0 && c.lane < 16) {
                float l[32];
#pragma unroll
                for (int q = 0; q < 8; ++q) { f32x4 tq = *(const f32x4*)(p.in[I_BROUTER] + 4 * q);
#pragma unroll
                    for (int w = 0; w < 4; ++w) tq += *(const LAS f32x4*)(L + RT_PART + w * 2048 + (c.lane * 32 + 4 * q) * 4);
                    l[4 * q] = tq[0]; l[4 * q + 1] = tq[1]; l[4 * q + 2] = tq[2]; l[4 * q + 3] = tq[3]; }
                unsigned used = 0u; float tv[4]; int ti[4];
#pragma unroll
                for (int s = 0; s < 4; ++s) { float best = -3.0e38f; int bi = 0;
#pragma unroll
                    for (int e = 0; e < 32; ++e) { const bool ok = !((used >> e) & 1u) && (l[e] > best); best = ok ? l[e] : best; bi = ok ? e : bi; }
                    used |= 1u << bi; tv[s] = best; ti[s] = bi; }
                const float e1 = __expf(tv[1] - tv[0]), e2 = __expf(tv[2] - tv[0]), e3 = __expf(tv[3] - tv[0]); const float inv = 1.f / (1.f + e1 + e2 + e3);
                const float gw[4] = {inv, e1 * inv, e2 * inv, e3 * inv};
                const int row = r0 + 16 * g + c.lane;
#pragma unroll
                for (int s = 0; s < 4; ++s) { const unsigned j = __hip_atomic_fetch_add(cntg + 16 * ti[s], 1u, RLX_AGENT);
                    rowtok[(size_t)ti[s] * ECAP + j] = row; roww[(size_t)ti[s] * ECAP + j] = gw[s]; sel[row * 4 + s] = ((unsigned)ti[s] << 16) | j; }
            }
        }
        __syncthreads();
    }
}
__device__ __forceinline__ void moe_plan(const Params& p, const Ctx& c) {
    LAS int* cnt = (LAS int*)(c.lds + LX_CNT); LAS int* tst = (LAS int*)(c.lds + LX_TST); LAS unsigned char* te = (LAS unsigned char*)(c.lds + LX_TE);
    const unsigned* cntg = (const unsigned*)(p.ws + WS_CTL) + CW_CNT;
    __syncthreads();
    if (c.tid < NE) cnt[c.tid] = (int)__hip_atomic_load(cntg + 16 * c.tid, RLX_AGENT);
    __syncthreads();
    if (c.tid == 0) { int a = 0; for (int e = 0; e < NE; ++e) { tst[e] = a; a += (cnt[e] + 255) >> 8; } tst[NE] = a; }
    __syncthreads();
    if (c.tid < NE) { for (int t = tst[c.tid]; t < tst[c.tid + 1]; ++t) te[t] = (unsigned char)c.tid; }
    __syncthreads();
}
__device__ __forceinline__ float half_sum(float v) {
#pragma unroll
    for (int o = 1; o < 32; o <<= 1) v += __shfl_xor(v, o);
    return v;
}
__device__ __forceinline__ void p13_final(const Params& p, const Ctx& c) {
    const float* XM = (const float*)(p.ws + WS_XMID); const unsigned char* DN = p.ws + WS_DOWN; const unsigned* sel = (const unsigned*)(p.ws + WS_SEL);
    const float* mod = (const float*)(p.ws + WS_MOD); const LAS int* tst = (const LAS int*)(c.lds + LX_TST);
    const int hl = c.lane & 31, hw = c.lane >> 5;
    for (int rp = c.gw; rp < TL / 2; rp += c.NGW) {
        const int row = 2 * rp + hw;
        const int b = row / SEQ; const float* gate = mod + (size_t)b * (6 * D) + 5 * D;
        size_t pos[4];
#pragma unroll
        for (int s = 0; s < 4; ++s) { const unsigned sv = sel[row * 4 + s]; pos[s] = (size_t)tst[(int)(sv >> 16)] * 256 + (sv & 0xffffu); }
        f32x4 a[8][2];
#pragma unroll
        for (int j = 0; j < 8; ++j) { a[j][0] = (f32x4){0.f, 0.f, 0.f, 0.f}; a[j][1] = a[j][0]; }
#pragma unroll
        for (int s = 0; s < 4; ++s)
#pragma unroll
            for (int j = 0; j < 8; ++j) { const u32x2 w = *(const u32x2*)(DN + pos[s] * D + 8 * hl + 256 * j);
                const f32x2 p0 = __builtin_amdgcn_cvt_pk_f32_fp8((int)w.x, false), p1 = __builtin_amdgcn_cvt_pk_f32_fp8((int)w.x, true), p2 = __builtin_amdgcn_cvt_pk_f32_fp8((int)w.y, false), p3 = __builtin_amdgcn_cvt_pk_f32_fp8((int)w.y, true);
                a[j][0] += (f32x4){p0.x, p0.y, p1.x, p1.y}; a[j][1] += (f32x4){p2.x, p2.y, p3.x, p3.y}; }
        float sm = 0.f;
#pragma unroll
        for (int j = 0; j < 8; ++j)
#pragma unroll
            for (int hh = 0; hh < 2; ++hh) { const int col = 8 * hl + 256 * j + 4 * hh; a[j][hh] = *(const f32x4*)(XM + (size_t)row * D + col) * DN_ALPHA + *(const f32x4*)(gate + col) * (a[j][hh] * (1.0f / DN8_SCALE));
                sm += (a[j][hh][0] + a[j][hh][1]) + (a[j][hh][2] + a[j][hh][3]); }
        const float mean = half_sum(sm) * (1.f / D); float s2 = 0.f;
#pragma unroll
        for (int j = 0; j < 8; ++j)
#pragma unroll
            for (int hh = 0; hh < 2; ++hh) { a[j][hh] = a[j][hh] - mean; s2 += (a[j][hh][0] * a[j][hh][0] + a[j][hh][1] * a[j][hh][1]) + (a[j][hh][2] * a[j][hh][2] + a[j][hh][3] * a[j][hh][3]); }
        const float rstd = __builtin_amdgcn_rsqf(half_sum(s2) * (1.f / D) + LN_EPS);
#pragma unroll
        for (int j = 0; j < 8; ++j)
#pragma unroll
            for (int hh = 0; hh < 2; ++hh) { const int col = 8 * hl + 256 * j + 4 * hh;
                *(f32x4*)(p.out + (size_t)row * D + col) = a[j][hh] * rstd * *(const f32x4*)(p.in[I_LN2G] + col) + *(const f32x4*)(p.in[I_LN2B] + col); }
    }
}

constexpr int N_PHASES = 14;
__global__ void __launch_bounds__(512, 2) fwd(Params p) {
    extern __shared__ __attribute__((aligned(16))) unsigned char lds_raw[];
    Ctx c; c.lds = (LAS unsigned char*)lds_raw; c.tid = threadIdx.x; c.lane = c.tid & 63; c.wave = __builtin_amdgcn_readfirstlane(c.tid >> 6);
    c.G = gridDim.x; c.bid = blockIdx.x; c.gw = c.bid * 8 + c.wave; c.NGW = c.G * 8;
    unsigned char* ws = p.ws;
    const int lo = p.ph_lo, hi = p.ph_hi;
    volatile LAS unsigned* MISC = (volatile LAS unsigned*)(c.lds + LX_MISC);
    if (c.tid < 64) MISC[c.tid] = 0u;
    __syncthreads();
    XcdBarrier bar; bar.bar = (unsigned*)(ws + WS_CTL) + CW_BAR; bar.x = 0; bar.st = nullptr;
    if (hi - lo > 1) bar = xcd_barrier_post((unsigned*)(ws + WS_CTL) + CW_BAR, MISC + 8);
#ifndef ONLY_PHASE
#define ONLY_PHASE -1
#endif
#define IN(k) ((ONLY_PHASE < 0 || ONLY_PHASE == (k)) && lo <= (k) && (k) < hi)
#define SEAM(k) do { if (IN(k) && IN((k) + 1)) xcd_barrier(bar); } while (0)
    LAS unsigned char* ring = c.lds;

#ifndef DUP_MASK
#define DUP_MASK 0
#endif
#define PH(k, ...) do { if (IN(k)) { __VA_ARGS__ if constexpr (((DUP_MASK) >> (k)) & 1) { if (hi - lo > 1) xcd_barrier(bar); __VA_ARGS__ } } SEAM(k); } while (0)
    PH(0, { p0_adaln(p, c); p0_small(p, c); p0_convert(p, c); if (!CONV_IN_SCAN || c.G != 256) moe_convert(p, c.gw, c.NGW, c.lane); });
    PH(1, { p1_modulate(p, c); });
    PH(2, { pg8::InProjSched S{(const bf16*)(ws + WS_U), (const bf16*)(ws + WS_WIN), c.G, c.bid};
        pg8::EpiInProj E{(bf16*)(ws + WS_ZL), (bf16*)(ws + WS_ZC), (const float*)(ws + WS_BIN)};
        pg8::gemm_phase<pg8::EpiInProj, pg8::InProjSched, false, true>(ring, D / 2, S, E, nullptr); });
    PH(3, { p3_conv(p, c); p3_alora(p, c); });
    PH(4, {
        { pg8::LoraSched S{(const bf16*)(ws + WS_ALORA3), (const bf16*)(ws + WS_WLORA), c.G, c.bid};
          pg8::EpiBf16Plain E{(bf16*)(ws + WS_LORA), LORA_N, nullptr};
          int kl = LORA_K; asm volatile("" : "+s"(kl));
          pg8::gemm_phase<pg8::EpiBf16Plain, pg8::LoraSched, false>(ring, kl, S, E, nullptr); }
        { pg8::PlainSched S{(const bf16*)(ws + WS_ACONV), (const bf16*)(ws + WS_WCO), DCV, TL / 256, D / 256, c.G, c.bid};
          pg8::EpiConvO E{(bf16*)(ws + WS_MIX), (const bf16*)(ws + WS_ZL), p.in[I_BCO]};
          pg8::gemm_phase<pg8::EpiConvO, pg8::PlainSched, false>(ring, DCV, S, E, nullptr); }
    });
    PH(6, { p6_scan(p, c); });
    PH(7, { p7_rwkvout(p, c); });
    PH(8, { pg8::PlainSched S{(const bf16*)(ws + WS_ARWKV), (const bf16*)(ws + WS_WRO), DR, TL / 256, D / 256, c.G, c.bid};
        pg8::EpiRwkvO E{(bf16*)(ws + WS_MIX), (const bf16*)(ws + WS_ZL)};
        pg8::gemm_phase<pg8::EpiRwkvO, pg8::PlainSched, false>(ring, DR, S, E, nullptr); });
    PH(9, { pg8::PlainSched S{(const bf16*)(ws + WS_MIX), (const bf16*)(ws + WS_WOUT), D, TL / 256, D / 256, c.G, c.bid};
        pg8::EpiOut E{(float*)(ws + WS_T1), p.in[I_X], (const float*)(ws + WS_MOD), p.in[I_BOUT]};
        pg8::gemm_phase<pg8::EpiOut, pg8::PlainSched, false>(ring, D, S, E, nullptr); });
    PH(10, { p10_router(p, c); });
    PH(11, { moe_plan(p, c);
        pg8::MoeSched S{nullptr, (const bf16*)(ws + WS_WGU), (const int*)(ws + WS_ROWTOK), D / 2, 4096, 16, c.G, c.bid, (const LAS int*)(c.lds + LX_CNT), (const LAS int*)(c.lds + LX_TST), (const LAS unsigned char*)(c.lds + LX_TE)};
        pg8::EpiGateUp E{ws + WS_HID, (const float*)(ws + WS_BGU)};
        pg8::gemm_phase<pg8::EpiGateUp, pg8::MoeSched, true, true>(ring, D / 2, S, E, (const char*)(ws + WS_U2F8)); });
    PH(12, { moe_plan(p, c);
        pg8::MoeSched S{(const bf16*)(ws + WS_HID), (const bf16*)(ws + WS_WDN), (const int*)(ws + WS_ROWTOK), D / 2, D, 8, c.G, c.bid, (const LAS int*)(c.lds + LX_CNT), (const LAS int*)(c.lds + LX_TST), (const LAS unsigned char*)(c.lds + LX_TE)};
        pg8::EpiDown E{ws + WS_DOWN, p.in[I_BDN], (const float*)(ws + WS_ROWW), (const LAS int*)(c.lds + LX_CNT)};
        pg8::gemm_phase<pg8::EpiDown, pg8::MoeSched, false, true>(ring, D / 2, S, E, nullptr); });
    PH(13, { moe_plan(p, c); p13_final(p, c); });
#undef PH
#undef IN
#undef SEAM
}

extern "C" void kernel_launch(void* const* d_in, const int* in_sizes, int n_in, void* d_out, int out_size, void* d_ws, size_t ws_size, hipStream_t stream) {
    static int grid = 0;
    if (grid == 0) {
        if (n_in != 38 || out_size != TL * D || ws_size < WS_END) { fprintf(stderr, "kernel_launch: unexpected shapes: n_in %d out %d ws %zu (need %zu)\n", n_in, out_size, ws_size, (size_t)WS_END); grid = -1; return; }
        int dev = 0, cus = 0, per_cu = 0;
        if (hipGetDevice(&dev) != hipSuccess || hipDeviceGetAttribute(&cus, hipDeviceAttributeMultiprocessorCount, dev) != hipSuccess) { grid = -1; return; }
        if (hipFuncSetAttribute((const void*)fwd, hipFuncAttributeMaxDynamicSharedMemorySize, LDS_BYTES) != hipSuccess) { fprintf(stderr, "kernel_launch: hipFuncSetAttribute failed\n"); grid = -1; return; }
        if (hipOccupancyMaxActiveBlocksPerMultiprocessor(&per_cu, (const void*)fwd, 512, LDS_BYTES) != hipSuccess || per_cu < 1) { fprintf(stderr, "kernel_launch: occupancy query says %d\n", per_cu); }
        (void)hipGetLastError();
        grid = cus;
    }
    if (grid < 0) return;
    (void)in_sizes;
    (void)hipMemsetAsync((char*)d_ws + WS_CTL, 0, CTL_ZERO_BYTES, stream);
    Params p; memset(&p, 0, sizeof(p));
    for (int i = 0; i < 38; ++i) p.in[i] = (const float*)d_in[i];
    p.out = (float*)d_out; p.ws = (unsigned char*)d_ws;
#if MK_FUSED
    p.ph_lo = 0; p.ph_hi = N_PHASES;
    hipLaunchKernelGGL(fwd, dim3(grid), dim3(512), LDS_BYTES, stream, p);
#else
    for (int k = 0; k < N_PHASES; ++k) { p.ph_lo = k; p.ph_hi = k + 1; hipLaunchKernelGGL(fwd, dim3(grid), dim3(512), LDS_BYTES, stream, p); }
#endif
}
```

```cpp
#include <hip/hip_runtime.h>
#include <cstdio>
#include <cstdint>
#include <cstring>

#ifndef CONV_IN_SCAN
#define CONV_IN_SCAN 1
#endif
#ifndef MK_FUSED
#define MK_FUSED 1
#endif

#define GAS __attribute__((address_space(1)))
#define LAS __attribute__((address_space(3)))
typedef unsigned short bf16;
typedef short bf16x8 __attribute__((ext_vector_type(8)));
typedef float f32x4 __attribute__((ext_vector_type(4)));
typedef float f32x2 __attribute__((ext_vector_type(2)));
typedef unsigned u32x4 __attribute__((ext_vector_type(4)));
typedef unsigned u32x2 __attribute__((ext_vector_type(2)));
typedef int v8i __attribute__((ext_vector_type(8)));
typedef int v4i __attribute__((ext_vector_type(4)));
typedef short v2s __attribute__((ext_vector_type(2)));

constexpr int D = 2048, NB = 8, SEQ = 2048, CTXL = 256, TL = NB * SEQ, TC = NB * CTXL, TT = TL + TC;
constexpr int DCV = 1024, DR = 1024, NH = 16, HS = 64, CWID = 31;
constexpr int DSHIFT = 3488, PIN = 9632;
constexpr int ZN = 9728, ZCN = 3584, ZR0 = 2048, ZG0 = 5632;
constexpr int NE = 32, ECAP = 16384, MAXMT = 288;
constexpr int LORA_K = 256, LORA_N = 5120;
constexpr int SCH = 16, NCHUNK = (CTXL + SEQ) / SCH;
constexpr float LN_EPS = 1e-5f, GN_EPS = 64e-5f, DN_ALPHA = 1.189207115002721f;
constexpr float SW_LIMIT = 7.0f, SW_ALPHA = 1.702f;
constexpr float W8_SCALE = 64.0f, W8_INV = 1.0f / 64.0f;
constexpr int SC_W8 = 0x79797979, SC_ONE = 0x7F7F7F7F;
constexpr float DN8_SCALE = 16.0f;

constexpr size_t MiB = 1u << 20;
constexpr size_t WS_CTL = 0, CTL_ZERO_BYTES = 32768;
constexpr size_t WS_MOD = 1 * MiB, WS_BIN = 2 * MiB, WS_BGU = 2 * MiB + 65536, WS_WR = 3 * MiB, WS_SEL = 4 * MiB, WS_RK = 5 * MiB;
constexpr size_t WS_ROWTOK = 6 * MiB, WS_ROWW = 8 * MiB, WS_WCO = 10 * MiB, WS_WRO = 14 * MiB, WS_WOUT = 18 * MiB, WS_WLORA = 26 * MiB;
constexpr size_t WS_WIN = 32 * MiB, WS_U = 70 * MiB, WS_ACONV = 142 * MiB, WS_ALORA = 174 * MiB, WS_ARWKV = 192 * MiB, WS_VS = 224 * MiB;
constexpr size_t WS_MIX = 256 * MiB, WS_U2HI = 320 * MiB, WS_U2LO = 384 * MiB, WS_T1 = 448 * MiB, WS_XMID = 576 * MiB, WS_Y = 704 * MiB;
constexpr size_t WS_ZC = 832 * MiB, WS_LORA = 848 * MiB, WS_ZL = 1028 * MiB, WS_SC = 1332 * MiB, WS_WGU = 1728 * MiB, WS_WDN = 2240 * MiB;
constexpr size_t WS_U2F8 = 1332 * MiB, WS_ALORA3 = 1364 * MiB;
constexpr size_t WS_HID = 2496 * MiB, WS_DOWN = 2784 * MiB, WS_END = 3072 * MiB;
constexpr int CW_BAR = 4096;
constexpr int CW_CNT = 1024;

constexpr int RING_BYTES = 131072;
constexpr int LDSX_OFF = 145408;
constexpr int LX_MISC = LDSX_OFF;
constexpr int LX_CNT = LDSX_OFF + 256;
constexpr int LX_TST = LDSX_OFF + 512;
constexpr int LX_TE = LDSX_OFF + 768;
constexpr int LDS_BYTES = 163840;

__device__ __forceinline__ unsigned f2bf(float f) { unsigned u = __builtin_bit_cast(unsigned, f); return (u + 0x7fffu + ((u >> 16) & 1u)) >> 16; }
__device__ __forceinline__ unsigned cvt_pk_bf16(float lo, float hi) { unsigned r; asm volatile("v_cvt_pk_bf16_f32 %0, %1, %2" : "=v"(r) : "v"(lo), "v"(hi)); return r; }
__device__ __forceinline__ float clamp448(float x) { return fminf(fmaxf(x, -448.f), 448.f); }
__device__ __forceinline__ unsigned pk_fp8x4(float a, float b, float c, float d) {
    unsigned w = 0u; w = (unsigned)__builtin_amdgcn_cvt_pk_fp8_f32(clamp448(a), clamp448(b), (int)w, false); w = (unsigned)__builtin_amdgcn_cvt_pk_fp8_f32(clamp448(c), clamp448(d), (int)w, true); return w; }
__device__ __forceinline__ unsigned pk_fp8x4_nc(float a, float b, float c, float d) {
    unsigned w = 0u; w = (unsigned)__builtin_amdgcn_cvt_pk_fp8_f32(a, b, (int)w, false); w = (unsigned)__builtin_amdgcn_cvt_pk_fp8_f32(c, d, (int)w, true); return w; }
__device__ __forceinline__ unsigned pk_fp8x4_w(float a, float b, float c, float d) {
    v2s r = {0, 0}; r = __builtin_amdgcn_cvt_scalef32_pk_fp8_f32(r, a, b, W8_INV, false); r = __builtin_amdgcn_cvt_scalef32_pk_fp8_f32(r, c, d, W8_INV, true);
    return __builtin_bit_cast(unsigned, r); }
__device__ __forceinline__ float bflo(unsigned u) { return __builtin_bit_cast(float, u << 16); }
__device__ __forceinline__ float bfhi(unsigned u) { return __builtin_bit_cast(float, u & 0xffff0000u); }
__device__ __forceinline__ float bf1(bf16 h) { return __builtin_bit_cast(float, ((unsigned)h) << 16); }
__device__ __forceinline__ float sigm(float x) { return __builtin_amdgcn_rcpf(1.f + __expf(-x)); }
__device__ __forceinline__ float wave_sum(float v) {
#pragma unroll
    for (int o = 1; o < 64; o <<= 1) v += __shfl_xor(v, o);
    return v;
}
#define RLX_AGENT __ATOMIC_RELAXED, __HIP_MEMORY_SCOPE_AGENT

#define XB_TMO      128
#define XB_XCNT(j)  (256  + 64 * (j))
#define XB_XSUB(j)  (1280 + 64 * (j))
#define XB_XGEN(j)  (2304 + 64 * (j))
#define XB_TOP      3328
#define XB_TOPGEN   3392
#define XCD_BAR_WORDS 3456
#define XB_SPIN_CAP (1u << 22)
__device__ __forceinline__ unsigned xb_ld(unsigned* p)              { return __hip_atomic_load(p, __ATOMIC_RELAXED, __HIP_MEMORY_SCOPE_AGENT); }
__device__ __forceinline__ unsigned xb_add(unsigned* p, unsigned v) { return __hip_atomic_fetch_add(p, v, __ATOMIC_RELAXED, __HIP_MEMORY_SCOPE_AGENT); }
__device__ __forceinline__ unsigned xb_xcc_id() { return (unsigned)__builtin_amdgcn_s_getreg((3 << 11) | 20) & 0xFu; }
#define XB_SPIN(cond, bar) do { unsigned _sp = 0; while (cond) { __builtin_amdgcn_s_sleep(1); \
    if ((++_sp & 255u) == 0u) { if (xb_ld(&(bar)[XB_TMO])) break; if (_sp > XB_SPIN_CAP) { atomicAdd(&(bar)[XB_TMO], 1u); break; } } } } while (0)
struct XcdBarrier { unsigned* bar; unsigned x; volatile LAS unsigned* st; };
__device__ __forceinline__ XcdBarrier xcd_barrier_post(unsigned* bar, volatile LAS unsigned* st) {
    XcdBarrier b; b.bar = bar; b.x = xb_xcc_id(); b.st = st;
    if (threadIdx.x == 0) (void)xb_add(&bar[XB_XCNT(b.x)], 1u);
    return b;
}
__device__ __forceinline__ void xcd_barrier_complete(unsigned* bar, unsigned x, unsigned& nloc, unsigned& nx) {
    const unsigned G = gridDim.x * gridDim.y * gridDim.z;
    unsigned sum, cnt, mine, sp = 0u;
    for (;;) {
        sum = 0u; cnt = 0u; mine = 0u;
#pragma unroll
        for (unsigned j = 0; j < 16; ++j) { const unsigned c = xb_ld(&bar[XB_XCNT(j)]); sum += c; cnt += (c > 0u) ? 1u : 0u; mine = (j == x) ? c : mine; }
        if (sum == G) break;
        __builtin_amdgcn_s_sleep(1);
        if ((++sp & 255u) == 0u) { if (xb_ld(&bar[XB_TMO])) break; if (sp > XB_SPIN_CAP) { atomicAdd(&bar[XB_TMO], 1u); break; } }
    }
    nloc = mine > 0u ? mine : 1u; nx = cnt > 0u ? cnt : 1u;
}
__device__ __forceinline__ void xcd_barrier(const XcdBarrier& b) {
    asm volatile("s_waitcnt vmcnt(0)" ::: "memory");
    __syncthreads();
    if (threadIdx.x == 0) {
        unsigned* bar = b.bar;
        __builtin_amdgcn_s_waitcnt(0);
        unsigned nloc = b.st[0], nx = b.st[1];
        if (nloc == 0u) { xcd_barrier_complete(bar, b.x, nloc, nx); b.st[0] = nloc; b.st[1] = nx; }
        const unsigned old = xb_add(&bar[XB_XSUB(b.x)], 1u);
        const unsigned gen = old / nloc;
        if (old + 1u == (gen + 1u) * nloc) {
            __builtin_amdgcn_fence(__ATOMIC_RELEASE, "agent");
            asm volatile("s_waitcnt vmcnt(0)" ::: "memory");
            const unsigned og = xb_add(&bar[XB_TOP], 1u);
            const unsigned tg = og / nx;
            if (og + 1u == (tg + 1u) * nx) xb_add(&bar[XB_TOPGEN], 1u);
            else XB_SPIN(xb_ld(&bar[XB_TOPGEN]) == tg, bar);
            __builtin_amdgcn_fence(__ATOMIC_ACQUIRE, "agent");
            xb_add(&bar[XB_XGEN(b.x)], 1u);
            asm volatile("s_waitcnt vmcnt(0)" ::: "memory");
        } else {
            XB_SPIN(xb_ld(&bar[XB_XGEN(b.x)]) == gen, bar);
            __builtin_amdgcn_fence(__ATOMIC_ACQUIRE, "agent");
            asm volatile("s_waitcnt vmcnt(0)" ::: "memory");
        }
    }
    __syncthreads();
}

namespace pg8 {
constexpr int BM = 256, BK = 64, HALF = 128, HTB = HALF * BK * 2, STAGE_BYTES = 8 * HTB, NXCD = 8, WGM = 8;
__host__ __device__ __forceinline__ int lds_byte(int r, int c) { const int st = (r >> 4) * 2 + (c >> 5), rr = r & 15, cc = c & 31, ob = rr * 64 + cc * 2; return st * 1024 + (ob ^ (((ob >> 9) & 1) << 5)); }
__host__ __device__ __forceinline__ void stage_rc(int b, int& R, int& C) { const int st = b / 1024, sb = b % 1024, swz = sb ^ (((sb >> 9) & 1) << 5); R = (st >> 1) * 16 + swz / 64; C = (st & 1) * 32 + (swz % 64) / 2; }
__host__ __device__ __forceinline__ int perm32(int rho) { const int n = rho >> 4, i = rho & 15; return 8 * (i >> 2) + 4 * n + (i & 3); }

struct Unit { int pm, pn, e, lt; };
__device__ __forceinline__ void map_tile(int wgid, int nwg, int nM, int nN, int& pm, int& pn) {
    { const int q = nwg / NXCD, r = nwg % NXCD, xcd = wgid % NXCD, off = wgid / NXCD; wgid = (xcd < r ? xcd * (q + 1) : r * (q + 1) + (xcd - r) * q) + off; }
    const int nig = WGM * nN, gid = wgid / nig, fm = gid * WGM, gsz = (nM - fm) < WGM ? (nM - fm) : WGM;
    pm = fm + ((wgid % nig) % gsz); pn = (wgid % nig) / gsz;
}
struct PlainSched {
    const bf16* A; const bf16* Bt; int K, nM, nN, G, c;
    __device__ __forceinline__ bool next(int i, Unit& u) const { const long L = (long)i * G + c; if (L >= (long)nM * nN) return false; map_tile((int)L, nM * nN, nM, nN, u.pm, u.pn); u.e = 0; u.lt = 0; return true; }
    __device__ __forceinline__ const char* aptr(const Unit& u) const { return (const char*)A + (size_t)u.pm * BM * K * 2; }
    __device__ __forceinline__ const char* bptr(const Unit& u) const { return (const char*)Bt + (size_t)u.pn * BM * K * 2; }
    __device__ __forceinline__ void rows(const Unit&, const int (&)[2], const int (&)[2], unsigned (&)[2][2]) const {}
    __device__ __forceinline__ void rows_issue(const Unit&, const int (&)[2], int (&)[2][2]) const {}
    __device__ __forceinline__ void rows_finish(const int (&)[2][2], const int (&)[2], unsigned (&)[2][2]) const {}
};
struct LoraSched {
    const bf16* A; const bf16* Bt; int G, c;
    __device__ __forceinline__ bool next(int i, Unit& u) const { const int L = i * G + c; constexpr int NU = (TT / 256) * (LORA_N / 256); if (L >= NU) return false; map_tile(L, NU, TT / 256, LORA_N / 256, u.pm, u.pn); u.e = u.pn < 8 ? 0 : (u.pn < 16 ? 1 : 2); u.lt = 0; return true; }
    __device__ __forceinline__ const char* aptr(const Unit& u) const { return (const char*)A + (unsigned)((u.e * TT + u.pm * BM) * (LORA_K * 2)); }
    __device__ __forceinline__ const char* bptr(const Unit& u) const { return (const char*)Bt + (unsigned)(u.pn * BM * LORA_K * 2); }
    __device__ __forceinline__ void rows(const Unit&, const int (&)[2], const int (&)[2], unsigned (&)[2][2]) const {}
    __device__ __forceinline__ void rows_issue(const Unit&, const int (&)[2], int (&)[2][2]) const {}
    __device__ __forceinline__ void rows_finish(const int (&)[2][2], const int (&)[2], unsigned (&)[2][2]) const {}
};
struct InProjSched {
    const bf16* A; const bf16* Bt; int G, c;
    __device__ __forceinline__ bool next(int i, Unit& u) const {
        const int L = i * G + c; constexpr int NL = 64 * 38, NCX = 8 * 14;
        if (L >= NL + NCX) return false;
        if (L < NL) map_tile(L, NL, 64, 38, u.pm, u.pn); else { map_tile(L - NL, NCX, 8, 14, u.pm, u.pn); u.pm += 64; u.pn += 8; }
        u.e = 0; u.lt = 0; return true; }
    __device__ __forceinline__ const char* aptr(const Unit& u) const { return (const char*)A + (size_t)u.pm * BM * D; }
    __device__ __forceinline__ const char* bptr(const Unit& u) const { return (const char*)Bt + (size_t)u.pn * BM * D; }
    __device__ __forceinline__ void rows(const Unit&, const int (&)[2], const int (&)[2], unsigned (&)[2][2]) const {}
    __device__ __forceinline__ void rows_issue(const Unit&, const int (&)[2], int (&)[2][2]) const {}
    __device__ __forceinline__ void rows_finish(const int (&)[2][2], const int (&)[2], unsigned (&)[2][2]) const {}
};
struct MoeSched {
    const bf16* A; const bf16* Bt; const int* rowtok; int K, N, nN, G, c; const LAS int* cnt; const LAS int* tst; const LAS unsigned char* te;
    __device__ __forceinline__ bool next(int i, Unit& u) const { const int nM = tst[NE]; const int L = i * G + c; if (L >= nM * nN) return false;
        map_tile(L, nM * nN, nM, nN, u.pm, u.pn); u.e = te[u.pm]; u.lt = u.pm - tst[u.e]; return true; }
    __device__ __forceinline__ const char* aptr(const Unit& u) const { return (const char*)A + (size_t)u.pm * BM * K * 2; }
    __device__ __forceinline__ const char* bptr(const Unit& u) const { return (const char*)Bt + ((size_t)u.e * N + (size_t)u.pn * BM) * K * 2; }
    __device__ __forceinline__ void rows(const Unit& u, const int (&sR)[2], const int (&sC2)[2], unsigned (&g)[2][2]) const {
        const int n = cnt[u.e]; const int* rt = rowtok + (size_t)u.e * ECAP;
#pragma unroll
        for (int h = 0; h < 2; ++h)
#pragma unroll
            for (int i = 0; i < 2; ++i) { const int j = u.lt * BM + h * HALF + sR[i]; const int tok = (j < n) ? rt[j] : 0; g[h][i] = (unsigned)tok * (unsigned)(K * 2) + (unsigned)sC2[i]; }
        asm volatile("s_waitcnt vmcnt(0)" ::: "memory");
    }
    __device__ __forceinline__ void rows_issue(const Unit& u, const int (&sR)[2], int (&tok)[2][2]) const {
        const int n = cnt[u.e]; const int* rt = rowtok + (size_t)u.e * ECAP;
#pragma unroll
        for (int h = 0; h < 2; ++h)
#pragma unroll
            for (int i = 0; i < 2; ++i) { const int j = u.lt * BM + h * HALF + sR[i]; const int tk = rt[j < n ? j : 0]; tok[h][i] = (j < n) ? tk : 0; }
    }
    __device__ __forceinline__ void rows_finish(const int (&tok)[2][2], const int (&sC2)[2], unsigned (&g)[2][2]) const {
#pragma unroll
        for (int h = 0; h < 2; ++h)
#pragma unroll
            for (int i = 0; i < 2; ++i) g[h][i] = (unsigned)tok[h][i] * (unsigned)(K * 2) + (unsigned)sC2[i];
    }
};

template <class Epi, class Sched, bool GATHER, bool F8 = false>
__device__ __forceinline__ void gemm_phase(LAS unsigned char* lds, const int K, const Sched& S, const Epi& E, const char* gatherA) {
    const int tid = threadIdx.x, wid = __builtin_amdgcn_readfirstlane(tid >> 6), lane = tid & 63, wr = wid >> 2, wc = wid & 3, fr = lane & 15, fq = lane >> 4;
    const int nt = K / BK;
    unsigned voffA[2], voffB[2]; int sR[2], sC2[2];
#pragma unroll
    for (int i = 0; i < 2; ++i) { int R, C; stage_rc(tid * 16 + i * 8192, R, C); const int Rb = Epi::PERM ? ((R & ~31) + perm32(R & 31)) : R;
        voffA[i] = (unsigned)(R * K + C) * 2u; voffB[i] = (unsigned)(Rb * K + C) * 2u; sR[i] = R; sC2[i] = C * 2; }
    const size_t kstep = (size_t)(BK * 2);
    const size_t hstep = (size_t)HALF * K * 2;
    const unsigned ldsw = (unsigned)wid * 1024u;
    const int aoff = lds_byte(wr * 64 + fr, fq * 8), boff = lds_byte(wc * 32 + fr, fq * 8);
#define PG8_SA(b, h) (((b) * 2 + (h)) * HTB)
#define PG8_SB(b, h) ((4 + (b) * 2 + (h)) * HTB)
#define PG8_STAGE(bufoff, gbase, voff) do { _Pragma("unroll") for (int _i = 0; _i < 2; ++_i) \
        __builtin_amdgcn_global_load_lds((const unsigned*)((const char*)(gbase) + (voff)[_i]), (LAS unsigned*)(lds + (bufoff) + ldsw + _i * 8192), 16, 0, 0); } while (0)
#define PG8_STG_A(bufoff, gbase, h, OFF) do { if constexpr (GATHER) { PG8_STAGE(bufoff, gbase, OFF); } else { PG8_STAGE(bufoff, (gbase) + (h) * hstep, voffA); } } while (0)
#define PG8_CAT(p0, p1) __builtin_shufflevector(*(const LAS v4i*)(p0), *(const LAS v4i*)(p1), 0, 1, 2, 3, 4, 5, 6, 7)
#define PG8_LDA(dst, b, h) do { _Pragma("unroll") for (int m = 0; m < 4; ++m) { if constexpr (F8) dst##8[m] = PG8_CAT(lds + PG8_SA(b, h) + aoff + m * 2048, lds + PG8_SA(b, h) + aoff + m * 2048 + 1024); \
        else { _Pragma("unroll") for (int k = 0; k < 2; ++k) dst[m][k] = *(const LAS bf16x8*)(lds + PG8_SA(b, h) + aoff + m * 2048 + k * 1024); } } } while (0)
#define PG8_LDB(dst, b, h) do { _Pragma("unroll") for (int n = 0; n < 2; ++n) { if constexpr (F8) dst##8[n] = PG8_CAT(lds + PG8_SB(b, h) + boff + n * 2048, lds + PG8_SB(b, h) + boff + n * 2048 + 1024); \
        else { _Pragma("unroll") for (int k = 0; k < 2; ++k) dst[n][k] = *(const LAS bf16x8*)(lds + PG8_SB(b, h) + boff + n * 2048 + k * 1024); } } } while (0)
#define PG8_MMA(ai, bj, At, Bt) do { __builtin_amdgcn_s_setprio(1); _Pragma("unroll") for (int m = 0; m < 4; ++m) _Pragma("unroll") for (int n = 0; n < 2; ++n) { \
        if constexpr (F8) asm volatile("v_mfma_scale_f32_16x16x128_f8f6f4 %0, %1, %2, %0, %3, %4 op_sel_hi:[0,0,0]" : "+v"(acc[ai][bj][m][n]) : "v"(Bt##8[n]), "v"(At##8[m]), "v"(scw8), "v"(sca8)); \
        else { _Pragma("unroll") for (int k = 0; k < 2; ++k) acc[ai][bj][m][n] = __builtin_amdgcn_mfma_f32_16x16x32_bf16(Bt[n][k], At[m][k], acc[ai][bj][m][n], 0, 0, 0); } } __builtin_amdgcn_s_setprio(0); } while (0)
#define PG8_WAIT_V(n) asm volatile("s_waitcnt vmcnt(" #n ")" ::: "memory")
#define PG8_WAIT_L(n) asm volatile("s_waitcnt lgkmcnt(" #n ")" ::: "memory")
#define PG8_BAR __builtin_amdgcn_s_barrier()
#define PG8_SCHED __builtin_amdgcn_sched_barrier(0)
    Unit cur, nxt; int ui = 0;
    if (!S.next(0, cur)) return;
    f32x4 acc[2][2][4][2];
#pragma unroll
    for (int a = 0; a < 2; ++a)
#pragma unroll
        for (int b = 0; b < 2; ++b)
#pragma unroll
            for (int m = 0; m < 4; ++m)
#pragma unroll
                for (int n = 0; n < 2; ++n) acc[a][b][m][n] = (f32x4){0.f, 0.f, 0.f, 0.f};
    bf16x8 At[4][2], B0[2][2], B1[2][2]; v8i At8[4], B08[2], B18[2]; const int scw8 = SC_W8, sca8 = SC_ONE;
    const char* cA = GATHER ? gatherA : S.aptr(cur); const char* cB = S.bptr(cur);
    unsigned gA[2][2] = {{0u, 0u}, {0u, 0u}}, gA1[2] = {0u, 0u}, gN[2][2] = {{0u, 0u}, {0u, 0u}};
    if constexpr (GATHER) S.rows(cur, sR, sC2, gA);
    PG8_STAGE(PG8_SB(0, 0), cB, voffB); PG8_STAGE(PG8_SB(0, 1), cB + hstep, voffB); PG8_STG_A(PG8_SA(0, 0), cA, 0, gA[0]); PG8_STG_A(PG8_SA(0, 1), cA, 1, gA[1]);
    if (wr == 1) PG8_BAR;
    PG8_WAIT_V(2); PG8_BAR;
    PG8_STAGE(PG8_SB(1, 0), cB + kstep, voffB); PG8_STG_A(PG8_SA(1, 0), cA + kstep, 0, gA[0]); PG8_STAGE(PG8_SB(1, 1), cB + hstep + kstep, voffB);
    PG8_WAIT_V(6); PG8_BAR;
    for (;;) {
        const bool has_next = S.next(ui + 1, nxt);
        const char* nA = GATHER ? gatherA : (has_next ? S.aptr(nxt) : cA); const char* nB = has_next ? S.bptr(nxt) : cB;
        for (int t = 0; t < nt; t += 2) {
            const bool last = (t == nt - 2);
            const char* a1 = cA + (size_t)(t + 1) * kstep;
            const char* a2 = last ? nA : cA + (size_t)(t + 2) * kstep; const char* b2 = last ? nB : cB + (size_t)(t + 2) * kstep;
            const char* a3 = a2 + kstep; const char* b3 = b2 + kstep;
            int tkn[2][2];
            if constexpr (GATHER) { gA1[0] = gA[1][0]; gA1[1] = gA[1][1];
                if (t == 0 && has_next) S.rows_issue(nxt, sR, tkn);
                if (last && has_next) { gA[0][0] = gN[0][0]; gA[0][1] = gN[0][1]; gA[1][0] = gN[1][0]; gA[1][1] = gN[1][1]; } }
            PG8_LDB(B0, 0, 0); PG8_LDB(B1, 0, 1); PG8_SCHED; PG8_LDA(At, 0, 0); PG8_STG_A(PG8_SA(1, 1), a1, 1, gA1);
            PG8_WAIT_V(8); PG8_WAIT_L(0); PG8_BAR; PG8_MMA(0, 0, At, B0); PG8_MMA(0, 1, At, B1); PG8_BAR; PG8_SCHED;
            PG8_LDA(At, 0, 1); PG8_STAGE(PG8_SB(0, 0), b2, voffB); PG8_STAGE(PG8_SB(0, 1), b2 + hstep, voffB); PG8_STG_A(PG8_SA(0, 0), a2, 0, gA[0]);
            PG8_WAIT_V(8); PG8_WAIT_L(0); PG8_BAR; PG8_MMA(1, 0, At, B0); PG8_MMA(1, 1, At, B1); PG8_BAR; PG8_SCHED;
            PG8_LDB(B0, 1, 0); PG8_LDB(B1, 1, 1); PG8_SCHED; PG8_LDA(At, 1, 0); PG8_STG_A(PG8_SA(0, 1), a2, 1, gA[1]);
            PG8_WAIT_V(8); PG8_WAIT_L(0); PG8_BAR; PG8_MMA(0, 0, At, B0); PG8_MMA(0, 1, At, B1); PG8_BAR; PG8_SCHED;
            PG8_LDA(At, 1, 1); PG8_STAGE(PG8_SB(1, 0), b3, voffB); PG8_STAGE(PG8_SB(1, 1), b3 + hstep, voffB); PG8_STG_A(PG8_SA(1, 0), a3, 0, gA[0]);
            PG8_WAIT_V(8); PG8_WAIT_L(0); PG8_BAR; PG8_MMA(1, 0, At, B0); PG8_MMA(1, 1, At, B1); PG8_BAR; PG8_SCHED;
            if constexpr (GATHER) { if (t == 0 && has_next) S.rows_finish(tkn, sC2, gN); }
        }
        if (wr == 0) PG8_BAR;
        if constexpr (F8) asm volatile("s_nop 7\n\ts_nop 7\n\ts_nop 7" ::: "memory");
        E(acc, cur, wr, wc, fr, fq);
        if (!has_next) break;
#pragma unroll
        for (int a = 0; a < 2; ++a)
#pragma unroll
            for (int b = 0; b < 2; ++b)
#pragma unroll
                for (int m = 0; m < 4; ++m)
#pragma unroll
                    for (int n = 0; n < 2; ++n) acc[a][b][m][n] = (f32x4){0.f, 0.f, 0.f, 0.f};
        cur = nxt; cA = nA; cB = nB; ++ui;
        if (wr == 1) PG8_BAR;
    }
    PG8_WAIT_V(0);
    PG8_BAR;
#undef PG8_SA
#undef PG8_SB
#undef PG8_STAGE
#undef PG8_STG_A
#undef PG8_LDA
#undef PG8_CAT
#undef PG8_LDB
#undef PG8_MMA
#undef PG8_WAIT_V
#undef PG8_WAIT_L
#undef PG8_BAR
#undef PG8_SCHED
}

typedef const f32x4 (&AccT)[2][2][4][2];
__device__ __forceinline__ u32x4 pack8(f32x4 v0, f32x4 v1) { u32x4 w; w.x = cvt_pk_bf16(v0[0], v0[1]); w.y = cvt_pk_bf16(v0[2], v0[3]); w.z = cvt_pk_bf16(v1[0], v1[1]); w.w = cvt_pk_bf16(v1[2], v1[3]); return w; }
__device__ __forceinline__ void unpack8(u32x4 w, f32x4& v0, f32x4& v1) { v0 = (f32x4){bflo(w.x), bfhi(w.x), bflo(w.y), bfhi(w.y)}; v1 = (f32x4){bflo(w.z), bfhi(w.z), bflo(w.w), bfhi(w.w)}; }
__device__ __forceinline__ f32x4 sig4(f32x4 v) { return (f32x4){sigm(v[0]), sigm(v[1]), sigm(v[2]), sigm(v[3])}; }

struct EpiBf16Plain {
    static constexpr bool PERM = true;
    bf16* O; int ldc; const float* bias;
    __device__ __forceinline__ void operator()(AccT acc, const Unit& u, int wr, int wc, int fr, int fq) const {
        const int row0 = u.pm * BM + wr * 64 + fr, col0 = u.pn * BM + wc * 32 + 8 * fq;
        f32x4 bv[2][2];
#pragma unroll
        for (int bj = 0; bj < 2; ++bj)
#pragma unroll
            for (int n = 0; n < 2; ++n) bv[bj][n] = bias ? *(const f32x4*)(bias + col0 + bj * HALF + 4 * n) : (f32x4){0.f, 0.f, 0.f, 0.f};
#pragma unroll
        for (int ai = 0; ai < 2; ++ai)
#pragma unroll
            for (int m = 0; m < 4; ++m) { bf16* rowp = O + (size_t)(row0 + ai * HALF + m * 16) * ldc + col0;
#pragma unroll
                for (int bj = 0; bj < 2; ++bj) *(u32x4*)(rowp + bj * HALF) = pack8(acc[ai][bj][m][0] + bv[bj][0], acc[ai][bj][m][1] + bv[bj][1]); }
    }
};
struct EpiInProj {
    static constexpr bool PERM = true;
    bf16* ZL; bf16* ZC; const float* bias;
    __device__ __forceinline__ void operator()(AccT acc, const Unit& u, int wr, int wc, int fr, int fq) const {
        const int row0 = u.pm * BM + wr * 64 + fr, col0 = u.pn * BM + wc * 32 + 8 * fq;
        f32x4 bv[2][2];
#pragma unroll
        for (int bj = 0; bj < 2; ++bj)
#pragma unroll
            for (int n = 0; n < 2; ++n) bv[bj][n] = *(const f32x4*)(bias + col0 + bj * HALF + 4 * n);
        const bool lat = u.pm < 64;
#pragma unroll
        for (int ai = 0; ai < 2; ++ai)
#pragma unroll
            for (int m = 0; m < 4; ++m) { const int r = row0 + ai * HALF + m * 16;
                bf16* rowp = lat ? ZL + (size_t)r * ZN + col0 : ZC + (size_t)(r - TL) * ZCN + (col0 - ZR0);
#pragma unroll
                for (int bj = 0; bj < 2; ++bj) *(u32x4*)(rowp + bj * HALF) = pack8(acc[ai][bj][m][0] + bv[bj][0], acc[ai][bj][m][1] + bv[bj][1]); }
    }
};
struct EpiConvO {
    static constexpr bool PERM = true;
    bf16* MIX; const bf16* ZL; const float* bias;
    __device__ __forceinline__ void operator()(AccT acc, const Unit& u, int wr, int wc, int fr, int fq) const {
        const int row0 = u.pm * BM + wr * 64 + fr, col0 = u.pn * BM + wc * 32 + 8 * fq;
        f32x4 bv[2][2];
#pragma unroll
        for (int bj = 0; bj < 2; ++bj)
#pragma unroll
            for (int n = 0; n < 2; ++n) bv[bj][n] = *(const f32x4*)(bias + col0 + bj * HALF + 4 * n);
#pragma unroll
        for (int ai = 0; ai < 2; ++ai)
#pragma unroll
            for (int m = 0; m < 4; ++m) { const size_t r = (size_t)(row0 + ai * HALF + m * 16);
#pragma unroll
                for (int bj = 0; bj < 2; ++bj) { const int c = col0 + bj * HALF; f32x4 g0, g1; unpack8(*(const u32x4*)(ZL + r * ZN + ZG0 + c), g0, g1);
                    *(u32x4*)(MIX + r * D + c) = pack8(sig4(g0) * (acc[ai][bj][m][0] + bv[bj][0]), sig4(g1) * (acc[ai][bj][m][1] + bv[bj][1])); } }
    }
};
struct EpiRwkvO {
    static constexpr bool PERM = true;
    bf16* MIX; const bf16* ZL;
    __device__ __forceinline__ void operator()(AccT acc, const Unit& u, int wr, int wc, int fr, int fq) const {
        const int row0 = u.pm * BM + wr * 64 + fr, col0 = u.pn * BM + wc * 32 + 8 * fq;
#pragma unroll
        for (int ai = 0; ai < 2; ++ai)
#pragma unroll
            for (int m = 0; m < 4; ++m) { const size_t r = (size_t)(row0 + ai * HALF + m * 16);
#pragma unroll
                for (int bj = 0; bj < 2; ++bj) { const int c = col0 + bj * HALF; f32x4 g0, g1, m0, m1; unpack8(*(const u32x4*)(ZL + r * ZN + ZG0 + D + c), g0, g1); unpack8(*(const u32x4*)(MIX + r * D + c), m0, m1);
                    *(u32x4*)(MIX + r * D + c) = pack8(m0 + sig4(g0) * acc[ai][bj][m][0], m1 + sig4(g1) * acc[ai][bj][m][1]); } }
    }
};
struct EpiOut {
    static constexpr bool PERM = true;
    float* T1; const float* x; const float* mod; const float* bias;
    __device__ __forceinline__ void operator()(AccT acc, const Unit& u, int wr, int wc, int fr, int fq) const {
        const int row0 = u.pm * BM + wr * 64 + fr, col0 = u.pn * BM + wc * 32 + 8 * fq;
        const float* gate = mod + (size_t)(u.pm / 8) * (6 * D) + 2 * D;
        f32x4 bv[2][2], gv[2][2];
#pragma unroll
        for (int bj = 0; bj < 2; ++bj)
#pragma unroll
            for (int n = 0; n < 2; ++n) { bv[bj][n] = *(const f32x4*)(bias + col0 + bj * HALF + 4 * n); gv[bj][n] = *(const f32x4*)(gate + col0 + bj * HALF + 4 * n); }
#pragma unroll
        for (int ai = 0; ai < 2; ++ai)
#pragma unroll
            for (int m = 0; m < 4; ++m) { const size_t off = (size_t)(row0 + ai * HALF + m * 16) * D + col0;
#pragma unroll
                for (int bj = 0; bj < 2; ++bj)
#pragma unroll
                    for (int n = 0; n < 2; ++n) { const f32x4 xv = *(const f32x4*)(x + off + bj * HALF + 4 * n);
                        *(f32x4*)(T1 + off + bj * HALF + 4 * n) = xv * DN_ALPHA + gv[bj][n] * (acc[ai][bj][m][n] + bv[bj][n]); } }
    }
};
struct EpiGateUp {
    static constexpr bool PERM = true;
    unsigned char* HID; const float* bias;
    __device__ __forceinline__ void operator()(AccT acc, const Unit& u, int wr, int wc, int fr, int fq) const {
        const int row0 = u.pm * BM + wr * 64 + fr, cb = u.pn * BM + wc * 32 + 8 * fq, co = u.pn * HALF + wc * 32 + 8 * fq;
        const float* bp = bias + (size_t)u.e * 4096 + cb;
        f32x4 bv[2][2];
#pragma unroll
        for (int bj = 0; bj < 2; ++bj)
#pragma unroll
            for (int n = 0; n < 2; ++n) bv[bj][n] = *(const f32x4*)(bp + bj * HALF + 4 * n);
#pragma unroll
        for (int ai = 0; ai < 2; ++ai)
#pragma unroll
            for (int m = 0; m < 4; ++m) { f32x4 h[2];
#pragma unroll
                for (int n = 0; n < 2; ++n) { const f32x4 g = acc[ai][0][m][n] + bv[0][n], up = acc[ai][1][m][n] + bv[1][n];
#pragma unroll
                    for (int j = 0; j < 4; ++j) { const float gg = fminf(g[j], SW_LIMIT), uu = fminf(fmaxf(up[j], -SW_LIMIT), SW_LIMIT); h[n][j] = (uu + 1.0f) * (gg * sigm(SW_ALPHA * gg)); } }
                u32x2 o; o.x = pk_fp8x4_nc(h[0][0], h[0][1], h[0][2], h[0][3]); o.y = pk_fp8x4_nc(h[1][0], h[1][1], h[1][2], h[1][3]);
                *(u32x2*)(HID + (size_t)(row0 + ai * HALF + m * 16) * D + co) = o; }
    }
};
struct EpiDown {
    static constexpr bool PERM = true;
    unsigned char* DOWN; const float* bias; const float* roww; const LAS int* cnt;
    __device__ __forceinline__ void operator()(AccT acc, const Unit& u, int wr, int wc, int fr, int fq) const {
        const int rl0 = wr * 64 + fr, col0 = u.pn * BM + wc * 32 + 8 * fq; const int n_e = cnt[u.e];
        const float* bp = bias + (size_t)u.e * D + col0; const float* rw = roww + (size_t)u.e * ECAP + u.lt * BM;
        f32x4 bv[2][2];
#pragma unroll
        for (int bj = 0; bj < 2; ++bj)
#pragma unroll
            for (int n = 0; n < 2; ++n) bv[bj][n] = *(const f32x4*)(bp + bj * HALF + 4 * n);
#pragma unroll
        for (int ai = 0; ai < 2; ++ai)
#pragma unroll
            for (int m = 0; m < 4; ++m) { const int rl = rl0 + ai * HALF + m * 16; const float gw = (u.lt * BM + rl < n_e) ? rw[rl] * DN8_SCALE : 0.f;
                unsigned char* rowp = DOWN + (size_t)(u.pm * BM + rl) * D + col0;
#pragma unroll
                for (int bj = 0; bj < 2; ++bj) { const f32x4 v0 = (acc[ai][bj][m][0] + bv[bj][0]) * gw, v1 = (acc[ai][bj][m][1] + bv[bj][1]) * gw;
                    u32x2 o; o.x = pk_fp8x4(v0[0], v0[1], v0[2], v0[3]); o.y = pk_fp8x4(v1[0], v1[1], v1[2], v1[3]); *(u32x2*)(rowp + bj * HALF) = o; } }
    }
};
}
__device__ __forceinline__ void unpack8(u32x4 w, f32x4& a, f32x4& b) { pg8::unpack8(w, a, b); }

struct Params { const float* in[38]; float* out; unsigned char* ws; int ph_lo, ph_hi; };
enum { I_X = 0, I_C, I_CTX, I_CCTX, I_WADA, I_BADA, I_WIN, I_BIN, I_SMU, I_CONVW, I_CONVB, I_CLNG, I_CLNB, I_WCO, I_BCO, I_W0, I_W2, I_A0, I_A2, I_G2,
       I_KK, I_KA, I_RK, I_LNXG, I_LNXB, I_WRO, I_WOUT, I_BOUT, I_LN1G, I_LN1B, I_WROUTER, I_BROUTER, I_WGU, I_BGU, I_WDN, I_BDN, I_LN2G, I_LN2B };

struct Ctx { LAS unsigned char* lds; int tid, lane, wave, G, bid, gw, NGW; };

__device__ __forceinline__ void cvt_item(const float* W, int N, int K, int k0, int n0, bf16* WT, int drow0, int lane) {
    const int ko = lane & 7, ng = lane >> 3;
    const float* src = W + (size_t)(k0 + 8 * ko) * N + n0 + 4 * ng;
    f32x4 v[8];
#pragma unroll
    for (int j = 0; j < 8; ++j) v[j] = *(const f32x4*)(src + (size_t)j * N);
#pragma unroll
    for (int jn = 0; jn < 4; ++jn) { u32x4 o; o.x = cvt_pk_bf16(v[0][jn], v[1][jn]); o.y = cvt_pk_bf16(v[2][jn], v[3][jn]); o.z = cvt_pk_bf16(v[4][jn], v[5][jn]); o.w = cvt_pk_bf16(v[6][jn], v[7][jn]);
        *(u32x4*)(WT + (size_t)(drow0 + 4 * ng + jn) * K + k0 + 8 * ko) = o; }
}
__device__ __forceinline__ void cvt8_item(const float* W, int N, int k0, int n0, unsigned char* WT, int pitch, int drow0, int lane) {
    const int ko = lane & 7, ng = lane >> 3;
    const float* src = W + (size_t)(k0 + 16 * ko) * N + n0 + 4 * ng;
    f32x4 v[16];
#pragma unroll
    for (int j = 0; j < 16; ++j) v[j] = *(const f32x4*)(src + (size_t)j * N) * W8_SCALE;
#pragma unroll
    for (int jn = 0; jn < 4; ++jn) { u32x4 o; o.x = pk_fp8x4(v[0][jn], v[1][jn], v[2][jn], v[3][jn]); o.y = pk_fp8x4(v[4][jn], v[5][jn], v[6][jn], v[7][jn]);
        o.z = pk_fp8x4(v[8][jn], v[9][jn], v[10][jn], v[11][jn]); o.w = pk_fp8x4(v[12][jn], v[13][jn], v[14][jn], v[15][jn]);
        *(u32x4*)(WT + (size_t)(drow0 + 4 * ng + jn) * pitch + k0 + 16 * ko) = o; }
}
__device__ __forceinline__ void p0_convert(const Params& p, const Ctx& c) {
    unsigned char* ws = p.ws;
    constexpr int I_IN = 16 * 301, I_CO = 16 * 64, I_RO = 16 * 64, I_OUT = 32 * 64;
    constexpr int NITEMS = I_IN + I_CO + I_RO + I_OUT;
    for (int it = c.gw; it < NITEMS; it += c.NGW) {
        int r = it;
        if (r < I_IN) { const int kb = r / 301, nb = r % 301, n0 = 32 * nb; cvt8_item(p.in[I_WIN], PIN, 128 * kb, n0, ws + WS_WIN, D, n0 < 5536 ? n0 : n0 + 96, c.lane); continue; } r -= I_IN;
        if (r < I_CO) { const int kb = r / 64, nb = r % 64; cvt_item(p.in[I_WCO], D, DCV, 64 * kb, 32 * nb, (bf16*)(ws + WS_WCO), 32 * nb, c.lane); continue; } r -= I_CO;
        if (r < I_RO) { const int kb = r / 64, nb = r % 64; cvt_item(p.in[I_WRO], D, DR, 64 * kb, 32 * nb, (bf16*)(ws + WS_WRO), 32 * nb, c.lane); continue; } r -= I_RO;
        { const int kb = r / 64, nb = r % 64; cvt_item(p.in[I_WOUT], D, D, 64 * kb, 32 * nb, (bf16*)(ws + WS_WOUT), 32 * nb, c.lane); }
    }
}
struct CvtAddr { const float* src; unsigned char* dst; int N; };
__device__ __forceinline__ CvtAddr moe_cvt_addr(const Params& p, int it, int lane) {
    constexpr int I_GU1 = 16 * 128, I_GU = NE * I_GU1, I_DN1 = 16 * 64;
    const int ko = lane & 7, ng = lane >> 3; CvtAddr a;
    if (it < I_GU) { const int e = it / I_GU1, q = it % I_GU1, kb = q / 128, nb = q % 128, n0 = 32 * nb; const int nn = n0 & 2047;
        const int drow = (nn >> 7) * 256 + (n0 >= 2048 ? 128 : 0) + (nn & 127);
        a.N = 4096; a.src = p.in[I_WGU] + (size_t)e * D * 4096 + (size_t)(128 * kb + 16 * ko) * 4096 + n0 + 4 * ng;
        a.dst = p.ws + WS_WGU + (size_t)e * 4096 * D + (size_t)(drow + 4 * ng) * D + 128 * kb + 16 * ko; }
    else { const int r = it - I_GU; const int e = r / I_DN1, q = r % I_DN1, kb = q / 64, nb = q % 64;
        a.N = D; a.src = p.in[I_WDN] + (size_t)e * D * D + (size_t)(128 * kb + 16 * ko) * D + 32 * nb + 4 * ng;
        a.dst = p.ws + WS_WDN + (size_t)e * D * D + (size_t)(32 * nb + 4 * ng) * D + 128 * kb + 16 * ko; }
    return a;
}
__device__ __forceinline__ void moe_cvt_load(const CvtAddr& a, f32x4 (&v)[16]) {
#pragma unroll
    for (int j = 0; j < 16; ++j) v[j] = __builtin_nontemporal_load((const f32x4*)(a.src + (size_t)j * a.N));
}
__device__ __forceinline__ void moe_cvt_store(const CvtAddr& a, const f32x4 (&v)[16]) {
#pragma unroll
    for (int jn = 0; jn < 4; ++jn) { u32x4 o;
        o.x = pk_fp8x4_w(v[0][jn], v[1][jn], v[2][jn], v[3][jn]); o.y = pk_fp8x4_w(v[4][jn], v[5][jn], v[6][jn], v[7][jn]);
        o.z = pk_fp8x4_w(v[8][jn], v[9][jn], v[10][jn], v[11][jn]); o.w = pk_fp8x4_w(v[12][jn], v[13][jn], v[14][jn], v[15][jn]);
        *(u32x4*)(a.dst + (size_t)jn * D) = o; }
}
__device__ __forceinline__ void moe_convert(const Params& p, int wi, int nw, int lane) {
    constexpr int NIT = NE * (16 * 128 + 16 * 64);
    f32x4 va[16], vb[16];
    int it = wi; if (it >= NIT) return;
    CvtAddr aa = moe_cvt_addr(p, it, lane), ab = aa; moe_cvt_load(aa, va);
    for (;;) {
        const int i1 = it + nw; ab = moe_cvt_addr(p, i1 < NIT ? i1 : NIT - 1, lane); moe_cvt_load(ab, vb);
        moe_cvt_store(aa, va); if (i1 >= NIT) break;
        const int i2 = i1 + nw; aa = moe_cvt_addr(p, i2 < NIT ? i2 : NIT - 1, lane); moe_cvt_load(aa, va);
        moe_cvt_store(ab, vb); if (i2 >= NIT) break;
        it = i2;
    }
}
__device__ __forceinline__ void p0_small(const Params& p, const Ctx& c) {
    unsigned char* ws = p.ws;
    const int gt = c.bid * 512 + c.tid, NT = c.G * 512;
    bf16* WL = (bf16*)(ws + WS_WLORA);
    for (int t = gt; t < LORA_N * (LORA_K / 8); t += NT) {
        const int n = t / (LORA_K / 8), k0 = (t % (LORA_K / 8)) * 8, g = n >> 10, ch = n & 1023; float v[8];
#pragma unroll
        for (int j = 0; j < 8; ++j) { const int k = k0 + j; float x = 0.f;
            if (g < 4) { const int gd = g & 1; if (k >= 64 * gd && k < 64 * gd + 64) { const float* src = (g < 2) ? p.in[I_W2] : p.in[I_A2]; x = src[((size_t)gd * 64 + (k - 64 * gd)) * DR + ch]; } }
            else { if (k < 160) x = p.in[I_G2][(size_t)k * DR + ch]; }
            v[j] = x; }
        u32x4 o; o.x = cvt_pk_bf16(v[0], v[1]); o.y = cvt_pk_bf16(v[2], v[3]); o.z = cvt_pk_bf16(v[4], v[5]); o.w = cvt_pk_bf16(v[6], v[7]);
        *(u32x4*)(WL + (size_t)n * LORA_K + k0) = o;
    }
    bf16* WRt = (bf16*)(ws + WS_WR);
    for (int t = gt; t < NE * D; t += NT) { const int e = t / D, k = t % D; const float w = p.in[I_WROUTER][(size_t)k * NE + e]; const unsigned hi = f2bf(w); const float lo = w - bflo(hi);
        WRt[t] = (bf16)hi; WRt[NE * D + t] = (bf16)f2bf(lo); }
    float* bin = (float*)(ws + WS_BIN);
    for (int t = gt; t < ZN; t += NT) bin[t] = t < 5536 ? p.in[I_BIN][t] : (t < ZG0 ? 0.f : p.in[I_BIN][t - 96]);
    float* bgu = (float*)(ws + WS_BGU);
    for (int t = gt; t < NE * 4096; t += NT) { const int e = t >> 12, q = t & 4095, pn = q >> 8, rr = q & 255; bgu[t] = p.in[I_BGU][(size_t)e * 4096 + (rr < 128 ? 128 * pn + rr : 2048 + 128 * pn + rr - 128)]; }
    unsigned char* WI = ws + WS_WIN;
    for (int t = gt; t < 96 * D / 16; t += NT) *(u32x4*)(WI + (size_t)5536 * D + (size_t)t * 16) = (u32x4){0u, 0u, 0u, 0u};
}
__device__ __forceinline__ void p0_adaln(const Params& p, const Ctx& c) {
    LAS float* act = (LAS float*)c.lds; LAS float* red = (LAS float*)(c.lds + 73728);
    for (int i = c.tid; i < 9 * D; i += 512) { const int r = i / D, k = i % D; const float v = r < 8 ? p.in[I_C][r * D + k] : p.in[I_CCTX][k]; act[i] = v * sigm(v); }
    __syncthreads();
    const int cg = c.tid & 15, ks = c.tid >> 4;
    float* mod = (float*)(p.ws + WS_MOD);
    for (int u = c.bid; u < 192; u += c.G) {
        f32x4 acc[9];
#pragma unroll
        for (int r = 0; r < 9; ++r) acc[r] = (f32x4){0.f, 0.f, 0.f, 0.f};
        const float* wp = p.in[I_WADA] + 64 * u + 4 * cg;
#pragma unroll 4
        for (int k = ks; k < D; k += 32) { const f32x4 w = *(const f32x4*)(wp + (size_t)k * (6 * D));
#pragma unroll
            for (int r = 0; r < 9; ++r) acc[r] += w * act[r * D + k]; }
#pragma unroll
        for (int r = 0; r < 9; ++r)
#pragma unroll
            for (int j = 0; j < 4; ++j) { float v = acc[r][j]; v += __shfl_xor(v, 16); v += __shfl_xor(v, 32); acc[r][j] = v; }
        if (c.lane < 16) {
#pragma unroll
            for (int r = 0; r < 9; ++r) *(LAS f32x4*)(red + (c.wave * 9 + r) * 64 + 4 * cg) = acc[r]; }
        __syncthreads();
        for (int i = c.tid; i < 9 * 64; i += 512) { const int r = i / 64, col = i % 64; float s = 0.f;
#pragma unroll
            for (int w = 0; w < 8; ++w) s += red[(w * 9 + r) * 64 + col];
            mod[r * (6 * D) + 64 * u + col] = s + p.in[I_BADA][64 * u + col]; }
        __syncthreads();
    }
}

__device__ __forceinline__ void p1_modulate(const Params& p, const Ctx& c) {
    const float* mod = (const float*)(p.ws + WS_MOD); unsigned char* U = p.ws + WS_U;
    for (int row = c.gw; row < TT; row += c.NGW) {
        const float* src = row < TL ? p.in[I_X] + (size_t)row * D : p.in[I_CTX] + (size_t)(row - TL) * D;
        const int b = row < TL ? row / SEQ : 8;
        const float* sh = mod + (size_t)b * (6 * D); const float* sc = sh + D;
        f32x4 v[8]; float s = 0.f;
#pragma unroll
        for (int j = 0; j < 8; ++j) { v[j] = *(const f32x4*)(src + 4 * c.lane + 256 * j); s += (v[j][0] + v[j][1]) + (v[j][2] + v[j][3]); }
        const float mean = wave_sum(s) * (1.f / D); float s2 = 0.f;
#pragma unroll
        for (int j = 0; j < 8; ++j) { v[j] = v[j] - mean; s2 += (v[j][0] * v[j][0] + v[j][1] * v[j][1]) + (v[j][2] * v[j][2] + v[j][3] * v[j][3]); }
        const float rstd = __builtin_amdgcn_rsqf(wave_sum(s2) * (1.f / D) + LN_EPS);
#pragma unroll
        for (int j = 0; j < 8; ++j) { const int col = 4 * c.lane + 256 * j; const f32x4 a = *(const f32x4*)(sc + col), bb = *(const f32x4*)(sh + col);
            const f32x4 o = v[j] * rstd * (a + 1.0f) + bb;
            *(unsigned*)(U + (size_t)row * D + col) = pk_fp8x4(o[0], o[1], o[2], o[3]); }
    }
}

__device__ __forceinline__ void p3_conv(const Params& p, const Ctx& c) {
    const bf16* ZL = (const bf16*)(p.ws + WS_ZL); bf16* AC = (bf16*)(p.ws + WS_ACONV);
    LAS unsigned* tile = (LAS unsigned*)c.lds;
    for (int gr = c.bid; gr < TL / 64; gr += c.G) {
        const int row0 = gr * 64, c0 = 2 * c.tid;
#pragma unroll 4
        for (int i = 0; i < 16; ++i) { const int ch = c.tid + 512 * i, t = ch >> 7, cg = ch & 127;
            f32x4 a0, a1, g0, g1; unpack8(*(const u32x4*)(ZL + (size_t)(row0 + t) * ZN + 8 * cg), a0, a1); unpack8(*(const u32x4*)(ZL + (size_t)(row0 + t) * ZN + DCV + 8 * cg), g0, g1);
            *(LAS u32x4*)(tile + t * 512 + 4 * cg) = pg8::pack8(a0 * pg8::sig4(g0), a1 * pg8::sig4(g1)); }
        __syncthreads();
#pragma unroll 1
        for (int cc = 0; cc < 2; ++cc) {
            float w[CWID];
#pragma unroll
            for (int j = 0; j < CWID; ++j) w[j] = p.in[I_CONVW][j * DCV + c0 + cc];
            const float cb = p.in[I_CONVB][c0 + cc];
            float h[64];
#pragma unroll
            for (int t = 0; t < 64; ++t) { const unsigned a = tile[t * 512 + c.tid]; h[t] = cc ? bfhi(a) : bflo(a); }
#pragma clang loop unroll(full)
            for (int t = 0; t < 64; ++t) { float a = cb;
#pragma clang loop unroll(full)
                for (int j = 0; j < CWID; ++j) { const int tt = t + j - CWID / 2; if (tt >= 0 && tt < 64) a += w[j] * h[tt]; }
                ((LAS bf16*)tile)[t * DCV + c0 + cc] = (bf16)f2bf(a); }
        }
        __syncthreads();
        f32x4 g[4], bb[4];
#pragma unroll
        for (int q = 0; q < 4; ++q) { g[q] = *(const f32x4*)(p.in[I_CLNG] + 16 * c.lane + 4 * q); bb[q] = *(const f32x4*)(p.in[I_CLNB] + 16 * c.lane + 4 * q); }
#pragma unroll 2
        for (int i = 0; i < 8; ++i) { const int t = c.wave * 8 + i;
            const u32x4 r0 = *(const LAS u32x4*)(tile + t * 512 + 8 * c.lane), r1 = *(const LAS u32x4*)(tile + t * 512 + 8 * c.lane + 4);
            f32x4 v[4]; unpack8(r0, v[0], v[1]); unpack8(r1, v[2], v[3]);
            float s = 0.f;
#pragma unroll
            for (int q = 0; q < 4; ++q) s += (v[q][0] + v[q][1]) + (v[q][2] + v[q][3]);
            const float mean = wave_sum(s) * (1.f / DCV); float s2 = 0.f;
#pragma unroll
            for (int q = 0; q < 4; ++q) { v[q] = v[q] - mean; s2 += (v[q][0] * v[q][0] + v[q][1] * v[q][1]) + (v[q][2] * v[q][2] + v[q][3] * v[q][3]); }
            const float rstd = __builtin_amdgcn_rsqf(wave_sum(s2) * (1.f / DCV) + LN_EPS);
#pragma unroll
            for (int q = 0; q < 4; ++q) { v[q] = v[q] * rstd * g[q] + bb[q];
#pragma unroll
                for (int j = 0; j < 4; ++j) v[q][j] = v[q][j] * sigm(v[q][j]); }
            bf16* o = AC + (size_t)(row0 + t) * DCV + 16 * c.lane;
            *(u32x4*)o = pg8::pack8(v[0], v[1]); *(u32x4*)(o + 8) = pg8::pack8(v[2], v[3]); }
        __syncthreads();
    }
}
__device__ __forceinline__ void p3_alora(const Params& p, const Ctx& c) {
    const bf16* ZL = (const bf16*)(p.ws + WS_ZL); const bf16* ZC = (const bf16*)(p.ws + WS_ZC); bf16* AL = (bf16*)(p.ws + WS_ALORA3);
    const float* mu = p.in[I_SMU];
    for (int row = c.gw; row < TT; row += c.NGW) {
        const bool lat = row < TL; const int pitch = lat ? ZN : ZCN; const int len = lat ? SEQ : CTXL; const int t = lat ? row % SEQ : (row - TL) % CTXL;
        const bf16* zp = lat ? ZL + (size_t)row * ZN + ZR0 : ZC + (size_t)(row - TL) * ZCN;
        const bool hp = t > 0, hn = t < len - 1; const int po = hp ? pitch : 0, no = hn ? pitch : 0; const float mp = hp ? 1.f : 0.f, mn = hn ? 1.f : 0.f;
#pragma unroll
        for (int i = 0; i < 12; ++i) { const int g = i >> 2, kk = c.lane + 64 * (i & 3); float o = 0.f;
            const int nv = g == 2 ? 160 : 128;
            if (kk < nv) { const int col = 3072 + 128 * g + kk; const float z = bf1(zp[col]); const float pv = mp * bf1(zp[col - po]), nx = mn * bf1(zp[col + no]);
                const float zs = z + mu[col] * (pv - z) + mu[DSHIFT + col] * (nx - z);
                o = g == 0 ? (1.f - 2.f * __builtin_amdgcn_rcpf(__expf(2.f * zs) + 1.f)) : (g == 1 ? zs : sigm(zs)); }
            AL[((size_t)g * TT + row) * LORA_K + kk] = (bf16)f2bf(o); }
    }
}

constexpr int PH = 72, PT = 20, PM = 20;
constexpr int SB_XAH = 0, SB_XRH = SB_XAH + 16 * PH * 2, SB_XBH = SB_XRH + 16 * PH * 2, SB_XKH = SB_XBH + 16 * PH * 2, SB_XBT = SB_XKH + 16 * PH * 2, SB_XKT = SB_XBT + 64 * PT * 2,
              SB_V = SB_XKT + 64 * PT * 2, SB_GAM = SB_V + 4096, SB_MAK = SB_GAM + 256, SB_TT = SB_MAK + 16 * PM * 4, SB_MBR = SB_TT + 16 * PM * 4, SB_MKR = SB_MBR + 16 * PM * 4, SB_NS = SB_MKR + 16 * PM * 4, SLOT = SB_NS + 1024;
constexpr int SNB = 5, S_FULL = LX_MISC + 64, S_DONE = LX_MISC + 128;
static_assert(SNB * SLOT <= LDSX_OFF && SLOT % 16 == 0 && SB_V % 16 == 0 && SB_XBT % 16 == 0, "scan ring");
typedef float f32x4v __attribute__((ext_vector_type(4)));
__device__ __forceinline__ f32x4 mfma4(float a, float b, f32x4 c) { return __builtin_amdgcn_mfma_f32_16x16x4f32(a, b, c, 0, 0, 0); }
__device__ __forceinline__ void red8x4(float& a, float& b, float& c, float& d) {
#define R4(ctrl) "v_add_f32_dpp %0, %0, %0 " ctrl " row_mask:0xf bank_mask:0xf\n\tv_add_f32_dpp %1, %1, %1 " ctrl " row_mask:0xf bank_mask:0xf\n\tv_add_f32_dpp %2, %2, %2 " ctrl " row_mask:0xf bank_mask:0xf\n\t" \
               "v_add_f32_dpp %3, %3, %3 " ctrl " row_mask:0xf bank_mask:0xf\n\t"
    asm volatile("s_nop 1\n\t" R4("quad_perm:[1,0,3,2]") R4("quad_perm:[2,3,0,1]") R4("row_half_mirror") "s_nop 1" : "+v"(a), "+v"(b), "+v"(c), "+v"(d));
#undef R4
}
__device__ __forceinline__ float rdl63(float x) { return __builtin_bit_cast(float, __builtin_amdgcn_readlane(__builtin_bit_cast(int, x), 63)); }
#define WR_STEP(N, ctrl) WR_##N(ctrl)
#define WR_2(ctrl) "v_add_f32_dpp %0, %0, %0 " ctrl "\n\tv_add_f32_dpp %1, %1, %1 " ctrl "\n\ts_nop 0\n\t"
#define WR_4(ctrl) "v_add_f32_dpp %0, %0, %0 " ctrl "\n\tv_add_f32_dpp %1, %1, %1 " ctrl "\n\tv_add_f32_dpp %2, %2, %2 " ctrl "\n\tv_add_f32_dpp %3, %3, %3 " ctrl "\n\t"
#define WR_6(ctrl) WR_4(ctrl) "v_add_f32_dpp %4, %4, %4 " ctrl "\n\tv_add_f32_dpp %5, %5, %5 " ctrl "\n\t"
#define WR_ALL(N) "s_nop 1\n\t" WR_STEP(N, "quad_perm:[1,0,3,2] row_mask:0xf bank_mask:0xf") WR_STEP(N, "quad_perm:[2,3,0,1] row_mask:0xf bank_mask:0xf") WR_STEP(N, "row_half_mirror row_mask:0xf bank_mask:0xf") \
    WR_STEP(N, "row_mirror row_mask:0xf bank_mask:0xf") WR_STEP(N, "row_bcast:15 row_mask:0xa bank_mask:0xf") WR_STEP(N, "row_bcast:31 row_mask:0xc bank_mask:0xf") "s_nop 1"
__device__ __forceinline__ void wred2(float& a, float& b) { asm volatile(WR_ALL(2) : "+v"(a), "+v"(b)); a = rdl63(a); b = rdl63(b); }
__device__ __forceinline__ void wred4(float& a, float& b, float& c, float& d) { asm volatile(WR_ALL(4) : "+v"(a), "+v"(b), "+v"(c), "+v"(d));
    a = rdl63(a); b = rdl63(b); c = rdl63(c); d = rdl63(d); }
__device__ __forceinline__ void wred6(float& a, float& b, float& c, float& d, float& e, float& f) { asm volatile(WR_ALL(6) : "+v"(a), "+v"(b), "+v"(c), "+v"(d), "+v"(e), "+v"(f));
    a = rdl63(a); b = rdl63(b); c = rdl63(c); d = rdl63(d); e = rdl63(e); f = rdl63(f); }
struct ScanCoef { f32x4 a0, a1, b0, b1, k0, k1, r0, r1; f32x2 vv, cc; };
__device__ __forceinline__ ScanCoef scan_ld(const LAS unsigned char* sb, const LAS unsigned char* vb, const LAS unsigned char* cb) {
    ScanCoef o; o.a0 = *(const LAS f32x4*)(sb); o.a1 = *(const LAS f32x4*)(sb + 16); o.b0 = *(const LAS f32x4*)(sb + 256); o.b1 = *(const LAS f32x4*)(sb + 272);
    o.k0 = *(const LAS f32x4*)(sb + 512); o.k1 = *(const LAS f32x4*)(sb + 528); o.r0 = *(const LAS f32x4*)(sb + 768); o.r1 = *(const LAS f32x4*)(sb + 784);
    o.vv = *(const LAS f32x2*)(vb); o.cc = *(const LAS f32x2*)(cb); return o;
}
typedef unsigned short us2 __attribute__((ext_vector_type(2)));
struct ScanRaw { us2 zr[9], zk[9], zv[9], lw[8], la[8], lo[8]; };
template <int DIR>
__device__ __forceinline__ void scan_geom(int b, int ch, bool& lat, int& pitch, int& len, int& t0, size_t& rowbase) {
    lat = ch >= CTXL / SCH;
    const int m = lat ? (DIR ? NCHUNK - 1 - ch : ch - CTXL / SCH) : (DIR ? CTXL / SCH - 1 - ch : ch);
    pitch = lat ? ZN : ZCN; len = lat ? SEQ : CTXL; t0 = 16 * m;
    rowbase = lat ? (size_t)b * SEQ + t0 : (size_t)b * CTXL + t0;
}
template <int DIR>
__device__ __forceinline__ ScanRaw scan_prefetch(const Params& p, int b, int h, int ch, int lane) {
    const bf16* ZL = (const bf16*)(p.ws + WS_ZL); const bf16* ZC = (const bf16*)(p.ws + WS_ZC); const bf16* LO = (const bf16*)(p.ws + WS_LORA);
    bool lat; int pitch, len, t0; size_t rowbase; scan_geom<DIR>(b, ch, lat, pitch, len, t0, rowbase);
    const int hc = h * HS + lane;
    const bf16* zp = lat ? ZL + rowbase * ZN + ZR0 : ZC + rowbase * ZCN;
    const size_t lrow = lat ? rowbase : (size_t)TL + rowbase;
    ScanRaw r;
#pragma unroll
    for (int i = 0; i < 18; ++i) { const int t = t0 - 1 + i; const int tc = t < 0 ? 0 : (t >= len ? len - 1 : t);
        const bf16* q = zp + (ptrdiff_t)(tc - t0) * pitch;
        if (i & 1) { r.zr[i >> 1].y = q[hc]; r.zk[i >> 1].y = q[DR + hc]; r.zv[i >> 1].y = q[2 * DR + hc]; } else { r.zr[i >> 1].x = q[hc]; r.zk[i >> 1].x = q[DR + hc]; r.zv[i >> 1].x = q[2 * DR + hc]; } }
#pragma unroll
    for (int i = 0; i < 16; ++i) { const bf16* lp = LO + (lrow + i) * LORA_N + hc;
        if (i & 1) { r.lw[i >> 1].y = lp[DIR * DR]; r.la[i >> 1].y = lp[(2 + DIR) * DR]; r.lo[i >> 1].y = lp[(3 - DIR) * DR]; } else { r.lw[i >> 1].x = lp[DIR * DR]; r.la[i >> 1].x = lp[(2 + DIR) * DR]; r.lo[i >> 1].x = lp[(3 - DIR) * DR]; } }
    return r;
}
struct ScanPar { float mpr, mnr, mpk, mnk, mpv, mnv, kk_, ka_, rk_, w0d, a0d, a0o; };
__device__ __forceinline__ ScanPar scan_par(const Params& p, int h, int d, int lane) {
    const float* mu = p.in[I_SMU]; const int hc = h * HS + lane; ScanPar q;
    q.mpr = mu[hc]; q.mnr = mu[DSHIFT + hc]; q.mpk = mu[DR + hc]; q.mnk = mu[DSHIFT + DR + hc]; q.mpv = mu[2 * DR + hc]; q.mnv = mu[DSHIFT + 2 * DR + hc];
    q.kk_ = p.in[I_KK][hc]; q.ka_ = p.in[I_KA][hc]; q.rk_ = p.in[I_RK][hc];
    q.w0d = p.in[I_W0][d * DR + hc]; q.a0d = p.in[I_A0][d * DR + hc]; q.a0o = p.in[I_A0][(1 - d) * DR + hc]; return q;
}
template <int DIR>
__device__ __forceinline__ void scan_produce(const Params& p, const ScanPar& sp_, const ScanRaw& raw, int b, int h, int ch, LAS unsigned char* slot, int lane) {
    bf16* VS = (bf16*)(p.ws + WS_VS); float* RK = (float*)(p.ws + WS_RK);
    bool lat; int pitch, len, t0; size_t rowbase; scan_geom<DIR>(b, ch, lat, pitch, len, t0, rowbase);
    const int hc = h * HS + lane;
    const float mpr = sp_.mpr, mnr = sp_.mnr, mpk = sp_.mpk, mnk = sp_.mnk, mpv = sp_.mpv, mnv = sp_.mnv, kk_ = sp_.kk_, ka_ = sp_.ka_, rk_ = sp_.rk_, w0d = sp_.w0d, a0d = sp_.a0d, a0o = sp_.a0o;
    float zr[18], zk[18], zv[18];
#pragma unroll
    for (int i = 0; i < 18; ++i) { zr[i] = bf1((i & 1) ? raw.zr[i >> 1].y : raw.zr[i >> 1].x); zk[i] = bf1((i & 1) ? raw.zk[i >> 1].y : raw.zk[i >> 1].x); zv[i] = bf1((i & 1) ? raw.zv[i >> 1].y : raw.zv[i >> 1].x); }
    { const float m0 = (t0 > 0) ? 1.f : 0.f, m1 = (t0 + 16 < len) ? 1.f : 0.f;
      zr[0] *= m0; zk[0] *= m0; zv[0] *= m0; zr[17] *= m1; zk[17] *= m1; zv[17] *= m1; }
    bf16 lw[16], la[16], lo[16];
#pragma unroll
    for (int i = 0; i < 16; ++i) { lw[i] = (i & 1) ? raw.lw[i >> 1].y : raw.lw[i >> 1].x; la[i] = (i & 1) ? raw.la[i >> 1].y : raw.la[i >> 1].x; lo[i] = (i & 1) ? raw.lo[i >> 1].y : raw.lo[i >> 1].x; }
    LAS unsigned char* SL = slot;
    float gam = 1.f;
#pragma unroll
    for (int sp = 0; sp < 16; sp += 2) {
        float r[2], k[2], v[2], kr[2], n2[2];
#pragma unroll
        for (int e = 0; e < 2; ++e) { const int i = DIR ? 15 - (sp + e) : sp + e;
            r[e] = zr[i + 1] + mpr * (zr[i] - zr[i + 1]) + mnr * (zr[i + 2] - zr[i + 1]);
            k[e] = zk[i + 1] + mpk * (zk[i] - zk[i + 1]) + mnk * (zk[i + 2] - zk[i + 1]);
            v[e] = zv[i + 1] + mpv * (zv[i] - zv[i + 1]) + mnv * (zv[i + 2] - zv[i + 1]);
            kr[e] = k[e] * kk_; n2[e] = kr[e] * kr[e]; }
        wred2(n2[0], n2[1]);
        float rs[2], fb[2], fk[2];
#pragma unroll
        for (int e = 0; e < 2; ++e) { const int s = sp + e, i = DIR ? 15 - s : s;
            const float kk = kr[e] * __builtin_amdgcn_rsqf(fmaxf(n2[e], 1e-24f));
            const float aa = sigm(a0d + bf1(la[i])); const float w = __expf(-0.6065306597f * sigm(w0d + bf1(lw[i])));
            const float kd = k[e] * (1.f + (aa - 1.f) * ka_), bb = kk * aa;
            const float gprev = gam; gam *= w; const float inv = __builtin_amdgcn_rcpf(gam);
            { const unsigned par = cvt_pk_bf16(gprev * -kk, gam * r[e]);
              ((LAS bf16*)(SL + SB_XAH))[s * PH + lane] = (bf16)(par & 0xffffu); ((LAS bf16*)(SL + SB_XRH))[s * PH + lane] = (bf16)(par >> 16);
              fb[e] = bb * inv; fk[e] = kd * inv; ((LAS float*)(SL + SB_V))[s * 64 + lane] = v[e]; }
            rs[e] = 0.f;
            if (DIR == 0) { const float ao = sigm(a0o + bf1(lo[i])); const float kdo = k[e] * (1.f + (ao - 1.f) * ka_); rs[e] = r[e] * (kd + kdo) * rk_; } }
        { const unsigned pb = cvt_pk_bf16(fb[0], fb[1]), pk = cvt_pk_bf16(fk[0], fk[1]);
          ((LAS bf16*)(SL + SB_XBH))[sp * PH + lane] = (bf16)(pb & 0xffffu); ((LAS bf16*)(SL + SB_XBH))[(sp + 1) * PH + lane] = (bf16)(pb >> 16);
          ((LAS bf16*)(SL + SB_XKH))[sp * PH + lane] = (bf16)(pk & 0xffffu); ((LAS bf16*)(SL + SB_XKH))[(sp + 1) * PH + lane] = (bf16)(pk >> 16);
          *(LAS unsigned*)((LAS bf16*)(SL + SB_XBT) + lane * PT + sp) = pb; *(LAS unsigned*)((LAS bf16*)(SL + SB_XKT) + lane * PT + sp) = pk; }
        if (DIR == 0 && lat) {
            wred2(rs[0], rs[1]);
#pragma unroll
            for (int e = 0; e < 2; ++e) { const int i = sp + e; if (lane == 0) RK[(rowbase + i) * NH + h] = rs[e]; VS[(rowbase + i) * DR + hc] = (bf16)(cvt_pk_bf16(v[e], 0.f) & 0xffffu); } }
    }
    ((LAS float*)(SL + SB_GAM))[lane] = gam;
    asm volatile("s_waitcnt lgkmcnt(0)" ::: "memory");
    { const int rw = lane & 15, g = lane >> 4; LAS float* S = (LAS float*)SL; constexpr int SO_MAK = SB_MAK / 4, SO_MBR = SB_MBR / 4, SO_MKR = SB_MKR / 4, SO_NS = SB_NS / 4, SO_TT = SB_TT / 4;
      f32x4 mab = (f32x4){0.f, 0.f, 0.f, 0.f}, mak = mab, mbr = mab, mkr = mab;
#pragma unroll
      for (int m = 0; m < 2; ++m) { const int off = (rw * PH + 32 * m + 8 * g) * 2;
          const bf16x8 a8 = *(const LAS bf16x8*)(SL + SB_XAH + off), r8 = *(const LAS bf16x8*)(SL + SB_XRH + off), b8 = *(const LAS bf16x8*)(SL + SB_XBH + off), k8 = *(const LAS bf16x8*)(SL + SB_XKH + off);
          mab = __builtin_amdgcn_mfma_f32_16x16x32_bf16(b8, a8, mab, 0, 0, 0); mak = __builtin_amdgcn_mfma_f32_16x16x32_bf16(k8, a8, mak, 0, 0, 0);
          mbr = __builtin_amdgcn_mfma_f32_16x16x32_bf16(b8, r8, mbr, 0, 0, 0); mkr = __builtin_amdgcn_mfma_f32_16x16x32_bf16(k8, r8, mkr, 0, 0, 0); }
      f32x4 oab, oak, obr, okr;
#pragma unroll
      for (int i = 0; i < 4; ++i) { const int r = 4 * g + i; oab[i] = r < rw ? mab[i] : 0.f; oak[i] = r < rw ? mak[i] : 0.f; obr[i] = r <= rw ? mbr[i] : 0.f; okr[i] = r <= rw ? mkr[i] : 0.f; }
      *(LAS f32x4*)(S + SO_MAK + rw * PM + 4 * g) = oak; *(LAS f32x4*)(S + SO_MBR + rw * PM + 4 * g) = obr; *(LAS f32x4*)(S + SO_MKR + rw * PM + 4 * g) = okr;
#pragma unroll
      for (int i = 0; i < 4; ++i) S[SO_NS + (4 * g + i) * 16 + rw] = oab[i];
      asm volatile("s_waitcnt lgkmcnt(0)" ::: "memory");
      float tc[16];
#pragma unroll
      for (int r = 0; r < 16; ++r) tc[r] = (r == rw) ? 1.f : 0.f;
#pragma unroll
      for (int r = 14; r >= 0; --r) { float acc = tc[r]; int zdep; asm volatile("v_and_b32 %0, 0, %1" : "=v"(zdep) : "v"(tc[r + 1]));
#pragma unroll
          for (int q4 = (r + 1) / 4; q4 < 4; ++q4) { const f32x4 n4 = *(const LAS f32x4*)(S + SO_NS + r * 16 + 4 * q4 + zdep);
#pragma unroll
              for (int i = 0; i < 4; ++i) { const int rp = 4 * q4 + i; if (rp > r) acc += n4[i] * tc[rp]; } }
          tc[r] = acc; }
      if (g == 0) {
#pragma unroll
          for (int q4 = 0; q4 < 4; ++q4) *(LAS f32x4*)(S + SO_TT + rw * PM + 4 * q4) = (f32x4){tc[4 * q4], tc[4 * q4 + 1], tc[4 * q4 + 2], tc[4 * q4 + 3]}; }
    }
}
constexpr int S_CVT = LX_MISC + 192, CVT_PER_WG = (NE * (16 * 128 + 16 * 64)) / 256;
__device__ __forceinline__ bool scan_try_convert(const Params& p, const Ctx& c, bool enabled) {
    if (!enabled) return false;
    int idx = 0; if (c.lane == 0) idx = (int)__hip_atomic_fetch_add((LAS unsigned*)(c.lds + S_CVT), 1u, __ATOMIC_RELAXED, __HIP_MEMORY_SCOPE_WORKGROUP);
    idx = __builtin_amdgcn_readfirstlane(idx);
    if (idx >= CVT_PER_WG) return false;
    f32x4 v[16]; const CvtAddr ca = moe_cvt_addr(p, c.bid + c.G * idx, c.lane); moe_cvt_load(ca, v); moe_cvt_store(ca, v); return true;
}
__device__ __forceinline__ void scan_convert_tail(const Params& p, const Ctx& c, bool enabled) {
    if (!enabled) return;
    for (;;) {
        int idx = 0; if (c.lane == 0) idx = (int)__hip_atomic_fetch_add((LAS unsigned*)(c.lds + S_CVT), 2u, __ATOMIC_RELAXED, __HIP_MEMORY_SCOPE_WORKGROUP);
        idx = __builtin_amdgcn_readfirstlane(idx);
        if (idx >= CVT_PER_WG) return;
        f32x4 va[16], vb[16]; const bool two = idx + 1 < CVT_PER_WG;
        const CvtAddr aa = moe_cvt_addr(p, c.bid + c.G * idx, c.lane), ab = moe_cvt_addr(p, c.bid + c.G * (two ? idx + 1 : idx), c.lane);
        moe_cvt_load(aa, va); moe_cvt_load(ab, vb); moe_cvt_store(aa, va); if (two) moe_cvt_store(ab, vb);
    }
}
__device__ __forceinline__ void p6_scan(const Params& p, const Ctx& c) {
    LAS unsigned char* L = c.lds; volatile LAS unsigned* full = (volatile LAS unsigned*)(L + S_FULL); volatile LAS unsigned* done = (volatile LAS unsigned*)(L + S_DONE);
    float* Y = (float*)(p.ws + WS_Y);
    for (int sid = c.bid; sid < NB * NH * 2; sid += c.G) {
        if (c.tid < 8) { full[c.tid] = 0u; done[c.tid] = 0u; }
        if (c.tid == 8 && sid == c.bid) *(LAS unsigned*)(L + S_CVT) = 0u;
        __syncthreads();
        const bool cvt_on = (c.G == 256);
        const int d = sid & 1, bh = sid >> 1, h = bh % NH, b = bh / NH;
        if (c.wave >= 4) {
            const int j = c.wave - 4;
            const ScanPar spar = scan_par(p, h, d, c.lane);
            ScanRaw raw = d ? scan_prefetch<1>(p, b, h, j, c.lane) : scan_prefetch<0>(p, b, h, j, c.lane);
            for (int ch = j; ch < NCHUNK; ch += 4) {
                const int buf = ch % SNB;
                if (ch >= SNB) { const unsigned want = 4u * (unsigned)(ch / SNB); unsigned sp = 0;
                    while (done[buf] < want) { __builtin_amdgcn_s_sleep(1); if (++sp > (1u << 24)) break; } }
                if (d) scan_produce<1>(p, spar, raw, b, h, ch, L + buf * SLOT, c.lane); else scan_produce<0>(p, spar, raw, b, h, ch, L + buf * SLOT, c.lane);
                asm volatile("s_waitcnt lgkmcnt(0)" ::: "memory");
                if (c.lane == 0) full[buf] = (unsigned)(ch + 1);
                { const int nc = ch + 4 < NCHUNK ? ch + 4 : ch; raw = d ? scan_prefetch<1>(p, b, h, nc, c.lane) : scan_prefetch<0>(p, b, h, nc, c.lane); }
            }
            scan_convert_tail(p, c, cvt_on);
        } else {
            const int vl = c.lane & 15, g = c.lane >> 4, w = c.wave;
            f32x4 sd[4];
#pragma unroll
            for (int kt = 0; kt < 4; ++kt) sd[kt] = (f32x4){0.f, 0.f, 0.f, 0.f};
            float* yb = Y + ((size_t)d * TL + (size_t)b * SEQ) * DR + h * HS + 16 * w + vl;
            for (int ch = 0; ch < NCHUNK; ++ch) {
                const int buf = ch % SNB; { unsigned sp = 0; while (full[buf] != (unsigned)(ch + 1)) { if (!scan_try_convert(p, c, cvt_on)) { __builtin_amdgcn_s_sleep(1); if (++sp > (1u << 24)) break; } } }
                const LAS unsigned char* SL = L + buf * SLOT; const LAS float* S = (const LAS float*)SL;
                constexpr int SO_V = SB_V / 4, SO_GAM = SB_GAM / 4, SO_MAK = SB_MAK / 4, SO_MBR = SB_MBR / 4, SO_MKR = SB_MKR / 4, SO_TT = SB_TT / 4;
                const bool lat = ch >= CTXL / SCH;
                f32x4 gt = (f32x4){0.f, 0.f, 0.f, 0.f}, ht = gt;
#pragma unroll
                for (int m = 0; m < 2; ++m) {
                    u32x4 sb; sb.x = cvt_pk_bf16(sd[2 * m][0], sd[2 * m][1]); sb.y = cvt_pk_bf16(sd[2 * m][2], sd[2 * m][3]); sb.z = cvt_pk_bf16(sd[2 * m + 1][0], sd[2 * m + 1][1]); sb.w = cvt_pk_bf16(sd[2 * m + 1][2], sd[2 * m + 1][3]);
                    const LAS bf16* pa = (const LAS bf16*)(SL + SB_XAH) + vl * PH + 32 * m + 4 * g; const LAS bf16* pr = (const LAS bf16*)(SL + SB_XRH) + vl * PH + 32 * m + 4 * g;
                    const u32x2 a0 = *(const LAS u32x2*)pa, a1 = *(const LAS u32x2*)(pa + 16), r0 = *(const LAS u32x2*)pr, r1 = *(const LAS u32x2*)(pr + 16);
                    const u32x4 av = (u32x4){a0.x, a0.y, a1.x, a1.y}, rv = (u32x4){r0.x, r0.y, r1.x, r1.y};
                    gt = __builtin_amdgcn_mfma_f32_16x16x32_bf16(__builtin_bit_cast(bf16x8, av), __builtin_bit_cast(bf16x8, sb), gt, 0, 0, 0);
                    ht = __builtin_amdgcn_mfma_f32_16x16x32_bf16(__builtin_bit_cast(bf16x8, rv), __builtin_bit_cast(bf16x8, sb), ht, 0, 0, 0); }
                f32x4 vt;
#pragma unroll
                for (int i = 0; i < 4; ++i) vt[i] = S[SO_V + (4 * g + i) * 64 + 16 * w + vl];
                { const f32x4 m4 = *(const LAS f32x4*)(S + SO_MAK + vl * PM + 4 * g);
#pragma unroll
                  for (int i = 0; i < 4; ++i) gt = mfma4(m4[i], vt[i], gt); }
                f32x4 ut = (f32x4){0.f, 0.f, 0.f, 0.f};
                { const f32x4 t4 = *(const LAS f32x4*)(S + SO_TT + vl * PM + 4 * g);
#pragma unroll
                  for (int i = 0; i < 4; ++i) ut = mfma4(t4[i], gt[i], ut); }
                if (lat) {
                    const f32x4 b4 = *(const LAS f32x4*)(S + SO_MBR + vl * PM + 4 * g), k4 = *(const LAS f32x4*)(S + SO_MKR + vl * PM + 4 * g);
#pragma unroll
                    for (int i = 0; i < 4; ++i) { ht = mfma4(b4[i], ut[i], ht); ht = mfma4(k4[i], vt[i], ht); }
#pragma unroll
                    for (int i = 0; i < 4; ++i) { const int P = ch * SCH + 4 * g + i - CTXL; const int t = d ? SEQ - 1 - P : P; yb[(size_t)t * DR] = ht[i]; }
                }
                { u32x4 ub; ub.x = cvt_pk_bf16(ut[0], ut[1]); ub.y = cvt_pk_bf16(ut[2], ut[3]); ub.z = cvt_pk_bf16(vt[0], vt[1]); ub.w = cvt_pk_bf16(vt[2], vt[3]);
#pragma unroll
                  for (int kt = 0; kt < 4; ++kt) {
                    const u32x2 xb = *(const LAS u32x2*)((const LAS bf16*)(SL + SB_XBT) + (16 * kt + vl) * PT + 4 * g), xk = *(const LAS u32x2*)((const LAS bf16*)(SL + SB_XKT) + (16 * kt + vl) * PT + 4 * g);
                    const u32x4 av = (u32x4){xb.x, xb.y, xk.x, xk.y};
                    sd[kt] = __builtin_amdgcn_mfma_f32_16x16x32_bf16(__builtin_bit_cast(bf16x8, av), __builtin_bit_cast(bf16x8, ub), sd[kt], 0, 0, 0);
                    sd[kt] *= *(const LAS f32x4*)(S + SO_GAM + 16 * kt + 4 * g); } }
                asm volatile("s_waitcnt lgkmcnt(0)" ::: "memory");
                if (c.lane == 0) __hip_atomic_fetch_add((LAS unsigned*)(L + S_DONE) + buf, 1u, __ATOMIC_RELAXED, __HIP_MEMORY_SCOPE_WORKGROUP);
            }
            scan_convert_tail(p, c, cvt_on);
        }
        __syncthreads();
    }
}

__device__ __forceinline__ void p7_rwkvout(const Params& p, const Ctx& c) {
    const float* Y = (const float*)(p.ws + WS_Y); const float* RK = (const float*)(p.ws + WS_RK); const bf16* VS = (const bf16*)(p.ws + WS_VS);
    const bf16* LO = (const bf16*)(p.ws + WS_LORA); bf16* AR = (bf16*)(p.ws + WS_ARWKV);
    const int c0 = 16 * c.lane, hd = c.lane >> 2;
    f32x4 g[4], bb[4];
#pragma unroll
    for (int q = 0; q < 4; ++q) { g[q] = *(const f32x4*)(p.in[I_LNXG] + c0 + 4 * q); bb[q] = *(const f32x4*)(p.in[I_LNXB] + c0 + 4 * q); }
    for (int row = c.gw; row < TL; row += c.NGW) {
        f32x4 y[4]; float s = 0.f;
#pragma unroll
        for (int q = 0; q < 4; ++q) { y[q] = *(const f32x4*)(Y + (size_t)row * DR + c0 + 4 * q) + *(const f32x4*)(Y + ((size_t)TL + row) * DR + c0 + 4 * q); s += (y[q][0] + y[q][1]) + (y[q][2] + y[q][3]); }
        s += __shfl_xor(s, 1); s += __shfl_xor(s, 2); const float mean = s * (1.f / HS); float s2 = 0.f;
#pragma unroll
        for (int q = 0; q < 4; ++q) { y[q] = y[q] - mean; s2 += (y[q][0] * y[q][0] + y[q][1] * y[q][1]) + (y[q][2] * y[q][2] + y[q][3] * y[q][3]); }
        s2 += __shfl_xor(s2, 1); s2 += __shfl_xor(s2, 2); const float rstd = __builtin_amdgcn_rsqf(s2 * (1.f / HS) + GN_EPS);
        const float rk = RK[(size_t)row * NH + hd];
        f32x4 v[4], gt[4];
        unpack8(*(const u32x4*)(VS + (size_t)row * DR + c0), v[0], v[1]); unpack8(*(const u32x4*)(VS + (size_t)row * DR + c0 + 8), v[2], v[3]);
        unpack8(*(const u32x4*)(LO + (size_t)row * LORA_N + 4 * DR + c0), gt[0], gt[1]); unpack8(*(const u32x4*)(LO + (size_t)row * LORA_N + 4 * DR + c0 + 8), gt[2], gt[3]);
#pragma unroll
        for (int q = 0; q < 4; ++q) y[q] = (y[q] * rstd * g[q] + bb[q] + v[q] * rk) * gt[q];
        bf16* o = AR + (size_t)row * DR + c0; *(u32x4*)o = pg8::pack8(y[0], y[1]); *(u32x4*)(o + 8) = pg8::pack8(y[2], y[3]);
    }
}

constexpr int RT_PITCH = 4096 + 16, RT_LO = 16 * RT_PITCH, RT_PART = LDSX_OFF + 2048;
static_assert(2 * RT_LO <= LDSX_OFF && RT_PART + 4 * 2048 <= LDS_BYTES, "router LDS map");
__device__ __forceinline__ void p10_router(const Params& p, const Ctx& c) {
    const float* T1 = (const float*)(p.ws + WS_T1); float* XM = (float*)(p.ws + WS_XMID);
    const float* mod = (const float*)(p.ws + WS_MOD); const bf16* WRt = (const bf16*)(p.ws + WS_WR); unsigned char* U8 = p.ws + WS_U2F8;
    unsigned* cntg = (unsigned*)(p.ws + WS_CTL) + CW_CNT; int* rowtok = (int*)(p.ws + WS_ROWTOK); float* roww = (float*)(p.ws + WS_ROWW); unsigned* sel = (unsigned*)(p.ws + WS_SEL);
    LAS unsigned char* L = c.lds;
    for (int un = c.bid; un < TL / 64; un += c.G) {
        const int r0 = un * 64, b = r0 / SEQ;
        const float* sh = mod + (size_t)b * (6 * D) + 3 * D; const float* sc = sh + D;
        for (int g = 0; g < 4; ++g) {
            for (int i = 0; i < 2; ++i) { const int tl = 2 * c.wave + i, row = r0 + 16 * g + tl;
                f32x4 v[8]; float s = 0.f;
#pragma unroll
                for (int j = 0; j < 8; ++j) { v[j] = *(const f32x4*)(T1 + (size_t)row * D + 4 * c.lane + 256 * j); s += (v[j][0] + v[j][1]) + (v[j][2] + v[j][3]); }
                float mean = wave_sum(s) * (1.f / D), s2 = 0.f;
#pragma unroll
                for (int j = 0; j < 8; ++j) { v[j] = v[j] - mean; s2 += (v[j][0] * v[j][0] + v[j][1] * v[j][1]) + (v[j][2] * v[j][2] + v[j][3] * v[j][3]); }
                float rstd = __builtin_amdgcn_rsqf(wave_sum(s2) * (1.f / D) + LN_EPS); s = 0.f;
#pragma unroll
                for (int j = 0; j < 8; ++j) { const int col = 4 * c.lane + 256 * j; v[j] = v[j] * rstd * *(const f32x4*)(p.in[I_LN1G] + col) + *(const f32x4*)(p.in[I_LN1B] + col);
                    *(f32x4*)(XM + (size_t)row * D + col) = v[j]; s += (v[j][0] + v[j][1]) + (v[j][2] + v[j][3]); }
                mean = wave_sum(s) * (1.f / D); s2 = 0.f;
#pragma unroll
                for (int j = 0; j < 8; ++j) { v[j] = v[j] - mean; s2 += (v[j][0] * v[j][0] + v[j][1] * v[j][1]) + (v[j][2] * v[j][2] + v[j][3] * v[j][3]); }
                rstd = __builtin_amdgcn_rsqf(wave_sum(s2) * (1.f / D) + LN_EPS);
#pragma unroll
                for (int j = 0; j < 8; ++j) { const int col = 4 * c.lane + 256 * j; const f32x4 o = v[j] * rstd * (*(const f32x4*)(sc + col) + 1.0f) + *(const f32x4*)(sh + col);
                    u32x2 hi; hi.x = cvt_pk_bf16(o[0], o[1]); hi.y = cvt_pk_bf16(o[2], o[3]);
                    u32x2 lo; lo.x = cvt_pk_bf16(o[0] - bflo(hi.x), o[1] - bfhi(hi.x)); lo.y = cvt_pk_bf16(o[2] - bflo(hi.y), o[3] - bfhi(hi.y));
                    *(LAS u32x2*)(L + tl * RT_PITCH + 2 * col) = hi; *(LAS u32x2*)(L + RT_LO + tl * RT_PITCH + 2 * col) = lo;
                    *(unsigned*)(U8 + (size_t)row * D + col) = pk_fp8x4(o[0], o[1], o[2], o[3]); }
            }
            __syncthreads();
            if (c.wave < 4) {
                const int t = c.lane & 15, kq = 8 * (c.lane >> 4), k0 = 512 * c.wave;
                f32x4 acc0 = (f32x4){0.f, 0.f, 0.f, 0.f}, acc1 = acc0;
                const LAS unsigned char* ah = L + t * RT_PITCH + 2 * (k0 + kq); const LAS unsigned char* al = ah + RT_LO;
                const bf16* bh0 = WRt + (size_t)t * D + k0 + kq; const bf16* bh1 = bh0 + 16 * D; const bf16* bl0 = bh0 + NE * D; const bf16* bl1 = bl0 + 16 * D;
#pragma unroll 4
                for (int s = 0; s < 16; ++s) {
                    const bf16x8 xh = *(const LAS bf16x8*)(ah + 64 * s), xl = *(const LAS bf16x8*)(al + 64 * s);
                    const bf16x8 wh0 = *(const bf16x8*)(bh0 + 32 * s), wh1 = *(const bf16x8*)(bh1 + 32 * s), wl0 = *(const bf16x8*)(bl0 + 32 * s), wl1 = *(const bf16x8*)(bl1 + 32 * s);
                    acc0 = __builtin_amdgcn_mfma_f32_16x16x32_bf16(xh, wh0, acc0, 0, 0, 0); acc1 = __builtin_amdgcn_mfma_f32_16x16x32_bf16(xh, wh1, acc1, 0, 0, 0);
                    acc0 = __builtin_amdgcn_mfma_f32_16x16x32_bf16(xl, wh0, acc0, 0, 0, 0); acc1 = __builtin_amdgcn_mfma_f32_16x16x32_bf16(xl, wh1, acc1, 0, 0, 0);
                    acc0 = __builtin_amdgcn_mfma_f32_16x16x32_bf16(xh, wl0, acc0, 0, 0, 0); acc1 = __builtin_amdgcn_mfma_f32_16x16x32_bf16(xh, wl1, acc1, 0, 0, 0);
                }
                LAS float* pw = (LAS float*)(L + RT_PART + c.wave * 2048);
#pragma unroll
                for (int i = 0; i < 4; ++i) { const int tk = (c.lane >> 4) * 4 + i; pw[tk * 32 + (c.lane & 15)] = acc0[i]; pw[tk * 32 + 16 + (c.lane & 15)] = acc1[i]; }
            }
            __syncthreads();
            if (c.wave == 0 && c.lane < 16) {
                float l[32];
#pragma unroll
                for (int q = 0; q < 8; ++q) { f32x4 tq = *(const f32x4*)(p.in[I_BROUTER] + 4 * q);
#pragma unroll
                    for (int w = 0; w < 4; ++w) tq += *(const LAS f32x4*)(L + RT_PART + w * 2048 + (c.lane * 32 + 4 * q) * 4);
                    l[4 * q] = tq[0]; l[4 * q + 1] = tq[1]; l[4 * q + 2] = tq[2]; l[4 * q + 3] = tq[3]; }
                unsigned used = 0u; float tv[4]; int ti[4];
#pragma unroll
                for (int s = 0; s < 4; ++s) { float best = -3.0e38f; int bi = 0;
#pragma unroll
                    for (int e = 0; e < 32; ++e) { const bool ok = !((used >> e) & 1u) && (l[e] > best); best = ok ? l[e] : best; bi = ok ? e : bi; }
                    used |= 1u << bi; tv[s] = best; ti[s] = bi; }
                const float e1 = __expf(tv[1] - tv[0]), e2 = __expf(tv[2] - tv[0]), e3 = __expf(tv[3] - tv[0]); const float inv = 1.f / (1.f + e1 + e2 + e3);
                const float gw[4] = {inv, e1 * inv, e2 * inv, e3 * inv};
                const int row = r0 + 16 * g + c.lane;
#pragma unroll
                for (int s = 0; s < 4; ++s) { const unsigned j = __hip_atomic_fetch_add(cntg + 16 * ti[s], 1u, RLX_AGENT);
                    rowtok[(size_t)ti[s] * ECAP + j] = row; roww[(size_t)ti[s] * ECAP + j] = gw[s]; sel[row * 4 + s] = ((unsigned)ti[s] << 16) | j; }
            }
        }
        __syncthreads();
    }
}
__device__ __forceinline__ void moe_plan(const Params& p, const Ctx& c) {
    LAS int* cnt = (LAS int*)(c.lds + LX_CNT); LAS int* tst = (LAS int*)(c.lds + LX_TST); LAS unsigned char* te = (LAS unsigned char*)(c.lds + LX_TE);
    const unsigned* cntg = (const unsigned*)(p.ws + WS_CTL) + CW_CNT;
    __syncthreads();
    if (c.tid < NE) cnt[c.tid] = (int)__hip_atomic_load(cntg + 16 * c.tid, RLX_AGENT);
    __syncthreads();
    if (c.tid == 0) { int a = 0; for (int e = 0; e < NE; ++e) { tst[e] = a; a += (cnt[e] + 255) >> 8; } tst[NE] = a; }
    __syncthreads();
    if (c.tid < NE) { for (int t = tst[c.tid]; t < tst[c.tid + 1]; ++t) te[t] = (unsigned char)c.tid; }
    __syncthreads();
}
__device__ __forceinline__ float half_sum(float v) {
#pragma unroll
    for (int o = 1; o < 32; o <<= 1) v += __shfl_xor(v, o);
    return v;
}
__device__ __forceinline__ void p13_final(const Params& p, const Ctx& c) {
    const float* XM = (const float*)(p.ws + WS_XMID); const unsigned char* DN = p.ws + WS_DOWN; const unsigned* sel = (const unsigned*)(p.ws + WS_SEL);
    const float* mod = (const float*)(p.ws + WS_MOD); const LAS int* tst = (const LAS int*)(c.lds + LX_TST);
    const int hl = c.lane & 31, hw = c.lane >> 5;
    for (int rp = c.gw; rp < TL / 2; rp += c.NGW) {
        const int row = 2 * rp + hw;
        const int b = row / SEQ; const float* gate = mod + (size_t)b * (6 * D) + 5 * D;
        size_t pos[4];
#pragma unroll
        for (int s = 0; s < 4; ++s) { const unsigned sv = sel[row * 4 + s]; pos[s] = (size_t)tst[(int)(sv >> 16)] * 256 + (sv & 0xffffu); }
        f32x4 a[8][2];
#pragma unroll
        for (int j = 0; j < 8; ++j) { a[j][0] = (f32x4){0.f, 0.f, 0.f, 0.f}; a[j][1] = a[j][0]; }
#pragma unroll
        for (int s = 0; s < 4; ++s)
#pragma unroll
            for (int j = 0; j < 8; ++j) { const u32x2 w = *(const u32x2*)(DN + pos[s] * D + 8 * hl + 256 * j);
                const f32x2 p0 = __builtin_amdgcn_cvt_pk_f32_fp8((int)w.x, false), p1 = __builtin_amdgcn_cvt_pk_f32_fp8((int)w.x, true), p2 = __builtin_amdgcn_cvt_pk_f32_fp8((int)w.y, false), p3 = __builtin_amdgcn_cvt_pk_f32_fp8((int)w.y, true);
                a[j][0] += (f32x4){p0.x, p0.y, p1.x, p1.y}; a[j][1] += (f32x4){p2.x, p2.y, p3.x, p3.y}; }
        float sm = 0.f;
#pragma unroll
        for (int j = 0; j < 8; ++j)
#pragma unroll
            for (int hh = 0; hh < 2; ++hh) { const int col = 8 * hl + 256 * j + 4 * hh; a[j][hh] = *(const f32x4*)(XM + (size_t)row * D + col) * DN_ALPHA + *(const f32x4*)(gate + col) * (a[j][hh] * (1.0f / DN8_SCALE));
                sm += (a[j][hh][0] + a[j][hh][1]) + (a[j][hh][2] + a[j][hh][3]); }
        const float mean = half_sum(sm) * (1.f / D); float s2 = 0.f;
#pragma unroll
        for (int j = 0; j < 8; ++j)
#pragma unroll
            for (int hh = 0; hh < 2; ++hh) { a[j][hh] = a[j][hh] - mean; s2 += (a[j][hh][0] * a[j][hh][0] + a[j][hh][1] * a[j][hh][1]) + (a[j][hh][2] * a[j][hh][2] + a[j][hh][3] * a[j][hh][3]); }
        const float rstd = __builtin_amdgcn_rsqf(half_sum(s2) * (1.f / D) + LN_EPS);
#pragma unroll
        for (int j = 0; j < 8; ++j)
#pragma unroll
            for (int hh = 0; hh < 2; ++hh) { const int col = 8 * hl + 256 * j + 4 * hh;
                *(f32x4*)(p.out + (size_t)row * D + col) = a[j][hh] * rstd * *(const f32x4*)(p.in[I_LN2G] + col) + *(const f32x4*)(p.in[I_LN2B] + col); }
    }
}

constexpr int N_PHASES = 14;
__global__ void __launch_bounds__(512, 2) fwd(Params p) {
    extern __shared__ __attribute__((aligned(16))) unsigned char lds_raw[];
    Ctx c; c.lds = (LAS unsigned char*)lds_raw; c.tid = threadIdx.x; c.lane = c.tid & 63; c.wave = __builtin_amdgcn_readfirstlane(c.tid >> 6);
    c.G = gridDim.x; c.bid = blockIdx.x; c.gw = c.bid * 8 + c.wave; c.NGW = c.G * 8;
    unsigned char* ws = p.ws;
    const int lo = p.ph_lo, hi = p.ph_hi;
    volatile LAS unsigned* MISC = (volatile LAS unsigned*)(c.lds + LX_MISC);
    if (c.tid < 64) MISC[c.tid] = 0u;
    __syncthreads();
    XcdBarrier bar; bar.bar = (unsigned*)(ws + WS_CTL) + CW_BAR; bar.x = 0; bar.st = nullptr;
    if (hi - lo > 1) bar = xcd_barrier_post((unsigned*)(ws + WS_CTL) + CW_BAR, MISC + 8);
#ifndef ONLY_PHASE
#define ONLY_PHASE -1
#endif
#define IN(k) ((ONLY_PHASE < 0 || ONLY_PHASE == (k)) && lo <= (k) && (k) < hi)
#define SEAM(k) do { if (IN(k) && IN((k) + 1)) xcd_barrier(bar); } while (0)
    LAS unsigned char* ring = c.lds;

#ifndef DUP_MASK
#define DUP_MASK 0
#endif
#define PH(k, ...) do { if (IN(k)) { __VA_ARGS__ if constexpr (((DUP_MASK) >> (k)) & 1) { if (hi - lo > 1) xcd_barrier(bar); __VA_ARGS__ } } SEAM(k); } while (0)
    PH(0, { p0_adaln(p, c); p0_small(p, c); p0_convert(p, c); if (!CONV_IN_SCAN || c.G != 256) moe_convert(p, c.gw, c.NGW, c.lane); });
    PH(1, { p1_modulate(p, c); });
    PH(2, { pg8::InProjSched S{(const bf16*)(ws + WS_U), (const bf16*)(ws + WS_WIN), c.G, c.bid};
        pg8::EpiInProj E{(bf16*)(ws + WS_ZL), (bf16*)(ws + WS_ZC), (const float*)(ws + WS_BIN)};
        pg8::gemm_phase<pg8::EpiInProj, pg8::InProjSched, false, true>(ring, D / 2, S, E, nullptr); });
    PH(3, { p3_conv(p, c); p3_alora(p, c); });
    PH(4, {
        { pg8::LoraSched S{(const bf16*)(ws + WS_ALORA3), (const bf16*)(ws + WS_WLORA), c.G, c.bid};
          pg8::EpiBf16Plain E{(bf16*)(ws + WS_LORA), LORA_N, nullptr};
          int kl = LORA_K; asm volatile("" : "+s"(kl));
          pg8::gemm_phase<pg8::EpiBf16Plain, pg8::LoraSched, false>(ring, kl, S, E, nullptr); }
        { pg8::PlainSched S{(const bf16*)(ws + WS_ACONV), (const bf16*)(ws + WS_WCO), DCV, TL / 256, D / 256, c.G, c.bid};
          pg8::EpiConvO E{(bf16*)(ws + WS_MIX), (const bf16*)(ws + WS_ZL), p.in[I_BCO]};
          pg8::gemm_phase<pg8::EpiConvO, pg8::PlainSched, false>(ring, DCV, S, E, nullptr); }
    });
    PH(6, { p6_scan(p, c); });
    PH(7, { p7_rwkvout(p, c); });
    PH(8, { pg8::PlainSched S{(const bf16*)(ws + WS_ARWKV), (const bf16*)(ws + WS_WRO), DR, TL / 256, D / 256, c.G, c.bid};
        pg8::EpiRwkvO E{(bf16*)(ws + WS_MIX), (const bf16*)(ws + WS_ZL)};
        pg8::gemm_phase<pg8::EpiRwkvO, pg8::PlainSched, false>(ring, DR, S, E, nullptr); });
    PH(9, { pg8::PlainSched S{(const bf16*)(ws + WS_MIX), (const bf16*)(ws + WS_WOUT), D, TL / 256, D / 256, c.G, c.bid};
        pg8::EpiOut E{(float*)(ws + WS_T1), p.in[I_X], (const float*)(ws + WS_MOD), p.in[I_BOUT]};
        pg8::gemm_phase<pg8::EpiOut, pg8::PlainSched, false>(ring, D, S, E, nullptr); });
    PH(10, { p10_router(p, c); });
    PH(11, { moe_plan(p, c);
        pg8::MoeSched S{nullptr, (const bf16*)(ws + WS_WGU), (const int*)(ws + WS_ROWTOK), D / 2, 4096, 16, c.G, c.bid, (const LAS int*)(c.lds + LX_CNT), (const LAS int*)(c.lds + LX_TST), (const LAS unsigned char*)(c.lds + LX_TE)};
        pg8::EpiGateUp E{ws + WS_HID, (const float*)(ws + WS_BGU)};
        pg8::gemm_phase<pg8::EpiGateUp, pg8::MoeSched, true, true>(ring, D / 2, S, E, (const char*)(ws + WS_U2F8)); });
    PH(12, { moe_plan(p, c);
        pg8::MoeSched S{(const bf16*)(ws + WS_HID), (const bf16*)(ws + WS_WDN), (const int*)(ws + WS_ROWTOK), D / 2, D, 8, c.G, c.bid, (const LAS int*)(c.lds + LX_CNT), (const LAS int*)(c.lds + LX_TST), (const LAS unsigned char*)(c.lds + LX_TE)};
        pg8::EpiDown E{ws + WS_DOWN, p.in[I_BDN], (const float*)(ws + WS_ROWW), (const LAS int*)(c.lds + LX_CNT)};
        pg8::gemm_phase<pg8::EpiDown, pg8::MoeSched, false, true>(ring, D / 2, S, E, nullptr); });
    PH(13, { moe_plan(p, c); p13_final(p, c); });
#undef PH
#undef IN
#undef SEAM
}

extern "C" void kernel_launch(void* const* d_in, const int* in_sizes, int n_in, void* d_out, int out_size, void* d_ws, size_t ws_size, hipStream_t stream) {
    static int grid = 0;
    if (grid == 0) {
        if (n_in != 38 || out_size != TL * D || ws_size < WS_END) { fprintf(stderr, "kernel_launch: unexpected shapes: n_in %d out %d ws %zu (need %zu)\n", n_in, out_size, ws_size, (size_t)WS_END); grid = -1; return; }
        int dev = 0, cus = 0, per_cu = 0;
        if (hipGetDevice(&dev) != hipSuccess || hipDeviceGetAttribute(&cus, hipDeviceAttributeMultiprocessorCount, dev) != hipSuccess) { grid = -1; return; }
        if (hipFuncSetAttribute((const void*)fwd, hipFuncAttributeMaxDynamicSharedMemorySize, LDS_BYTES) != hipSuccess) { fprintf(stderr, "kernel_launch: hipFuncSetAttribute failed\n"); grid = -1; return; }
        if (hipOccupancyMaxActiveBlocksPerMultiprocessor(&per_cu, (const void*)fwd, 512, LDS_BYTES) != hipSuccess || per_cu < 1) { fprintf(stderr, "kernel_launch: occupancy query says %d\n", per_cu); }
        (void)hipGetLastError();
        grid = cus;
    }
    if (grid < 0) return;
    (void)in_sizes;
    (void)hipMemsetAsync((char*)d_ws + WS_CTL, 0, CTL_ZERO_BYTES, stream);
    Params p; memset(&p, 0, sizeof(p));
    for (int i = 0; i < 38; ++i) p.in[i] = (const float*)d_in[i];
    p.out = (float*)d_out; p.ws = (unsigned char*)d_ws;
#if MK_FUSED
    p.ph_lo = 0; p.ph_hi = N_PHASES;
    hipLaunchKernelGGL(fwd, dim3(grid), dim3(512), LDS_BYTES, stream, p);
#else
    for (int k = 0; k < N_PHASES; ++k) { p.ph_lo = k; p.ph_hi = k + 1; hipLaunchKernelGGL(fwd, dim3(grid), dim3(512), LDS_BYTES, stream, p); }
#endif
}
```
